# Optimizing an MI355X kernel written in HIP

```python
import math
import jax, jax.numpy as jnp
from jax import lax
import numpy as np

D_MODEL = 1024
BATCH = 4
SEQ = 4096
DEPTH = 1

FOURIER_WIDTH = D_MODEL // 2
FOURIER_GROUPS = 4
FOURIER_GROUP_CH = FOURIER_WIDTH // FOURIER_GROUPS
SSM_WIDTH = D_MODEL // 2
SSM_GROUP_CH = 16
SSM_GROUPS = SSM_WIDTH // SSM_GROUP_CH
SSM_STATE = 64
DT_MIN = 1e-3
DT_MAX = 1e-1
N_BRANCHES = 2
IN_WIDTH = FOURIER_WIDTH + SSM_WIDTH + N_BRANCHES * D_MODEL
MOE_GROUPS = 8
EXPERTS_PER_GROUP = 8
N_EXPERTS = MOE_GROUPS * EXPERTS_PER_GROUP
MOE_TOP_K = 2
D_EXPERT = D_MODEL // 2
MOE_BLOCK = 128
RMS_EPS = 1e-6

kernel_name = "hybrid_fnet_s5_hiermoe_encoder_block"


def _rmsnorm(x, g):
    xf = x.astype(jnp.float32)
    inv = lax.rsqrt(jnp.mean(xf * xf, axis=-1, keepdims=True) + RMS_EPS)
    return (xf * inv * g.astype(jnp.float32)).astype(x.dtype)


def _fourier_mix(u):
    b, l, _ = u.shape
    ug = u.astype(jnp.float32).reshape(b, l, FOURIER_GROUPS, FOURIER_GROUP_CH)
    f = jnp.fft.fft2(ug, axes=(1, 3), norm='ortho').real
    return f.reshape(b, l, FOURIER_WIDTH).astype(u.dtype)


def _scan_combine(e1, e2):
    a1, b1 = e1
    a2, b2 = e2
    return a1 * a2, a2 * b1 + b2


def _ssm_direction(ug, a_re, a_im, log_dt, b_re, b_im, c_re, c_im, reverse):
    lam = lax.complex(a_re.astype(jnp.float32), a_im.astype(jnp.float32))
    dt = jnp.exp(log_dt.astype(jnp.float32))[:, None]
    a_bar = jnp.exp(lam * dt)
    b_mat = lax.complex(b_re.astype(jnp.float32), b_im.astype(jnp.float32))
    b_bar = ((a_bar - 1.0) / lam)[..., None] * b_mat
    bu = jnp.einsum('blgc,gnc->blgn', ug.astype(jnp.complex64), b_bar)
    a = jnp.broadcast_to(a_bar, bu.shape)
    _, h = lax.associative_scan(_scan_combine, (a, bu), axis=1, reverse=reverse)
    c_mat = lax.complex(c_re.astype(jnp.float32), c_im.astype(jnp.float32))
    return jnp.einsum('blgn,gcn->blgc', h, c_mat).real


def _ssm_mix(u, a_re, a_im, log_dt, b_re, b_im, c_re, c_im, d_skip, w_glu):
    b, l, _ = u.shape
    uf = u.astype(jnp.float32)
    ug = uf.reshape(b, l, SSM_GROUPS, SSM_GROUP_CH)
    y = (_ssm_direction(ug, a_re[0], a_im[0], log_dt[0], b_re[0], b_im[0], c_re[0], c_im[0], False)
         + _ssm_direction(ug, a_re[1], a_im[1], log_dt[1], b_re[1], b_im[1], c_re[1], c_im[1], True))
    y = y.reshape(b, l, SSM_WIDTH) + d_skip.astype(jnp.float32) * uf
    y = jax.nn.gelu(y)
    y = y * jax.nn.sigmoid(y @ w_glu.astype(jnp.float32))
    return y.astype(u.dtype)


def _hier_moe(h, wg, bg, we, be, w_gate, w_up, w_down):
    bsz, l, d = h.shape
    t = bsz * l
    ht = h.reshape(t, d)
    g_prob = jax.nn.softmax((ht @ wg).astype(jnp.float32) + bg.astype(jnp.float32), axis=-1)
    p_g, g_idx = lax.top_k(g_prob, 1)
    e_logits = ((ht @ we).astype(jnp.float32) + be.astype(jnp.float32)).reshape(t, MOE_GROUPS, EXPERTS_PER_GROUP)
    e_sel = jnp.take_along_axis(e_logits, g_idx[:, :, None], axis=1)[:, 0]
    top_l, top_i = lax.top_k(e_sel, MOE_TOP_K)
    gate_w = p_g * jax.nn.softmax(top_l, axis=-1)
    expert = g_idx * EXPERTS_PER_GROUP + top_i

    n_assign = t * MOE_TOP_K
    e_flat = expert.reshape(n_assign)
    w_flat = gate_w.reshape(n_assign)
    tok_flat = jnp.repeat(jnp.arange(t, dtype=jnp.int32), MOE_TOP_K)
    order = jnp.argsort(e_flat)
    e_s = e_flat[order]
    tok_s = tok_flat[order]
    w_s = w_flat[order]
    counts = jnp.bincount(e_flat, length=N_EXPERTS)
    starts = jnp.cumsum(counts) - counts
    padded = ((counts + MOE_BLOCK - 1) // MOE_BLOCK) * MOE_BLOCK
    pstarts = jnp.cumsum(padded) - padded
    pends = pstarts + padded
    dest = pstarts[e_s] + jnp.arange(n_assign, dtype=jnp.int32) - starts[e_s]
    n_blocks = -(-n_assign // MOE_BLOCK) + N_EXPERTS
    rows = n_blocks * MOE_BLOCK
    x_pad = jnp.zeros((rows, d), h.dtype).at[dest].set(ht[tok_s])
    block_start = jnp.arange(n_blocks, dtype=jnp.int32) * MOE_BLOCK
    block_e = jnp.minimum(jnp.searchsorted(pends, block_start, side='right'), N_EXPERTS - 1)

    def expert_block(args):
        xb, e = args
        a = jax.nn.silu(xb @ w_gate[e]) * (xb @ w_up[e])
        return a @ w_down[e]

    y_pad = lax.map(expert_block, (x_pad.reshape(n_blocks, MOE_BLOCK, d), block_e)).reshape(rows, d)
    y = y_pad[dest] * w_s[:, None].astype(h.dtype)
    out = jax.ops.segment_sum(y, tok_s, num_segments=t)
    return out.reshape(bsz, l, d)


def setup_inputs(seed: int = 0) -> dict:
    key = jax.random.key(seed)
    ks = jax.random.split(key, 24)
    f32 = jnp.float32

    def nrm(k, shape, scale):
        return jax.random.normal(k, shape, f32) * scale

    S, F, D = SSM_WIDTH, FOURIER_WIDTH, D_MODEL
    G, N, C = SSM_GROUPS, SSM_STATE, SSM_GROUP_CH
    n_idx = jnp.arange(N, dtype=f32)
    return {
        'x': nrm(ks[0], (BATCH, SEQ, D), 1.0),
        'mix_norm_g': 1.0 + nrm(ks[1], (DEPTH, D), 0.02),
        'w_in': nrm(ks[2], (DEPTH, D, IN_WIDTH), D ** -0.5),
        'w_fourier_out': nrm(ks[3], (DEPTH, F, D), F ** -0.5),
        'ssm_A_re': -0.5 + nrm(ks[4], (DEPTH, 2, G, N), 0.01),
        'ssm_A_im': math.pi * n_idx + nrm(ks[5], (DEPTH, 2, G, N), 0.01),
        'ssm_log_dt': jax.random.uniform(ks[6], (DEPTH, 2, G), f32, math.log(DT_MIN), math.log(DT_MAX)),
        'ssm_B_re': nrm(ks[7], (DEPTH, 2, G, N, C), (2 * C) ** -0.5),
        'ssm_B_im': nrm(ks[8], (DEPTH, 2, G, N, C), (2 * C) ** -0.5),
        'ssm_C_re': nrm(ks[9], (DEPTH, 2, G, C, N), N ** -0.5),
        'ssm_C_im': nrm(ks[10], (DEPTH, 2, G, C, N), N ** -0.5),
        'ssm_D': nrm(ks[11], (DEPTH, S), 1.0),
        'ssm_w_glu': nrm(ks[12], (DEPTH, S, S), S ** -0.5),
        'w_ssm_out': nrm(ks[13], (DEPTH, S, D), S ** -0.5),
        'w_out': nrm(ks[14], (DEPTH, D, D), D ** -0.5),
        'ffn_norm_g': 1.0 + nrm(ks[15], (DEPTH, D), 0.02),
        'router_group_w': nrm(ks[16], (DEPTH, D, MOE_GROUPS), D ** -0.5),
        'router_group_b': nrm(ks[17], (DEPTH, MOE_GROUPS), 0.01),
        'router_expert_w': nrm(ks[18], (DEPTH, D, N_EXPERTS), D ** -0.5),
        'router_expert_b': nrm(ks[19], (DEPTH, N_EXPERTS), 0.01),
        'expert_w_gate': nrm(ks[20], (DEPTH, N_EXPERTS, D, D_EXPERT), D ** -0.5),
        'expert_w_up': nrm(ks[21], (DEPTH, N_EXPERTS, D, D_EXPERT), D ** -0.5),
        'expert_w_down': nrm(ks[22], (DEPTH, N_EXPERTS, D_EXPERT, D), D_EXPERT ** -0.5),
        'final_norm_g': 1.0 + nrm(ks[23], (D,), 0.02),
    }


def reference(x, mix_norm_g, w_in, w_fourier_out, ssm_A_re, ssm_A_im, ssm_log_dt,
              ssm_B_re, ssm_B_im, ssm_C_re, ssm_C_im, ssm_D, ssm_w_glu, w_ssm_out,
              w_out, ffn_norm_g, router_group_w, router_group_b, router_expert_w,
              router_expert_b, expert_w_gate, expert_w_up, expert_w_down, final_norm_g):
    for i in range(DEPTH):
        h = _rmsnorm(x, mix_norm_g[i])
        z = h @ w_in[i]
        u_f = z[..., :FOURIER_WIDTH]
        u_s = z[..., FOURIER_WIDTH:FOURIER_WIDTH + SSM_WIDTH]
        gates = jax.nn.sigmoid(z[..., FOURIER_WIDTH + SSM_WIDTH:].astype(jnp.float32)).astype(x.dtype)
        y_f = _fourier_mix(u_f) @ w_fourier_out[i]
        y_s = _ssm_mix(u_s, ssm_A_re[i], ssm_A_im[i], ssm_log_dt[i], ssm_B_re[i], ssm_B_im[i],
                       ssm_C_re[i], ssm_C_im[i], ssm_D[i], ssm_w_glu[i]) @ w_ssm_out[i]
        merged = gates[..., :D_MODEL] * y_f + gates[..., D_MODEL:] * y_s
        x = x + merged @ w_out[i]
        hn = _rmsnorm(x, ffn_norm_g[i])
        x = x + _hier_moe(hn, router_group_w[i], router_group_b[i], router_expert_w[i],
                          router_expert_b[i], expert_w_gate[i], expert_w_up[i], expert_w_down[i])
    return _rmsnorm(x, final_norm_g)
```

```cpp
#include <hip/hip_runtime.h>
#include <hip/hip_cooperative_groups.h>
#include <cstdio>
namespace cg = cooperative_groups;

typedef unsigned short bf16_t;
typedef short bf16x8 __attribute__((ext_vector_type(8)));
typedef float f32x4 __attribute__((ext_vector_type(4)));
typedef float f32x2 __attribute__((ext_vector_type(2)));
typedef unsigned u32x2 __attribute__((ext_vector_type(2)));
typedef unsigned u32x4 __attribute__((ext_vector_type(4)));

constexpr int D = 1024, BATCH = 4, SEQ = 4096, T = BATCH * SEQ;
constexpr int FW = 512, SW = 512, INW = 3072;
constexpr int SG = 32, SC = 16, SN = 64;
constexpr int LC = 32, NCH = SEQ / LC, ROWS = T / LC;
constexpr int UK = 768;
constexpr int NE = 64, DE = 512, LISTCAP = 16384;
constexpr int NTHREADS = 512, NWAVES = 8;
constexpr int SMEM_BYTES = 136 * 1024;

constexpr size_t MiB = 1024 * 1024;
constexpr size_t OFF_WGT  = 0;
constexpr size_t OFF_WUT  = OFF_WGT + 64 * MiB;
constexpr size_t OFF_WDT  = OFF_WUT + 64 * MiB;
constexpr size_t OFF_WINT = OFF_WDT + 64 * MiB;
constexpr size_t OFF_WPT  = OFF_WINT + 6 * MiB;
constexpr size_t OFF_WGLT = OFF_WPT + 2 * MiB;
constexpr size_t OFF_WSOT = OFF_WGLT + MiB / 2;
constexpr size_t OFF_WOT  = OFF_WSOT + 1 * MiB;
constexpr size_t OFF_BTS  = OFF_WOT + 2 * MiB;
constexpr size_t OFF_BTY  = OFF_BTS + 8 * MiB;
constexpr size_t OFF_C    = OFF_BTY + 24 * MiB;
constexpr size_t OFF_D    = OFF_C + 64 * MiB;
constexpr size_t OFF_E    = OFF_D + 32 * MiB;
constexpr size_t OFF_FG   = OFF_E + 64 * MiB;
constexpr size_t OFF_H    = OFF_FG + 32 * MiB;
constexpr size_t OFF_I    = OFF_H + 24 * MiB;
constexpr size_t OFF_J    = OFF_I + 32 * MiB;
constexpr size_t J_CNT   = 0;
constexpr size_t J_AL    = 1024;
constexpr size_t J_WGTS  = 64 * 1024;
constexpr size_t J_LIST  = 256 * 1024;
constexpr size_t WS_NEED = OFF_J + 5 * MiB;

struct Params {
    const float* x; const float* mix_g; const float* w_in; const float* w_fo;
    const float* A_re; const float* A_im; const float* log_dt; const float* B_re; const float* B_im; const float* C_re; const float* C_im;
    const float* ssm_D; const float* w_glu; const float* w_sso; const float* w_out; const float* ffn_g;
    const float* rg_w; const float* rg_b; const float* re_w; const float* re_b;
    const float* e_gate; const float* e_up; const float* e_down; const float* fin_g;
    float* out; unsigned char* ws;
};

__device__ __forceinline__ bf16_t f2bf(float f) { unsigned u = __float_as_uint(f); u += 0x7FFFu + ((u >> 16) & 1u); return (bf16_t)(u >> 16); }
__device__ __forceinline__ float bf2f(bf16_t b) { return __uint_as_float(((unsigned)b) << 16); }
__device__ __forceinline__ unsigned pack2(float lo, float hi) { return (unsigned)f2bf(lo) | ((unsigned)f2bf(hi) << 16); }
__device__ __forceinline__ float sigmoidf_(float v) { return 1.0f / (1.0f + __expf(-v)); }
__device__ __forceinline__ float gelu_tanh(float v) { const float u = 0.7978845608028654f * (v + 0.044715f * v * v * v); return 0.5f * v * (1.0f + tanhf(u)); }
__device__ __forceinline__ float wave_sum(float v) {
#pragma unroll
    for (int o = 32; o > 0; o >>= 1) v += __shfl_xor(v, o);
    return v;
}

template <class AF, class BF, class EF>
__device__ __forceinline__ void wave_gemm_64x64(const int K, const AF& arow, const BF& brow, const EF& epi, const int m0, const int n0, const int lane) {
    const int fr = lane & 15, fq = lane >> 4;
    const bf16_t* ap0 = arow(m0 + fr) + fq * 8;
    const bf16_t* ap1 = arow(m0 + 16 + fr) + fq * 8;
    const bf16_t* ap2 = arow(m0 + 32 + fr) + fq * 8;
    const bf16_t* ap3 = arow(m0 + 48 + fr) + fq * 8;
    const bf16_t* bp0 = brow(n0 + fr) + fq * 8;
    const bf16_t* bp1 = brow(n0 + 16 + fr) + fq * 8;
    const bf16_t* bp2 = brow(n0 + 32 + fr) + fq * 8;
    const bf16_t* bp3 = brow(n0 + 48 + fr) + fq * 8;
    f32x4 acc[4][4];
#pragma unroll
    for (int i = 0; i < 4; ++i)
#pragma unroll
        for (int j = 0; j < 4; ++j) acc[i][j] = (f32x4){0.f, 0.f, 0.f, 0.f};
    bf16x8 a[4], b[4];
    a[0] = *(const bf16x8*)ap0; a[1] = *(const bf16x8*)ap1; a[2] = *(const bf16x8*)ap2; a[3] = *(const bf16x8*)ap3;
    b[0] = *(const bf16x8*)bp0; b[1] = *(const bf16x8*)bp1; b[2] = *(const bf16x8*)bp2; b[3] = *(const bf16x8*)bp3;
    for (int k = 0; k < K; k += 32) {
        bf16x8 an[4], bn[4];
        const int kn = (k + 32 < K) ? k + 32 : k;
        an[0] = *(const bf16x8*)(ap0 + kn); an[1] = *(const bf16x8*)(ap1 + kn); an[2] = *(const bf16x8*)(ap2 + kn); an[3] = *(const bf16x8*)(ap3 + kn);
        bn[0] = *(const bf16x8*)(bp0 + kn); bn[1] = *(const bf16x8*)(bp1 + kn); bn[2] = *(const bf16x8*)(bp2 + kn); bn[3] = *(const bf16x8*)(bp3 + kn);
#pragma unroll
        for (int i = 0; i < 4; ++i)
#pragma unroll
            for (int j = 0; j < 4; ++j) acc[i][j] = __builtin_amdgcn_mfma_f32_16x16x32_bf16(b[j], a[i], acc[i][j], 0, 0, 0);
#pragma unroll
        for (int i = 0; i < 4; ++i) { a[i] = an[i]; b[i] = bn[i]; }
    }
#pragma unroll
    for (int i = 0; i < 4; ++i)
#pragma unroll
        for (int j = 0; j < 4; ++j) epi(m0 + 16 * i + fr, n0 + 16 * j + 4 * fq, acc[i][j]);
}

template <class AF, class BF, class EF>
__device__ __forceinline__ void gemm_phase_simple(const int M, const int N, const int K, const AF& arow, const BF& brow, const EF& epi) {
    const int lane = threadIdx.x & 63, wid = threadIdx.x >> 6;
    const int gw = blockIdx.x * NWAVES + wid, nw = gridDim.x * NWAVES;
    const int tn = N / 64, tiles = (M / 64) * tn;
    for (int t = gw; t < tiles; t += nw) wave_gemm_64x64(K, arow, brow, epi, (t / tn) * 64, (t % tn) * 64, lane);
}

__device__ void transpose_cvt_tile(const float* __restrict__ src, bf16_t* __restrict__ dst, const int K, const int N, const int tile, float* lds) {
    const int tn = N / 64, k0 = (tile / tn) * 64, n0 = (tile % tn) * 64;
    const int t = threadIdx.x;
    __syncthreads();
#pragma unroll
    for (int i = 0; i < 2; ++i) {
        const int kk = (t >> 4) + 32 * i, c4 = (t & 15) * 4;
        const f32x4 v = *(const f32x4*)(src + (size_t)(k0 + kk) * N + n0 + c4);
        lds[kk * 65 + c4 + 0] = v[0]; lds[kk * 65 + c4 + 1] = v[1]; lds[kk * 65 + c4 + 2] = v[2]; lds[kk * 65 + c4 + 3] = v[3];
    }
    __syncthreads();
    {
        const int n = t >> 3, kc = (t & 7) * 8;
        u32x4 w;
        w[0] = pack2(lds[(kc + 0) * 65 + n], lds[(kc + 1) * 65 + n]);
        w[1] = pack2(lds[(kc + 2) * 65 + n], lds[(kc + 3) * 65 + n]);
        w[2] = pack2(lds[(kc + 4) * 65 + n], lds[(kc + 5) * 65 + n]);
        w[3] = pack2(lds[(kc + 6) * 65 + n], lds[(kc + 7) * 65 + n]);
        *(u32x4*)(dst + (size_t)(n0 + n) * K + k0 + kc) = w;
    }
}

__device__ void ssm_prep_group(const Params& p, const int g, float* lds) {
    f32x2* pw = (f32x2*)lds;
    f32x2* bb = pw + 4224;
    f32x2* cm = bb + 2048;
    float* kt = (float*)(cm + 2048);
    const int t = threadIdx.x;
    bf16_t* BtS = (bf16_t*)(p.ws + OFF_BTS) + (size_t)g * 256 * 512;
    bf16_t* BtY = (bf16_t*)(p.ws + OFF_BTY) + (size_t)g * 512 * UK;
    f32x2* aL = (f32x2*)(p.ws + OFF_J + J_AL);
    __syncthreads();
    for (int i = t; i < 2 * 64 * 33; i += NTHREADS) {
        const int dir = i / (64 * 33), n = (i / 33) % 64, tau = i % 33;
        const double are = (double)p.A_re[(dir * SG + g) * SN + n], aim = (double)p.A_im[(dir * SG + g) * SN + n];
        const double dt = exp((double)p.log_dt[dir * SG + g]);
        const double mag = exp(are * dt * tau), ang = aim * dt * tau;
        pw[i] = (f32x2){(float)(mag * cos(ang)), (float)(mag * sin(ang))};
        if (tau == 32) aL[(dir * SG + g) * SN + n] = pw[i];
    }
    for (int i = t; i < 2 * 64 * 16; i += NTHREADS) {
        const int dir = i / 1024, n = (i / 16) % 64, ci = i % 16;
        const double are = (double)p.A_re[(dir * SG + g) * SN + n], aim = (double)p.A_im[(dir * SG + g) * SN + n];
        const double dt = exp((double)p.log_dt[dir * SG + g]);
        const double mag = exp(are * dt), ang = aim * dt;
        const double nr = mag * cos(ang) - 1.0, ni = mag * sin(ang);
        const double den = are * are + aim * aim;
        const double qr = (nr * are + ni * aim) / den, qi = (ni * are - nr * aim) / den;
        const size_t bi = ((size_t)(dir * SG + g) * SN + n) * SC + ci;
        const double br = (double)p.B_re[bi], bim = (double)p.B_im[bi];
        bb[i] = (f32x2){(float)(qr * br - qi * bim), (float)(qr * bim + qi * br)};
    }
    for (int i = t; i < 2 * 16 * 64; i += NTHREADS) {
        const int dir = i / 1024, co = (i / 64) % 16, n = i % 64;
        const size_t ci_ = ((size_t)(dir * SG + g) * SC + co) * SN + n;
        cm[i] = (f32x2){p.C_re[ci_], p.C_im[ci_]};
    }
    __syncthreads();
    for (int i = t; i < 2 * 32 * 256; i += NTHREADS) {
        const int dir = i / 8192, tau = (i / 256) % 32, co = (i / 16) % 16, ci = i % 16;
        float s = 0.f;
        for (int n = 0; n < 64; ++n) {
            const f32x2 c = cm[(dir * 16 + co) * 64 + n], a = pw[(dir * 64 + n) * 33 + tau], b = bb[(dir * 64 + n) * 16 + ci];
            const float zr = c[0] * a[0] - c[1] * a[1], zi = c[0] * a[1] + c[1] * a[0];
            s += zr * b[0] - zi * b[1];
        }
        kt[i] = s;
    }
    __syncthreads();
    for (int i = t; i < 256 * 512; i += NTHREADS) {
        const int row = i / 512, col = i % 512;
        const int dir = row / 128, n = (row / 2) % 64, ri = row & 1, s = col / 16, ci = col % 16;
        const int tau = dir == 0 ? (LC - 1 - s) : s;
        const f32x2 a = pw[(dir * 64 + n) * 33 + tau], b = bb[(dir * 64 + n) * 16 + ci];
        const float v = ri == 0 ? (a[0] * b[0] - a[1] * b[1]) : (a[0] * b[1] + a[1] * b[0]);
        BtS[i] = f2bf(v);
    }
    for (int i = t; i < 512 * UK; i += NTHREADS) {
        const int row = i / UK, kk = i % UK;
        const int tt = row / 16, co = row % 16;
        float v;
        if (kk < 512) {
            const int s = kk / 16, ci = kk % 16;
            if (s < tt) v = kt[((0 * 32 + (tt - s)) * 16 + co) * 16 + ci];
            else if (s > tt) v = kt[((1 * 32 + (s - tt)) * 16 + co) * 16 + ci];
            else v = kt[((0 * 32 + 0) * 16 + co) * 16 + ci] + kt[((1 * 32 + 0) * 16 + co) * 16 + ci];
        } else {
            const int q = kk - 512, dir = q / 128, n = (q / 2) % 64, ri = q & 1;
            const int tau = dir == 0 ? (tt + 1) : (LC - tt);
            const f32x2 c = cm[(dir * 16 + co) * 64 + n], a = pw[(dir * 64 + n) * 33 + tau];
            const float zr = c[0] * a[0] - c[1] * a[1], zi = c[0] * a[1] + c[1] * a[0];
            v = ri == 0 ? zr : -zi;
        }
        BtY[i] = f2bf(v);
    }
}

__device__ __forceinline__ void load_row(const float* row, const int lane, f32x4 (&v)[4]) {
#pragma unroll
    for (int i = 0; i < 4; ++i) v[i] = *(const f32x4*)(row + 4 * lane + 256 * i);
}
__device__ __forceinline__ float row_inv_rms(const f32x4 (&v)[4]) {
    float s = 0.f;
#pragma unroll
    for (int i = 0; i < 4; ++i) s += v[i][0] * v[i][0] + v[i][1] * v[i][1] + v[i][2] * v[i][2] + v[i][3] * v[i][3];
    s = wave_sum(s);
    return 1.0f / sqrtf(s * (1.0f / 1024.0f) + 1e-6f);
}

__global__ void __launch_bounds__(NTHREADS) fwd_megakernel(const Params p) {
    cg::grid_group grid = cg::this_grid();
    __shared__ __attribute__((aligned(16))) unsigned char smem[SMEM_BYTES];
    const int tid = threadIdx.x, lane = tid & 63, wid = tid >> 6;
    const int gw = blockIdx.x * NWAVES + wid, nw = gridDim.x * NWAVES;
    const int gt = blockIdx.x * NTHREADS + tid, nt = gridDim.x * NTHREADS;
    unsigned char* ws = p.ws;
    bf16_t* WgT = (bf16_t*)(ws + OFF_WGT); bf16_t* WuT = (bf16_t*)(ws + OFF_WUT); bf16_t* WdT = (bf16_t*)(ws + OFF_WDT);
    bf16_t* WinT = (bf16_t*)(ws + OFF_WINT); bf16_t* WpT = (bf16_t*)(ws + OFF_WPT); bf16_t* WglT = (bf16_t*)(ws + OFF_WGLT);
    bf16_t* WsoT = (bf16_t*)(ws + OFF_WSOT); bf16_t* WoT = (bf16_t*)(ws + OFF_WOT);
    bf16_t* BtS = (bf16_t*)(ws + OFF_BTS); bf16_t* BtY = (bf16_t*)(ws + OFF_BTY);
    bf16_t* DT = (bf16_t*)(ws + OFF_C); bf16_t* ybuf = (bf16_t*)(ws + OFF_C);
    bf16_t* hn = (bf16_t*)(ws + OFF_D); bf16_t* Fb = (bf16_t*)(ws + OFF_D); bf16_t* hn2 = (bf16_t*)(ws + OFF_D);
    bf16_t* gates = (bf16_t*)(ws + OFF_E); bf16_t* act = (bf16_t*)(ws + OFF_E);
    bf16_t* uT = (bf16_t*)(ws + OFF_FG); float* Sst = (float*)(ws + OFF_FG + 16 * MiB); bf16_t* m1 = (bf16_t*)(ws + OFF_FG);
    bf16_t* Ucomb = (bf16_t*)(ws + OFF_H);
    bf16_t* yg = (bf16_t*)(ws + OFF_I); bf16_t* ys2 = (bf16_t*)(ws + OFF_I + 16 * MiB);
    unsigned* cnt = (unsigned*)(ws + OFF_J + J_CNT);
    const f32x2* aL = (const f32x2*)(ws + OFF_J + J_AL);
    float* wgts = (float*)(ws + OFF_J + J_WGTS);
    int* list = (int*)(ws + OFF_J + J_LIST);
    float* x2 = p.out;

    {
        float* ldsf = (float*)smem;
        const int T_WIN = 16 * 48, T_GLU = 8 * 8, T_SSO = 8 * 16, T_WO = 16 * 16, T_EG = 64 * 16 * 8, T_ED = 64 * 8 * 16;
        const int total = T_WIN + T_GLU + T_SSO + T_WO + 2 * T_EG + T_ED;
        for (int j = blockIdx.x; j < total; j += gridDim.x) {
            int q = j;
            if (q < T_WIN) { transpose_cvt_tile(p.w_in, WinT, 1024, 3072, q, ldsf); continue; } q -= T_WIN;
            if (q < T_GLU) { transpose_cvt_tile(p.w_glu, WglT, 512, 512, q, ldsf); continue; } q -= T_GLU;
            if (q < T_SSO) { transpose_cvt_tile(p.w_sso, WsoT, 512, 1024, q, ldsf); continue; } q -= T_SSO;
            if (q < T_WO) { transpose_cvt_tile(p.w_out, WoT, 1024, 1024, q, ldsf); continue; } q -= T_WO;
            if (q < T_EG) { const int e = q / 128; transpose_cvt_tile(p.e_gate + (size_t)e * 1024 * 512, WgT + (size_t)e * 512 * 1024, 1024, 512, q % 128, ldsf); continue; } q -= T_EG;
            if (q < T_EG) { const int e = q / 128; transpose_cvt_tile(p.e_up + (size_t)e * 1024 * 512, WuT + (size_t)e * 512 * 1024, 1024, 512, q % 128, ldsf); continue; } q -= T_EG;
            { const int e = q / 128; transpose_cvt_tile(p.e_down + (size_t)e * 512 * 1024, WdT + (size_t)e * 1024 * 512, 512, 1024, q % 128, ldsf); }
        }
        __syncthreads();
        for (int i = gt; i < 1024 * 1024; i += nt) {
            const int d = i & 1023, kk = i >> 10;
            const int g = kk >> 8, c = (kk >> 1) & 127, ri = kk & 1;
            float s = 0.f;
            for (int m = 0; m < 128; ++m) {
                const float ang = (float)((c * m) & 127) * (1.0f / 64.0f);
                const float f = ri ? sinpif(ang) : cospif(ang);
                s += f * p.w_fo[(size_t)(g * 128 + m) * 1024 + d];
            }
            WpT[(size_t)d * 1024 + kk] = f2bf(s * 0.08838834764831845f);
        }
        for (int i = gt; i < 8192 * 512; i += nt) {
            const int row = i >> 9, l0 = (i & 511) * 8;
            const int k = row >> 1, ri = row & 1;
            unsigned w[4];
#pragma unroll
            for (int j = 0; j < 4; ++j) {
                float v[2];
#pragma unroll
                for (int h = 0; h < 2; ++h) {
                    const int l = l0 + 2 * j + h;
                    const float ang = (float)((k * l) & 4095) * (1.0f / 2048.0f);
                    v[h] = (ri ? -sinpif(ang) : cospif(ang)) * (1.0f / 64.0f);
                }
                w[j] = pack2(v[0], v[1]);
            }
            *(u32x4*)(DT + (size_t)row * 4096 + l0) = (u32x4){w[0], w[1], w[2], w[3]};
        }
        for (int g = blockIdx.x; g < SG; g += gridDim.x) ssm_prep_group(p, g, (float*)smem);
        for (int r = gw; r < T; r += nw) {
            f32x4 v[4]; load_row(p.x + (size_t)r * D, lane, v);
            const float inv = row_inv_rms(v);
#pragma unroll
            for (int i = 0; i < 4; ++i) {
                const f32x4 gg = *(const f32x4*)(p.mix_g + 4 * lane + 256 * i);
                u32x2 w; w[0] = pack2(v[i][0] * inv * gg[0], v[i][1] * inv * gg[1]); w[1] = pack2(v[i][2] * inv * gg[2], v[i][3] * inv * gg[3]);
                *(u32x2*)(hn + (size_t)r * D + 4 * lane + 256 * i) = w;
            }
        }
    }
    grid.sync();
    {
        auto arow = [=](int m) { return hn + (size_t)m * D; };
        auto brow = [=](int n) { return WinT + (size_t)n * D; };
        auto epi = [=](int m, int n4, f32x4 v) {
            if (n4 < FW) {
                const int b = m >> 12, l = m & 4095;
#pragma unroll
                for (int j = 0; j < 4; ++j) uT[((size_t)(b * FW + n4 + j) << 12) + l] = f2bf(v[j]);
            } else if (n4 < FW + SW) {
                const int ch = n4 - FW, g = ch >> 4, ci = ch & 15;
                u32x2 w; w[0] = pack2(v[0], v[1]); w[1] = pack2(v[2], v[3]);
                *(u32x2*)(Ucomb + ((size_t)(g * ROWS + (m >> 5))) * UK + (m & 31) * 16 + ci) = w;
            } else {
                u32x2 w; w[0] = pack2(sigmoidf_(v[0]), sigmoidf_(v[1])); w[1] = pack2(sigmoidf_(v[2]), sigmoidf_(v[3]));
                *(u32x2*)(gates + (size_t)m * 2048 + (n4 - 1024)) = w;
            }
        };
        gemm_phase_simple(T, INW, D, arow, brow, epi);
    }
    grid.sync();
    {
        for (int b = 0; b < BATCH; ++b) {
            auto arow = [=](int m) { return uT + ((size_t)(b * FW + m) << 12); };
            auto brow = [=](int n) { return DT + ((size_t)n << 12); };
            auto epi = [=](int m, int n4, f32x4 v) {
                const int k0 = n4 >> 1;
                *(unsigned*)(Fb + ((size_t)(b * SEQ + k0)) * 1024 + 2 * m) = pack2(v[0], v[1]);
                *(unsigned*)(Fb + ((size_t)(b * SEQ + k0 + 1)) * 1024 + 2 * m) = pack2(v[2], v[3]);
            };
            gemm_phase_simple(FW, 2 * SEQ, SEQ, arow, brow, epi);
        }
        for (int g = 0; g < SG; ++g) {
            auto arow = [=](int m) { return Ucomb + (size_t)(g * ROWS + m) * UK; };
            auto brow = [=](int n) { return BtS + (size_t)(g * 256 + n) * 512; };
            auto epi = [=](int m, int n4, f32x4 v) { *(f32x4*)(Sst + (size_t)(g * ROWS + m) * 256 + n4) = v; };
            gemm_phase_simple(ROWS, 256, 512, arow, brow, epi);
        }
    }
    grid.sync();
    {
        for (int i = gt; i < BATCH * SG * 2 * SN; i += nt) {
            const int n = i & 63, dir = (i >> 6) & 1, g = (i >> 7) & 31, b = i >> 12;
            const f32x2 a = aL[(dir * SG + g) * SN + n];
            float hr = 0.f, hi = 0.f;
            for (int jj = 0; jj < NCH; ++jj) {
                const int j = dir == 0 ? jj : (NCH - 1 - jj);
                const size_t row = (size_t)g * ROWS + b * NCH + j;
                *(unsigned*)(Ucomb + row * UK + 512 + (dir * 64 + n) * 2) = pack2(hr, hi);
                const f32x2 s = *(const f32x2*)(Sst + row * 256 + (dir * 64 + n) * 2);
                const float nr = a[0] * hr - a[1] * hi + s[0], ni = a[0] * hi + a[1] * hr + s[1];
                hr = nr; hi = ni;
            }
        }
    }
    grid.sync();
    {
        for (int g = 0; g < SG; ++g) {
            auto arow = [=](int m) { return Ucomb + (size_t)(g * ROWS + m) * UK; };
            auto brow = [=](int n) { return BtY + (size_t)(g * 512 + n) * UK; };
            auto epi = [=](int m, int n4, f32x4 v) {
                const int tt = n4 >> 4, co = n4 & 15, tok = m * LC + tt, ch = g * 16 + co;
                const u32x2 uu = *(const u32x2*)(Ucomb + (size_t)(g * ROWS + m) * UK + n4);
                const f32x4 dd = *(const f32x4*)(p.ssm_D + ch);
                const float u0 = __uint_as_float(uu[0] << 16), u1 = __uint_as_float(uu[0] & 0xffff0000u), u2 = __uint_as_float(uu[1] << 16), u3 = __uint_as_float(uu[1] & 0xffff0000u);
                u32x2 w; w[0] = pack2(gelu_tanh(v[0] + dd[0] * u0), gelu_tanh(v[1] + dd[1] * u1)); w[1] = pack2(gelu_tanh(v[2] + dd[2] * u2), gelu_tanh(v[3] + dd[3] * u3));
                *(u32x2*)(yg + (size_t)tok * SW + ch) = w;
            };
            gemm_phase_simple(ROWS, 512, UK, arow, brow, epi);
        }
        {
            auto arow = [=](int m) { return Fb + (size_t)m * 1024; };
            auto brow = [=](int n) { return WpT + (size_t)n * 1024; };
            auto epi = [=](int m, int n4, f32x4 v) {
                const u32x2 gg = *(const u32x2*)(gates + (size_t)m * 2048 + n4);
                const float g0 = __uint_as_float(gg[0] << 16), g1 = __uint_as_float(gg[0] & 0xffff0000u), g2 = __uint_as_float(gg[1] << 16), g3 = __uint_as_float(gg[1] & 0xffff0000u);
                u32x2 w; w[0] = pack2(g0 * v[0], g1 * v[1]); w[1] = pack2(g2 * v[2], g3 * v[3]);
                *(u32x2*)(m1 + (size_t)m * D + n4) = w;
            };
            gemm_phase_simple(T, D, 1024, arow, brow, epi);
        }
    }
    grid.sync();
    {
        auto arow = [=](int m) { return yg + (size_t)m * SW; };
        auto brow = [=](int n) { return WglT + (size_t)n * SW; };
        auto epi = [=](int m, int n4, f32x4 v) {
            const u32x2 yy = *(const u32x2*)(yg + (size_t)m * SW + n4);
            const float y0 = __uint_as_float(yy[0] << 16), y1 = __uint_as_float(yy[0] & 0xffff0000u), y2 = __uint_as_float(yy[1] << 16), y3 = __uint_as_float(yy[1] & 0xffff0000u);
            u32x2 w; w[0] = pack2(y0 * sigmoidf_(v[0]), y1 * sigmoidf_(v[1])); w[1] = pack2(y2 * sigmoidf_(v[2]), y3 * sigmoidf_(v[3]));
            *(u32x2*)(ys2 + (size_t)m * SW + n4) = w;
        };
        gemm_phase_simple(T, SW, SW, arow, brow, epi);
    }
    grid.sync();
    {
        auto arow = [=](int m) { return ys2 + (size_t)m * SW; };
        auto brow = [=](int n) { return WsoT + (size_t)n * SW; };
        auto epi = [=](int m, int n4, f32x4 v) {
            const u32x2 gg = *(const u32x2*)(gates + (size_t)m * 2048 + 1024 + n4);
            const u32x2 mm = *(const u32x2*)(m1 + (size_t)m * D + n4);
            const float g0 = __uint_as_float(gg[0] << 16), g1 = __uint_as_float(gg[0] & 0xffff0000u), g2 = __uint_as_float(gg[1] << 16), g3 = __uint_as_float(gg[1] & 0xffff0000u);
            const float a0 = __uint_as_float(mm[0] << 16), a1 = __uint_as_float(mm[0] & 0xffff0000u), a2 = __uint_as_float(mm[1] << 16), a3 = __uint_as_float(mm[1] & 0xffff0000u);
            u32x2 w; w[0] = pack2(a0 + g0 * v[0], a1 + g1 * v[1]); w[1] = pack2(a2 + g2 * v[2], a3 + g3 * v[3]);
            *(u32x2*)(m1 + (size_t)m * D + n4) = w;
        };
        gemm_phase_simple(T, D, SW, arow, brow, epi);
    }
    grid.sync();
    {
        auto arow = [=](int m) { return m1 + (size_t)m * D; };
        auto brow = [=](int n) { return WoT + (size_t)n * D; };
        auto epi = [=](int m, int n4, f32x4 v) {
            const f32x4 xx = *(const f32x4*)(p.x + (size_t)m * D + n4);
            *(f32x4*)(x2 + (size_t)m * D + n4) = xx + v;
        };
        gemm_phase_simple(T, D, D, arow, brow, epi);
    }
    grid.sync();
    {
        float* rows = (float*)smem + (size_t)wid * 4 * 1024;
        for (int t0 = gw * 4; t0 < T; t0 += nw * 4) {
#pragma unroll
            for (int q = 0; q < 4; ++q) {
                const int r = t0 + q;
                f32x4 v[4]; load_row(x2 + (size_t)r * D, lane, v);
                const float inv = row_inv_rms(v);
#pragma unroll
                for (int i = 0; i < 4; ++i) {
                    const f32x4 gg = *(const f32x4*)(p.ffn_g + 4 * lane + 256 * i);
                    const f32x4 h = (f32x4){v[i][0] * inv * gg[0], v[i][1] * inv * gg[1], v[i][2] * inv * gg[2], v[i][3] * inv * gg[3]};
                    *(f32x4*)(rows + q * 1024 + 4 * lane + 256 * i) = h;
                    u32x2 w; w[0] = pack2(h[0], h[1]); w[1] = pack2(h[2], h[3]);
                    *(u32x2*)(hn2 + (size_t)r * D + 4 * lane + 256 * i) = w;
                }
            }
            asm volatile("s_waitcnt lgkmcnt(0)" ::: "memory");
            float ae[4] = {0.f, 0.f, 0.f, 0.f}, ag[4] = {0.f, 0.f, 0.f, 0.f};
            const int gl = lane & 7;
            for (int k = 0; k < 1024; ++k) {
                const float we = p.re_w[k * 64 + lane], wg = p.rg_w[k * 8 + gl];
#pragma unroll
                for (int q = 0; q < 4; ++q) { const float h = rows[q * 1024 + k]; ae[q] += h * we; ag[q] += h * wg; }
            }
            const float be = p.re_b[lane], bg = p.rg_b[gl];
#pragma unroll
            for (int q = 0; q < 4; ++q) {
                const float le = ae[q] + be, lg = ag[q] + bg;
                float gv[8];
#pragma unroll
                for (int i = 0; i < 8; ++i) gv[i] = __shfl(lg, i);
                int gi = 0; float gm = gv[0];
#pragma unroll
                for (int i = 1; i < 8; ++i) if (gv[i] > gm) { gm = gv[i]; gi = i; }
                float den = 0.f;
#pragma unroll
                for (int i = 0; i < 8; ++i) den += __expf(gv[i] - gm);
                const float pg = 1.0f / den;
                float ev[8];
#pragma unroll
                for (int i = 0; i < 8; ++i) ev[i] = __shfl(le, gi * 8 + i);
                int i1 = 0; float v1 = ev[0];
#pragma unroll
                for (int i = 1; i < 8; ++i) if (ev[i] > v1) { v1 = ev[i]; i1 = i; }
                int i2 = -1; float v2 = -3.0e38f;
#pragma unroll
                for (int i = 0; i < 8; ++i) if (i != i1 && ev[i] > v2) { v2 = ev[i]; i2 = i; }
                const float e2 = __expf(v2 - v1), w1 = pg / (1.0f + e2), w2 = pg * e2 / (1.0f + e2);
                if (lane == 0) {
                    const int tok = t0 + q, ex1 = gi * 8 + i1, ex2 = gi * 8 + i2;
                    const unsigned p1 = atomicAdd(&cnt[ex1], 1u), p2 = atomicAdd(&cnt[ex2], 1u);
                    list[ex1 * LISTCAP + p1] = tok * 2; list[ex2 * LISTCAP + p2] = tok * 2 + 1;
                    wgts[tok * 2] = w1; wgts[tok * 2 + 1] = w2;
                }
            }
        }
    }
    grid.sync();
    int* sh_i = (int*)smem;
    {
        __syncthreads();
        if (tid == 0) {
            int ro = 0, tp = 0;
            for (int e = 0; e < NE; ++e) { const int c = (int)cnt[e]; sh_i[e] = c; sh_i[64 + e] = ro; sh_i[128 + e] = tp; ro += c; tp += (c + 63) / 64; }
            sh_i[128 + NE] = tp;
        }
        __syncthreads();
        const int total_m = sh_i[128 + NE];
        for (int t = gw; t < total_m * 16; t += nw) {
            const int mt_g = t >> 4, ntile = t & 15;
            int e = 0;
            while (sh_i[128 + e + 1] <= mt_g) ++e;
            const int mt = mt_g - sh_i[128 + e], c = sh_i[e], ro = sh_i[64 + e];
            const int* le = list + e * LISTCAP;
            auto arow = [=](int m) { const int idx = m < c ? m : c - 1; return hn2 + (size_t)(le[idx] >> 1) * D; };
            auto brow = [=](int n) { return ((n & 1) ? WuT : WgT) + ((size_t)e * DE + (n >> 1)) * D; };
            auto epi = [=](int m, int n4, f32x4 v) {
                if (m < c) {
                    const float s0 = v[0] * sigmoidf_(v[0]) * v[1], s1 = v[2] * sigmoidf_(v[2]) * v[3];
                    *(unsigned*)(act + (size_t)(ro + m) * DE + (n4 >> 1)) = pack2(s0, s1);
                }
            };
            wave_gemm_64x64(D, arow, brow, epi, mt * 64, ntile * 64, lane);
        }
    }
    grid.sync();
    {
        const int total_m = sh_i[128 + NE];
        for (int t = gw; t < total_m * 16; t += nw) {
            const int mt_g = t >> 4, ntile = t & 15;
            int e = 0;
            while (sh_i[128 + e + 1] <= mt_g) ++e;
            const int mt = mt_g - sh_i[128 + e], c = sh_i[e], ro = sh_i[64 + e];
            const int* le = list + e * LISTCAP;
            auto arow = [=](int m) { const int idx = m < c ? m : c - 1; return act + (size_t)(ro + idx) * DE; };
            auto brow = [=](int n) { return WdT + ((size_t)e * D + n) * DE; };
            auto epi = [=](int m, int n4, f32x4 v) {
                if (m < c) {
                    const int as = le[m]; const float w = wgts[as];
                    u32x2 o; o[0] = pack2(w * v[0], w * v[1]); o[1] = pack2(w * v[2], w * v[3]);
                    *(u32x2*)(ybuf + (size_t)as * D + n4) = o;
                }
            };
            wave_gemm_64x64(DE, arow, brow, epi, mt * 64, ntile * 64, lane);
        }
    }
    grid.sync();
    {
        for (int r = gw; r < T; r += nw) {
            f32x4 v[4]; load_row(x2 + (size_t)r * D, lane, v);
#pragma unroll
            for (int i = 0; i < 4; ++i) {
                const u32x2 y0 = *(const u32x2*)(ybuf + (size_t)(2 * r) * D + 4 * lane + 256 * i);
                const u32x2 y1 = *(const u32x2*)(ybuf + (size_t)(2 * r + 1) * D + 4 * lane + 256 * i);
                v[i][0] += __uint_as_float(y0[0] << 16) + __uint_as_float(y1[0] << 16);
                v[i][1] += __uint_as_float(y0[0] & 0xffff0000u) + __uint_as_float(y1[0] & 0xffff0000u);
                v[i][2] += __uint_as_float(y0[1] << 16) + __uint_as_float(y1[1] << 16);
                v[i][3] += __uint_as_float(y0[1] & 0xffff0000u) + __uint_as_float(y1[1] & 0xffff0000u);
            }
            const float inv = row_inv_rms(v);
#pragma unroll
            for (int i = 0; i < 4; ++i) {
                const f32x4 gg = *(const f32x4*)(p.fin_g + 4 * lane + 256 * i);
                *(f32x4*)(p.out + (size_t)r * D + 4 * lane + 256 * i) = (f32x4){v[i][0] * inv * gg[0], v[i][1] * inv * gg[1], v[i][2] * inv * gg[2], v[i][3] * inv * gg[3]};
            }
        }
    }
}

extern "C" void kernel_launch(void* const* d_in, const int* in_sizes, int n_in, void* d_out, int out_size, void* d_ws, size_t ws_size, hipStream_t stream) {
    (void)in_sizes; (void)n_in; (void)out_size;
    static int grid_blocks = 0;
    if (!grid_blocks) {
        int dev = 0, cus = 0, per_cu = 0;
        hipGetDevice(&dev);
        hipDeviceGetAttribute(&cus, hipDeviceAttributeMultiprocessorCount, dev);
        hipOccupancyMaxActiveBlocksPerMultiprocessor(&per_cu, fwd_megakernel, NTHREADS, 0);
        if (per_cu > 1) per_cu = 1;
        if (per_cu < 1) per_cu = 1;
        grid_blocks = cus * per_cu;
    }
    if (ws_size < WS_NEED) { fprintf(stderr, "workspace too small: %zu < %zu\n", ws_size, (size_t)WS_NEED); return; }
    Params p{};
    p.x = (const float*)d_in[0]; p.mix_g = (const float*)d_in[1]; p.w_in = (const float*)d_in[2]; p.w_fo = (const float*)d_in[3];
    p.A_re = (const float*)d_in[4]; p.A_im = (const float*)d_in[5]; p.log_dt = (const float*)d_in[6];
    p.B_re = (const float*)d_in[7]; p.B_im = (const float*)d_in[8]; p.C_re = (const float*)d_in[9]; p.C_im = (const float*)d_in[10];
    p.ssm_D = (const float*)d_in[11]; p.w_glu = (const float*)d_in[12]; p.w_sso = (const float*)d_in[13]; p.w_out = (const float*)d_in[14];
    p.ffn_g = (const float*)d_in[15]; p.rg_w = (const float*)d_in[16]; p.rg_b = (const float*)d_in[17]; p.re_w = (const float*)d_in[18]; p.re_b = (const float*)d_in[19];
    p.e_gate = (const float*)d_in[20]; p.e_up = (const float*)d_in[21]; p.e_down = (const float*)d_in[22]; p.fin_g = (const float*)d_in[23];
    p.out = (float*)d_out; p.ws = (unsigned char*)d_ws;
    hipMemsetAsync((unsigned char*)d_ws + OFF_J + J_CNT, 0, 1024, stream);
    void* args[] = {&p};
    hipError_t e = hipLaunchCooperativeKernel((const void*)fwd_megakernel, dim3(grid_blocks), dim3(NTHREADS), args, 0, stream);
    if (e != hipSuccess) fprintf(stderr, "cooperative launch failed: %s (grid %d)\n", hipGetErrorString(e), grid_blocks);
}
```

```cpp
#include <hip/hip_runtime.h>
#include <hip/hip_cooperative_groups.h>
#include <cstdio>
namespace cg = cooperative_groups;

typedef unsigned short bf16_t;
typedef short bf16x8 __attribute__((ext_vector_type(8)));
typedef float f32x4 __attribute__((ext_vector_type(4)));
typedef float f32x2 __attribute__((ext_vector_type(2)));
typedef unsigned u32x2 __attribute__((ext_vector_type(2)));
typedef unsigned u32x4 __attribute__((ext_vector_type(4)));

constexpr int D = 1024, BATCH = 4, SEQ = 4096, T = BATCH * SEQ;
constexpr int FW = 512, SW = 512, INW = 3072;
constexpr int SG = 32, SC = 16, SN = 64;
constexpr int LC = 32, NCH = SEQ / LC, ROWS = T / LC;
constexpr int UK = 768;
constexpr int NE = 64, DE = 512, LISTCAP = 16384;
constexpr int NTHREADS = 512, NWAVES = 8;
constexpr int SMEM_BYTES = 136 * 1024;

constexpr size_t MiB = 1024 * 1024;
constexpr size_t OFF_WGT  = 0;
constexpr size_t OFF_WUT  = OFF_WGT + 64 * MiB;
constexpr size_t OFF_WDT  = OFF_WUT + 64 * MiB;
constexpr size_t OFF_WINT = OFF_WDT + 64 * MiB;
constexpr size_t OFF_WPT  = OFF_WINT + 6 * MiB;
constexpr size_t OFF_WGLT = OFF_WPT + 2 * MiB;
constexpr size_t OFF_WSOT = OFF_WGLT + MiB / 2;
constexpr size_t OFF_WOT  = OFF_WSOT + 1 * MiB;
constexpr size_t OFF_BTS  = OFF_WOT + 2 * MiB;
constexpr size_t OFF_BTY  = OFF_BTS + 8 * MiB;
constexpr size_t OFF_C    = OFF_BTY + 24 * MiB;
constexpr size_t OFF_D    = OFF_C + 64 * MiB;
constexpr size_t OFF_E    = OFF_D + 32 * MiB;
constexpr size_t OFF_FG   = OFF_E + 64 * MiB;
constexpr size_t OFF_H    = OFF_FG + 32 * MiB;
constexpr size_t OFF_I    = OFF_H + 24 * MiB;
constexpr size_t OFF_J    = OFF_I + 32 * MiB;
constexpr size_t J_CNT   = 0;
constexpr size_t J_AL    = 1024;
constexpr size_t J_WGTS  = 64 * 1024;
constexpr size_t J_LIST  = 256 * 1024;
constexpr size_t WS_NEED = OFF_J + 5 * MiB;

struct Params {
    const float* x; const float* mix_g; const float* w_in; const float* w_fo;
    const float* A_re; const float* A_im; const float* log_dt; const float* B_re; const float* B_im; const float* C_re; const float* C_im;
    const float* ssm_D; const float* w_glu; const float* w_sso; const float* w_out; const float* ffn_g;
    const float* rg_w; const float* rg_b; const float* re_w; const float* re_b;
    const float* e_gate; const float* e_up; const float* e_down; const float* fin_g;
    float* out; unsigned char* ws;
};

__device__ __forceinline__ bf16_t f2bf(float f) { unsigned u = __float_as_uint(f); u += 0x7FFFu + ((u >> 16) & 1u); return (bf16_t)(u >> 16); }
__device__ __forceinline__ float bf2f(bf16_t b) { return __uint_as_float(((unsigned)b) << 16); }
__device__ __forceinline__ unsigned pack2(float lo, float hi) { return (unsigned)f2bf(lo) | ((unsigned)f2bf(hi) << 16); }
__device__ __forceinline__ float sigmoidf_(float v) { return 1.0f / (1.0f + __expf(-v)); }
__device__ __forceinline__ float gelu_tanh(float v) { const float u = 0.7978845608028654f * (v + 0.044715f * v * v * v); return 0.5f * v * (1.0f + tanhf(u)); }
__device__ __forceinline__ float wave_sum(float v) {
#pragma unroll
    for (int o = 32; o > 0; o >>= 1) v += __shfl_xor(v, o);
    return v;
}

template <class AF, class BF, class EF>
__device__ __forceinline__ void wave_gemm_64x64(const int K, const AF& arow, const BF& brow, const EF& epi, const int m0, const int n0, const int lane) {
    const int fr = lane & 15, fq = lane >> 4;
    const bf16_t* ap0 = arow(m0 + fr) + fq * 8;
    const bf16_t* ap1 = arow(m0 + 16 + fr) + fq * 8;
    const bf16_t* ap2 = arow(m0 + 32 + fr) + fq * 8;
    const bf16_t* ap3 = arow(m0 + 48 + fr) + fq * 8;
    const bf16_t* bp0 = brow(n0 + fr) + fq * 8;
    const bf16_t* bp1 = brow(n0 + 16 + fr) + fq * 8;
    const bf16_t* bp2 = brow(n0 + 32 + fr) + fq * 8;
    const bf16_t* bp3 = brow(n0 + 48 + fr) + fq * 8;
    f32x4 acc[4][4];
#pragma unroll
    for (int i = 0; i < 4; ++i)
#pragma unroll
        for (int j = 0; j < 4; ++j) acc[i][j] = (f32x4){0.f, 0.f, 0.f, 0.f};
    bf16x8 a[4], b[4];
    a[0] = *(const bf16x8*)ap0; a[1] = *(const bf16x8*)ap1; a[2] = *(const bf16x8*)ap2; a[3] = *(const bf16x8*)ap3;
    b[0] = *(const bf16x8*)bp0; b[1] = *(const bf16x8*)bp1; b[2] = *(const bf16x8*)bp2; b[3] = *(const bf16x8*)bp3;
    for (int k = 0; k < K; k += 32) {
        bf16x8 an[4], bn[4];
        const int kn = (k + 32 < K) ? k + 32 : k;
        an[0] = *(const bf16x8*)(ap0 + kn); an[1] = *(const bf16x8*)(ap1 + kn); an[2] = *(const bf16x8*)(ap2 + kn); an[3] = *(const bf16x8*)(ap3 + kn);
        bn[0] = *(const bf16x8*)(bp0 + kn); bn[1] = *(const bf16x8*)(bp1 + kn); bn[2] = *(const bf16x8*)(bp2 + kn); bn[3] = *(const bf16x8*)(bp3 + kn);
#pragma unroll
        for (int i = 0; i < 4; ++i)
#pragma unroll
            for (int j = 0; j < 4; ++j) acc[i][j] = __builtin_amdgcn_mfma_f32_16x16x32_bf16(b[j], a[i], acc[i][j], 0, 0, 0);
#pragma unroll
        for (int i = 0; i < 4; ++i) { a[i] = an[i]; b[i] = bn[i]; }
    }
#pragma unroll
    for (int i = 0; i < 4; ++i)
#pragma unroll
        for (int j = 0; j < 4; ++j) epi(m0 + 16 * i + fr, n0 + 16 * j + 4 * fq, acc[i][j]);
}

template <class AF, class BF, class EF>
__device__ __forceinline__ void gemm_phase_simple(const int M, const int N, const int K, const AF& arow, const BF& brow, const EF& epi) {
    const int lane = threadIdx.x & 63, wid = threadIdx.x >> 6;
    const int gw = blockIdx.x * NWAVES + wid, nw = gridDim.x * NWAVES;
    const int tn = N / 64, tiles = (M / 64) * tn;
    for (int t = gw; t < tiles; t += nw) wave_gemm_64x64(K, arow, brow, epi, (t / tn) * 64, (t % tn) * 64, lane);
}


#define LAS __attribute__((address_space(3)))
namespace g8 {
constexpr int BM = 256, BK = 64, HALF = 128, HTB = HALF * BK * 2, STAGE_BYTES = 8 * HTB;
__device__ __forceinline__ int lds_byte(int r, int c) { const int st = (r >> 4) * 2 + (c >> 5), rr = r & 15, cc = c & 31, ob = rr * 64 + cc * 2; return st * 1024 + (ob ^ (((ob >> 9) & 1) << 5)); }
__device__ __forceinline__ void stage_rc(int b, int& R, int& C) { const int st = b / 1024, sb = b % 1024, swz = sb ^ (((sb >> 9) & 1) << 5); R = (st >> 1) * 16 + swz / 64; C = (st & 1) * 32 + (swz % 64) / 2; }
struct Unit { const char* A; const char* B; int r0, c0, aux, nrows; };

struct DenseSched {
    const char* A; const char* B; size_t gsA, gsB; int lda, ldb, nM, nN, nG, G, c;
    __device__ __forceinline__ bool next(int i, Unit& u) const {
        const int nMt = nM * nG, nwg = nMt * nN;
        const long L = (long)i * G + c; if (L >= nwg) return false;
        int wgid = (int)L; { const int q = nwg / 8, r = nwg % 8, xcd = wgid % 8, off = wgid / 8; wgid = (xcd < r ? xcd * (q + 1) : r * (q + 1) + (xcd - r) * q) + off; }
        const int nig = 8 * nN, gid = wgid / nig, fm = gid * 8, gsz = (nMt - fm) < 8 ? (nMt - fm) : 8;
        const int pmt = fm + ((wgid % nig) % gsz), pn = (wgid % nig) / gsz;
        const int g = pmt / nM, pm = pmt % nM;
        u.A = A + (size_t)g * gsA + (size_t)pm * BM * lda * 2; u.B = B + (size_t)g * gsB + (size_t)pn * BM * ldb * 2;
        u.r0 = pm * BM; u.c0 = pn * BM; u.aux = g; u.nrows = BM; return true;
    }
};

template <class Sched, class Epi>
__device__ __forceinline__ void gemm_phase(LAS unsigned char* lds, const int K, const int lda, const int ldb, const Sched& S, const Epi& E) {
    const int tid = threadIdx.x, wid = __builtin_amdgcn_readfirstlane(tid >> 6), lane = tid & 63, wr = wid >> 2, wc = wid & 3, fr = lane & 15, fq = lane >> 4;
    const int nt = K / BK;
    unsigned voffA[2], voffB[2];
#pragma unroll
    for (int i = 0; i < 2; ++i) { int R, C; stage_rc(tid * 16 + i * 8192, R, C); voffA[i] = (unsigned)(R * lda + C) * 2u; voffB[i] = (unsigned)(R * ldb + C) * 2u; }
    const size_t kstep = (size_t)(BK * 2);
    const size_t hstepA = (size_t)HALF * lda * 2, hstepB = (size_t)HALF * ldb * 2;
    const unsigned ldsw = (unsigned)wid * 1024u;
    const int aoff = lds_byte(wr * 64 + fr, fq * 8), boff = lds_byte(wc * 32 + fr, fq * 8);
#define G8_SA(b, h) (((b) * 2 + (h)) * HTB)
#define G8_SB(b, h) ((4 + (b) * 2 + (h)) * HTB)
#define G8_STAGE(bufoff, gbase, voff) do { _Pragma("unroll") for (int _i = 0; _i < 2; ++_i) \
        __builtin_amdgcn_global_load_lds((const unsigned*)((const char*)(gbase) + (voff)[_i]), (LAS unsigned*)(lds + (bufoff) + ldsw + _i * 8192), 16, 0, 0); } while (0)
#define G8_LDA(dst, b, h) do { _Pragma("unroll") for (int m = 0; m < 4; ++m) _Pragma("unroll") for (int k = 0; k < 2; ++k) dst[m][k] = *(const LAS bf16x8*)(lds + G8_SA(b, h) + aoff + m * 2048 + k * 1024); } while (0)
#define G8_LDB(dst, b, h) do { _Pragma("unroll") for (int n = 0; n < 2; ++n) _Pragma("unroll") for (int k = 0; k < 2; ++k) dst[n][k] = *(const LAS bf16x8*)(lds + G8_SB(b, h) + boff + n * 2048 + k * 1024); } while (0)
#define G8_MMA(ai, bj, At, Bt) do { __builtin_amdgcn_s_setprio(1); _Pragma("unroll") for (int m = 0; m < 4; ++m) _Pragma("unroll") for (int n = 0; n < 2; ++n) _Pragma("unroll") for (int k = 0; k < 2; ++k) \
        acc[ai][bj][m][n] = __builtin_amdgcn_mfma_f32_16x16x32_bf16(Bt[n][k], At[m][k], acc[ai][bj][m][n], 0, 0, 0); __builtin_amdgcn_s_setprio(0); } while (0)
#define G8_WAIT_V(n) asm volatile("s_waitcnt vmcnt(" #n ")" ::: "memory")
#define G8_WAIT_L(n) asm volatile("s_waitcnt lgkmcnt(" #n ")" ::: "memory")
#define G8_BAR __builtin_amdgcn_s_barrier()
#define G8_SCHED __builtin_amdgcn_sched_barrier(0)
    Unit cur, nxt; int ui = 0;
    if (!S.next(0, cur)) return;
    f32x4 acc[2][2][4][2];
#pragma unroll
    for (int a = 0; a < 2; ++a)
#pragma unroll
        for (int b = 0; b < 2; ++b)
#pragma unroll
            for (int m = 0; m < 4; ++m)
#pragma unroll
                for (int n = 0; n < 2; ++n) acc[a][b][m][n] = (f32x4){0.f, 0.f, 0.f, 0.f};
    bf16x8 At[4][2], B0[2][2], B1[2][2];
    const char* cA = cur.A; const char* cB = cur.B;
    G8_STAGE(G8_SB(0, 0), cB, voffB); G8_STAGE(G8_SA(0, 0), cA, voffA); G8_STAGE(G8_SB(0, 1), cB + hstepB, voffB); G8_STAGE(G8_SA(0, 1), cA + hstepA, voffA);
    if (wr == 1) G8_BAR;
    G8_WAIT_V(4); G8_BAR;
    G8_STAGE(G8_SB(1, 0), cB + kstep, voffB); G8_STAGE(G8_SA(1, 0), cA + kstep, voffA); G8_STAGE(G8_SB(1, 1), cB + hstepB + kstep, voffB);
    G8_WAIT_V(6); G8_BAR;
    for (;;) {
        const bool has_next = S.next(ui + 1, nxt);
        const char* nA = has_next ? nxt.A : cA; const char* nB = has_next ? nxt.B : cB;
        for (int t = 0; t < nt; t += 2) {
            const bool last = (t == nt - 2);
            const char* a1 = cA + (size_t)(t + 1) * kstep;
            const char* a2 = last ? nA : cA + (size_t)(t + 2) * kstep; const char* b2 = last ? nB : cB + (size_t)(t + 2) * kstep;
            const char* a3 = a2 + kstep; const char* b3 = b2 + kstep;
            G8_LDB(B0, 0, 0); G8_SCHED; G8_LDA(At, 0, 0); G8_STAGE(G8_SA(1, 1), a1 + hstepA, voffA);
            G8_WAIT_L(8); G8_BAR; G8_WAIT_L(0); G8_MMA(0, 0, At, B0); G8_BAR; G8_SCHED;
            G8_LDB(B1, 0, 1); G8_STAGE(G8_SB(0, 0), b2, voffB);
            G8_BAR; G8_WAIT_L(0); G8_MMA(0, 1, At, B1); G8_BAR;
            G8_LDA(At, 0, 1); G8_STAGE(G8_SA(0, 0), a2, voffA);
            G8_BAR; G8_WAIT_L(0); G8_MMA(1, 0, At, B0); G8_BAR; G8_SCHED;
            G8_STAGE(G8_SB(0, 1), b2 + hstepB, voffB);
            G8_WAIT_V(6); G8_BAR; G8_MMA(1, 1, At, B1); G8_BAR;
            G8_LDB(B0, 1, 0); G8_SCHED; G8_LDA(At, 1, 0); G8_STAGE(G8_SA(0, 1), a2 + hstepA, voffA);
            G8_WAIT_L(8); G8_BAR; G8_WAIT_L(0); G8_MMA(0, 0, At, B0); G8_BAR; G8_SCHED;
            G8_LDB(B1, 1, 1); G8_STAGE(G8_SB(1, 0), b3, voffB);
            G8_BAR; G8_WAIT_L(0); G8_MMA(0, 1, At, B1); G8_BAR;
            G8_LDA(At, 1, 1); G8_STAGE(G8_SA(1, 0), a3, voffA);
            G8_BAR; G8_WAIT_L(0); G8_MMA(1, 0, At, B0); G8_BAR; G8_SCHED;
            G8_STAGE(G8_SB(1, 1), b3 + hstepB, voffB);
            G8_WAIT_V(6); G8_BAR; G8_MMA(1, 1, At, B1); G8_BAR;
        }
#pragma unroll
        for (int ai = 0; ai < 2; ++ai)
#pragma unroll
            for (int m = 0; m < 4; ++m)
#pragma unroll
                for (int bj = 0; bj < 2; ++bj)
#pragma unroll
                    for (int n = 0; n < 2; ++n) E(cur, ai * HALF + wr * 64 + m * 16 + fr, bj * HALF + wc * 32 + n * 16 + 4 * fq, acc[ai][bj][m][n]);
        if (!has_next) break;
#pragma unroll
        for (int a = 0; a < 2; ++a)
#pragma unroll
            for (int b = 0; b < 2; ++b)
#pragma unroll
                for (int m = 0; m < 4; ++m)
#pragma unroll
                    for (int n = 0; n < 2; ++n) acc[a][b][m][n] = (f32x4){0.f, 0.f, 0.f, 0.f};
        cur = nxt; cA = nA; cB = nB; ++ui;
    }
    G8_WAIT_V(0);
    if (wr == 0) G8_BAR;
    G8_BAR;
#undef G8_SA
#undef G8_SB
#undef G8_STAGE
#undef G8_LDA
#undef G8_LDB
#undef G8_MMA
#undef G8_WAIT_V
#undef G8_WAIT_L
#undef G8_BAR
#undef G8_SCHED
}
}

template <class Epi>
__device__ __forceinline__ void dense_gemm(LAS unsigned char* lds, const bf16_t* A, const bf16_t* B, int M, int N, int K, int lda, int ldb, int nG, size_t gsA, size_t gsB, const Epi& E) {
    g8::DenseSched S; S.A = (const char*)A; S.B = (const char*)B; S.gsA = gsA * 2; S.gsB = gsB * 2; S.lda = lda; S.ldb = ldb; S.nM = M / 256; S.nN = N / 256; S.nG = nG; S.G = gridDim.x; S.c = blockIdx.x;
    g8::gemm_phase(lds, K, lda, ldb, S, E);
}

__device__ void transpose_cvt_tile(const float* __restrict__ src, bf16_t* __restrict__ dst, const int K, const int N, const int tile, float* lds) {
    const int tn = N / 64, k0 = (tile / tn) * 64, n0 = (tile % tn) * 64;
    const int t = threadIdx.x;
    __syncthreads();
#pragma unroll
    for (int i = 0; i < 2; ++i) {
        const int kk = (t >> 4) + 32 * i, c4 = (t & 15) * 4;
        const f32x4 v = *(const f32x4*)(src + (size_t)(k0 + kk) * N + n0 + c4);
        lds[kk * 65 + c4 + 0] = v[0]; lds[kk * 65 + c4 + 1] = v[1]; lds[kk * 65 + c4 + 2] = v[2]; lds[kk * 65 + c4 + 3] = v[3];
    }
    __syncthreads();
    {
        const int n = t >> 3, kc = (t & 7) * 8;
        u32x4 w;
        w[0] = pack2(lds[(kc + 0) * 65 + n], lds[(kc + 1) * 65 + n]);
        w[1] = pack2(lds[(kc + 2) * 65 + n], lds[(kc + 3) * 65 + n]);
        w[2] = pack2(lds[(kc + 4) * 65 + n], lds[(kc + 5) * 65 + n]);
        w[3] = pack2(lds[(kc + 6) * 65 + n], lds[(kc + 7) * 65 + n]);
        *(u32x4*)(dst + (size_t)(n0 + n) * K + k0 + kc) = w;
    }
}

__device__ void ssm_prep_group(const Params& p, const int g, float* lds) {
    f32x2* pw = (f32x2*)lds;
    f32x2* bb = pw + 4224;
    f32x2* cm = bb + 2048;
    float* kt = (float*)(cm + 2048);
    const int t = threadIdx.x;
    bf16_t* BtS = (bf16_t*)(p.ws + OFF_BTS) + (size_t)g * 256 * 512;
    bf16_t* BtY = (bf16_t*)(p.ws + OFF_BTY) + (size_t)g * 512 * UK;
    f32x2* aL = (f32x2*)(p.ws + OFF_J + J_AL);
    __syncthreads();
    for (int i = t; i < 2 * 64 * 33; i += NTHREADS) {
        const int dir = i / (64 * 33), n = (i / 33) % 64, tau = i % 33;
        const double are = (double)p.A_re[(dir * SG + g) * SN + n], aim = (double)p.A_im[(dir * SG + g) * SN + n];
        const double dt = exp((double)p.log_dt[dir * SG + g]);
        const double mag = exp(are * dt * tau), ang = aim * dt * tau;
        pw[i] = (f32x2){(float)(mag * cos(ang)), (float)(mag * sin(ang))};
        if (tau == 32) aL[(dir * SG + g) * SN + n] = pw[i];
    }
    for (int i = t; i < 2 * 64 * 16; i += NTHREADS) {
        const int dir = i / 1024, n = (i / 16) % 64, ci = i % 16;
        const double are = (double)p.A_re[(dir * SG + g) * SN + n], aim = (double)p.A_im[(dir * SG + g) * SN + n];
        const double dt = exp((double)p.log_dt[dir * SG + g]);
        const double mag = exp(are * dt), ang = aim * dt;
        const double nr = mag * cos(ang) - 1.0, ni = mag * sin(ang);
        const double den = are * are + aim * aim;
        const double qr = (nr * are + ni * aim) / den, qi = (ni * are - nr * aim) / den;
        const size_t bi = ((size_t)(dir * SG + g) * SN + n) * SC + ci;
        const double br = (double)p.B_re[bi], bim = (double)p.B_im[bi];
        bb[i] = (f32x2){(float)(qr * br - qi * bim), (float)(qr * bim + qi * br)};
    }
    for (int i = t; i < 2 * 16 * 64; i += NTHREADS) {
        const int dir = i / 1024, co = (i / 64) % 16, n = i % 64;
        const size_t ci_ = ((size_t)(dir * SG + g) * SC + co) * SN + n;
        cm[i] = (f32x2){p.C_re[ci_], p.C_im[ci_]};
    }
    __syncthreads();
    for (int i = t; i < 2 * 32 * 256; i += NTHREADS) {
        const int dir = i / 8192, tau = (i / 256) % 32, co = (i / 16) % 16, ci = i % 16;
        float s = 0.f;
        for (int n = 0; n < 64; ++n) {
            const f32x2 c = cm[(dir * 16 + co) * 64 + n], a = pw[(dir * 64 + n) * 33 + tau], b = bb[(dir * 64 + n) * 16 + ci];
            const float zr = c[0] * a[0] - c[1] * a[1], zi = c[0] * a[1] + c[1] * a[0];
            s += zr * b[0] - zi * b[1];
        }
        kt[i] = s;
    }
    __syncthreads();
    for (int i = t; i < 256 * 512; i += NTHREADS) {
        const int row = i / 512, col = i % 512;
        const int dir = row / 128, n = (row / 2) % 64, ri = row & 1, s = col / 16, ci = col % 16;
        const int tau = dir == 0 ? (LC - 1 - s) : s;
        const f32x2 a = pw[(dir * 64 + n) * 33 + tau], b = bb[(dir * 64 + n) * 16 + ci];
        const float v = ri == 0 ? (a[0] * b[0] - a[1] * b[1]) : (a[0] * b[1] + a[1] * b[0]);
        BtS[i] = f2bf(v);
    }
    for (int i = t; i < 512 * UK; i += NTHREADS) {
        const int row = i / UK, kk = i % UK;
        const int tt = row / 16, co = row % 16;
        float v;
        if (kk < 512) {
            const int s = kk / 16, ci = kk % 16;
            if (s < tt) v = kt[((0 * 32 + (tt - s)) * 16 + co) * 16 + ci];
            else if (s > tt) v = kt[((1 * 32 + (s - tt)) * 16 + co) * 16 + ci];
            else v = kt[((0 * 32 + 0) * 16 + co) * 16 + ci] + kt[((1 * 32 + 0) * 16 + co) * 16 + ci];
        } else {
            const int q = kk - 512, dir = q / 128, n = (q / 2) % 64, ri = q & 1;
            const int tau = dir == 0 ? (tt + 1) : (LC - tt);
            const f32x2 c = cm[(dir * 16 + co) * 64 + n], a = pw[(dir * 64 + n) * 33 + tau];
            const float zr = c[0] * a[0] - c[1] * a[1], zi = c[0] * a[1] + c[1] * a[0];
            v = ri == 0 ? zr : -zi;
        }
        BtY[i] = f2bf(v);
    }
}

__device__ __forceinline__ void load_row(const float* row, const int lane, f32x4 (&v)[4]) {
#pragma unroll
    for (int i = 0; i < 4; ++i) v[i] = *(const f32x4*)(row + 4 * lane + 256 * i);
}
__device__ __forceinline__ float row_inv_rms(const f32x4 (&v)[4]) {
    float s = 0.f;
#pragma unroll
    for (int i = 0; i < 4; ++i) s += v[i][0] * v[i][0] + v[i][1] * v[i][1] + v[i][2] * v[i][2] + v[i][3] * v[i][3];
    s = wave_sum(s);
    return 1.0f / sqrtf(s * (1.0f / 1024.0f) + 1e-6f);
}

__global__ void __launch_bounds__(NTHREADS) fwd_megakernel(const Params p) {
    cg::grid_group grid = cg::this_grid();
    __shared__ __attribute__((aligned(16))) unsigned char smem[SMEM_BYTES];
    const int tid = threadIdx.x, lane = tid & 63, wid = tid >> 6;
    const int gw = blockIdx.x * NWAVES + wid, nw = gridDim.x * NWAVES;
    const int gt = blockIdx.x * NTHREADS + tid, nt = gridDim.x * NTHREADS;
    unsigned char* ws = p.ws;
    bf16_t* WgT = (bf16_t*)(ws + OFF_WGT); bf16_t* WuT = (bf16_t*)(ws + OFF_WUT); bf16_t* WdT = (bf16_t*)(ws + OFF_WDT);
    bf16_t* WinT = (bf16_t*)(ws + OFF_WINT); bf16_t* WpT = (bf16_t*)(ws + OFF_WPT); bf16_t* WglT = (bf16_t*)(ws + OFF_WGLT);
    bf16_t* WsoT = (bf16_t*)(ws + OFF_WSOT); bf16_t* WoT = (bf16_t*)(ws + OFF_WOT);
    bf16_t* BtS = (bf16_t*)(ws + OFF_BTS); bf16_t* BtY = (bf16_t*)(ws + OFF_BTY);
    bf16_t* DT = (bf16_t*)(ws + OFF_C); bf16_t* ybuf = (bf16_t*)(ws + OFF_C);
    bf16_t* hn = (bf16_t*)(ws + OFF_D); bf16_t* Fb = (bf16_t*)(ws + OFF_D); bf16_t* hn2 = (bf16_t*)(ws + OFF_D);
    bf16_t* gates = (bf16_t*)(ws + OFF_E); bf16_t* act = (bf16_t*)(ws + OFF_E);
    bf16_t* uT = (bf16_t*)(ws + OFF_FG); float* Sst = (float*)(ws + OFF_FG + 16 * MiB); bf16_t* m1 = (bf16_t*)(ws + OFF_FG);
    bf16_t* Ucomb = (bf16_t*)(ws + OFF_H);
    bf16_t* yg = (bf16_t*)(ws + OFF_I); bf16_t* ys2 = (bf16_t*)(ws + OFF_I + 16 * MiB);
    unsigned* cnt = (unsigned*)(ws + OFF_J + J_CNT);
    const f32x2* aL = (const f32x2*)(ws + OFF_J + J_AL);
    float* wgts = (float*)(ws + OFF_J + J_WGTS);
    int* list = (int*)(ws + OFF_J + J_LIST);
    float* x2 = p.out;
    LAS unsigned char* ldsp = (LAS unsigned char*)smem;

    {
        float* ldsf = (float*)smem;
        const int T_WIN = 16 * 48, T_GLU = 8 * 8, T_SSO = 8 * 16, T_WO = 16 * 16, T_EG = 64 * 16 * 8, T_ED = 64 * 8 * 16;
        const int total = T_WIN + T_GLU + T_SSO + T_WO + 2 * T_EG + T_ED;
        for (int j = blockIdx.x; j < total; j += gridDim.x) {
            int q = j;
            if (q < T_WIN) { transpose_cvt_tile(p.w_in, WinT, 1024, 3072, q, ldsf); continue; } q -= T_WIN;
            if (q < T_GLU) { transpose_cvt_tile(p.w_glu, WglT, 512, 512, q, ldsf); continue; } q -= T_GLU;
            if (q < T_SSO) { transpose_cvt_tile(p.w_sso, WsoT, 512, 1024, q, ldsf); continue; } q -= T_SSO;
            if (q < T_WO) { transpose_cvt_tile(p.w_out, WoT, 1024, 1024, q, ldsf); continue; } q -= T_WO;
            if (q < T_EG) { const int e = q / 128; transpose_cvt_tile(p.e_gate + (size_t)e * 1024 * 512, WgT + (size_t)e * 512 * 1024, 1024, 512, q % 128, ldsf); continue; } q -= T_EG;
            if (q < T_EG) { const int e = q / 128; transpose_cvt_tile(p.e_up + (size_t)e * 1024 * 512, WuT + (size_t)e * 512 * 1024, 1024, 512, q % 128, ldsf); continue; } q -= T_EG;
            { const int e = q / 128; transpose_cvt_tile(p.e_down + (size_t)e * 512 * 1024, WdT + (size_t)e * 1024 * 512, 512, 1024, q % 128, ldsf); }
        }
        __syncthreads();
        for (int i = gt; i < 1024 * 1024; i += nt) {
            const int d = i & 1023, kk = i >> 10;
            const int g = kk >> 8, c = (kk >> 1) & 127, ri = kk & 1;
            float s = 0.f;
            for (int m = 0; m < 128; ++m) {
                const float ang = (float)((c * m) & 127) * (1.0f / 64.0f);
                const float f = ri ? sinpif(ang) : cospif(ang);
                s += f * p.w_fo[(size_t)(g * 128 + m) * 1024 + d];
            }
            WpT[(size_t)d * 1024 + kk] = f2bf(s * 0.08838834764831845f);
        }
        for (int i = gt; i < 8192 * 512; i += nt) {
            const int row = i >> 9, l0 = (i & 511) * 8;
            const int k = row >> 1, ri = row & 1;
            unsigned w[4];
#pragma unroll
            for (int j = 0; j < 4; ++j) {
                float v[2];
#pragma unroll
                for (int h = 0; h < 2; ++h) {
                    const int l = l0 + 2 * j + h;
                    const float ang = (float)((k * l) & 4095) * (1.0f / 2048.0f);
                    v[h] = (ri ? -sinpif(ang) : cospif(ang)) * (1.0f / 64.0f);
                }
                w[j] = pack2(v[0], v[1]);
            }
            *(u32x4*)(DT + (size_t)row * 4096 + l0) = (u32x4){w[0], w[1], w[2], w[3]};
        }
        for (int g = blockIdx.x; g < SG; g += gridDim.x) ssm_prep_group(p, g, (float*)smem);
        for (int r = gw; r < T; r += nw) {
            f32x4 v[4]; load_row(p.x + (size_t)r * D, lane, v);
            const float inv = row_inv_rms(v);
#pragma unroll
            for (int i = 0; i < 4; ++i) {
                const f32x4 gg = *(const f32x4*)(p.mix_g + 4 * lane + 256 * i);
                u32x2 w; w[0] = pack2(v[i][0] * inv * gg[0], v[i][1] * inv * gg[1]); w[1] = pack2(v[i][2] * inv * gg[2], v[i][3] * inv * gg[3]);
                *(u32x2*)(hn + (size_t)r * D + 4 * lane + 256 * i) = w;
            }
        }
    }
    grid.sync();
    {
        auto arow = [=](int m) { return hn + (size_t)m * D; };
        auto brow = [=](int n) { return WinT + (size_t)n * D; };
        auto epi = [=](int m, int n4, f32x4 v) {
            if (n4 < FW) {
                const int b = m >> 12, l = m & 4095;
#pragma unroll
                for (int j = 0; j < 4; ++j) uT[((size_t)(b * FW + n4 + j) << 12) + l] = f2bf(v[j]);
            } else if (n4 < FW + SW) {
                const int ch = n4 - FW, g = ch >> 4, ci = ch & 15;
                u32x2 w; w[0] = pack2(v[0], v[1]); w[1] = pack2(v[2], v[3]);
                *(u32x2*)(Ucomb + ((size_t)(g * ROWS + (m >> 5))) * UK + (m & 31) * 16 + ci) = w;
            } else {
                u32x2 w; w[0] = pack2(sigmoidf_(v[0]), sigmoidf_(v[1])); w[1] = pack2(sigmoidf_(v[2]), sigmoidf_(v[3]));
                *(u32x2*)(gates + (size_t)m * 2048 + (n4 - 1024)) = w;
            }
        };
        auto E = [=](const g8::Unit& u, int rl, int cl, f32x4 v) { epi(u.r0 + rl, u.c0 + cl, v); };
        dense_gemm(ldsp, hn, WinT, T, INW, D, D, D, 1, 0, 0, E);
    }
    grid.sync();
    {
        {
            auto E = [=](const g8::Unit& u, int rl, int cl, f32x4 v) {
                const int b = u.aux, m = u.r0 + rl, k0 = (u.c0 + cl) >> 1;
                *(unsigned*)(Fb + ((size_t)(b * SEQ + k0)) * 1024 + 2 * m) = pack2(v[0], v[1]);
                *(unsigned*)(Fb + ((size_t)(b * SEQ + k0 + 1)) * 1024 + 2 * m) = pack2(v[2], v[3]);
            };
            dense_gemm(ldsp, uT, DT, FW, 2 * SEQ, SEQ, SEQ, SEQ, BATCH, (size_t)FW * SEQ, 0, E);
        }
        for (int g = 0; g < SG; ++g) {
            auto arow = [=](int m) { return Ucomb + (size_t)(g * ROWS + m) * UK; };
            auto brow = [=](int n) { return BtS + (size_t)(g * 256 + n) * 512; };
            auto epi = [=](int m, int n4, f32x4 v) { *(f32x4*)(Sst + (size_t)(g * ROWS + m) * 256 + n4) = v; };
            gemm_phase_simple(ROWS, 256, 512, arow, brow, epi);
        }
    }
    grid.sync();
    {
        for (int i = gt; i < BATCH * SG * 2 * SN; i += nt) {
            const int n = i & 63, dir = (i >> 6) & 1, g = (i >> 7) & 31, b = i >> 12;
            const f32x2 a = aL[(dir * SG + g) * SN + n];
            float hr = 0.f, hi = 0.f;
            for (int jj = 0; jj < NCH; ++jj) {
                const int j = dir == 0 ? jj : (NCH - 1 - jj);
                const size_t row = (size_t)g * ROWS + b * NCH + j;
                *(unsigned*)(Ucomb + row * UK + 512 + (dir * 64 + n) * 2) = pack2(hr, hi);
                const f32x2 s = *(const f32x2*)(Sst + row * 256 + (dir * 64 + n) * 2);
                const float nr = a[0] * hr - a[1] * hi + s[0], ni = a[0] * hi + a[1] * hr + s[1];
                hr = nr; hi = ni;
            }
        }
    }
    grid.sync();
    {
        for (int g = 0; g < SG; ++g) {
            auto arow = [=](int m) { return Ucomb + (size_t)(g * ROWS + m) * UK; };
            auto brow = [=](int n) { return BtY + (size_t)(g * 512 + n) * UK; };
            auto epi = [=](int m, int n4, f32x4 v) {
                const int tt = n4 >> 4, co = n4 & 15, tok = m * LC + tt, ch = g * 16 + co;
                const u32x2 uu = *(const u32x2*)(Ucomb + (size_t)(g * ROWS + m) * UK + n4);
                const f32x4 dd = *(const f32x4*)(p.ssm_D + ch);
                const float u0 = __uint_as_float(uu[0] << 16), u1 = __uint_as_float(uu[0] & 0xffff0000u), u2 = __uint_as_float(uu[1] << 16), u3 = __uint_as_float(uu[1] & 0xffff0000u);
                u32x2 w; w[0] = pack2(gelu_tanh(v[0] + dd[0] * u0), gelu_tanh(v[1] + dd[1] * u1)); w[1] = pack2(gelu_tanh(v[2] + dd[2] * u2), gelu_tanh(v[3] + dd[3] * u3));
                *(u32x2*)(yg + (size_t)tok * SW + ch) = w;
            };
            gemm_phase_simple(ROWS, 512, UK, arow, brow, epi);
        }
        {
            auto arow = [=](int m) { return Fb + (size_t)m * 1024; };
            auto brow = [=](int n) { return WpT + (size_t)n * 1024; };
            auto epi = [=](int m, int n4, f32x4 v) {
                const u32x2 gg = *(const u32x2*)(gates + (size_t)m * 2048 + n4);
                const float g0 = __uint_as_float(gg[0] << 16), g1 = __uint_as_float(gg[0] & 0xffff0000u), g2 = __uint_as_float(gg[1] << 16), g3 = __uint_as_float(gg[1] & 0xffff0000u);
                u32x2 w; w[0] = pack2(g0 * v[0], g1 * v[1]); w[1] = pack2(g2 * v[2], g3 * v[3]);
                *(u32x2*)(m1 + (size_t)m * D + n4) = w;
            };
            auto E = [=](const g8::Unit& u, int rl, int cl, f32x4 v) { epi(u.r0 + rl, u.c0 + cl, v); };
            dense_gemm(ldsp, Fb, WpT, T, D, 1024, 1024, 1024, 1, 0, 0, E);
        }
    }
    grid.sync();
    {
        auto arow = [=](int m) { return yg + (size_t)m * SW; };
        auto brow = [=](int n) { return WglT + (size_t)n * SW; };
        auto epi = [=](int m, int n4, f32x4 v) {
            const u32x2 yy = *(const u32x2*)(yg + (size_t)m * SW + n4);
            const float y0 = __uint_as_float(yy[0] << 16), y1 = __uint_as_float(yy[0] & 0xffff0000u), y2 = __uint_as_float(yy[1] << 16), y3 = __uint_as_float(yy[1] & 0xffff0000u);
            u32x2 w; w[0] = pack2(y0 * sigmoidf_(v[0]), y1 * sigmoidf_(v[1])); w[1] = pack2(y2 * sigmoidf_(v[2]), y3 * sigmoidf_(v[3]));
            *(u32x2*)(ys2 + (size_t)m * SW + n4) = w;
        };
        auto E = [=](const g8::Unit& u, int rl, int cl, f32x4 v) { epi(u.r0 + rl, u.c0 + cl, v); };
        dense_gemm(ldsp, yg, WglT, T, SW, SW, SW, SW, 1, 0, 0, E);
    }
    grid.sync();
    {
        auto arow = [=](int m) { return ys2 + (size_t)m * SW; };
        auto brow = [=](int n) { return WsoT + (size_t)n * SW; };
        auto epi = [=](int m, int n4, f32x4 v) {
            const u32x2 gg = *(const u32x2*)(gates + (size_t)m * 2048 + 1024 + n4);
            const u32x2 mm = *(const u32x2*)(m1 + (size_t)m * D + n4);
            const float g0 = __uint_as_float(gg[0] << 16), g1 = __uint_as_float(gg[0] & 0xffff0000u), g2 = __uint_as_float(gg[1] << 16), g3 = __uint_as_float(gg[1] & 0xffff0000u);
            const float a0 = __uint_as_float(mm[0] << 16), a1 = __uint_as_float(mm[0] & 0xffff0000u), a2 = __uint_as_float(mm[1] << 16), a3 = __uint_as_float(mm[1] & 0xffff0000u);
            u32x2 w; w[0] = pack2(a0 + g0 * v[0], a1 + g1 * v[1]); w[1] = pack2(a2 + g2 * v[2], a3 + g3 * v[3]);
            *(u32x2*)(m1 + (size_t)m * D + n4) = w;
        };
        auto E = [=](const g8::Unit& u, int rl, int cl, f32x4 v) { epi(u.r0 + rl, u.c0 + cl, v); };
        dense_gemm(ldsp, ys2, WsoT, T, D, SW, SW, SW, 1, 0, 0, E);
    }
    grid.sync();
    {
        auto arow = [=](int m) { return m1 + (size_t)m * D; };
        auto brow = [=](int n) { return WoT + (size_t)n * D; };
        auto epi = [=](int m, int n4, f32x4 v) {
            const f32x4 xx = *(const f32x4*)(p.x + (size_t)m * D + n4);
            *(f32x4*)(x2 + (size_t)m * D + n4) = xx + v;
        };
        auto E = [=](const g8::Unit& u, int rl, int cl, f32x4 v) { epi(u.r0 + rl, u.c0 + cl, v); };
        dense_gemm(ldsp, m1, WoT, T, D, D, D, D, 1, 0, 0, E);
    }
    grid.sync();
    {
        float* rows = (float*)smem + (size_t)wid * 4 * 1024;
        for (int t0 = gw * 4; t0 < T; t0 += nw * 4) {
#pragma unroll
            for (int q = 0; q < 4; ++q) {
                const int r = t0 + q;
                f32x4 v[4]; load_row(x2 + (size_t)r * D, lane, v);
                const float inv = row_inv_rms(v);
#pragma unroll
                for (int i = 0; i < 4; ++i) {
                    const f32x4 gg = *(const f32x4*)(p.ffn_g + 4 * lane + 256 * i);
                    const f32x4 h = (f32x4){v[i][0] * inv * gg[0], v[i][1] * inv * gg[1], v[i][2] * inv * gg[2], v[i][3] * inv * gg[3]};
                    *(f32x4*)(rows + q * 1024 + 4 * lane + 256 * i) = h;
                    u32x2 w; w[0] = pack2(h[0], h[1]); w[1] = pack2(h[2], h[3]);
                    *(u32x2*)(hn2 + (size_t)r * D + 4 * lane + 256 * i) = w;
                }
            }
            asm volatile("s_waitcnt lgkmcnt(0)" ::: "memory");
            float ae[4] = {0.f, 0.f, 0.f, 0.f}, ag[4] = {0.f, 0.f, 0.f, 0.f};
            const int gl = lane & 7;
            for (int k = 0; k < 1024; ++k) {
                const float we = p.re_w[k * 64 + lane], wg = p.rg_w[k * 8 + gl];
#pragma unroll
                for (int q = 0; q < 4; ++q) { const float h = rows[q * 1024 + k]; ae[q] += h * we; ag[q] += h * wg; }
            }
            const float be = p.re_b[lane], bg = p.rg_b[gl];
#pragma unroll
            for (int q = 0; q < 4; ++q) {
                const float le = ae[q] + be, lg = ag[q] + bg;
                float gv[8];
#pragma unroll
                for (int i = 0; i < 8; ++i) gv[i] = __shfl(lg, i);
                int gi = 0; float gm = gv[0];
#pragma unroll
                for (int i = 1; i < 8; ++i) if (gv[i] > gm) { gm = gv[i]; gi = i; }
                float den = 0.f;
#pragma unroll
                for (int i = 0; i < 8; ++i) den += __expf(gv[i] - gm);
                const float pg = 1.0f / den;
                float ev[8];
#pragma unroll
                for (int i = 0; i < 8; ++i) ev[i] = __shfl(le, gi * 8 + i);
                int i1 = 0; float v1 = ev[0];
#pragma unroll
                for (int i = 1; i < 8; ++i) if (ev[i] > v1) { v1 = ev[i]; i1 = i; }
                int i2 = -1; float v2 = -3.0e38f;
#pragma unroll
                for (int i = 0; i < 8; ++i) if (i != i1 && ev[i] > v2) { v2 = ev[i]; i2 = i; }
                const float e2 = __expf(v2 - v1), w1 = pg / (1.0f + e2), w2 = pg * e2 / (1.0f + e2);
                if (lane == 0) {
                    const int tok = t0 + q, ex1 = gi * 8 + i1, ex2 = gi * 8 + i2;
                    const unsigned p1 = atomicAdd(&cnt[ex1], 1u), p2 = atomicAdd(&cnt[ex2], 1u);
                    list[ex1 * LISTCAP + p1] = tok * 2; list[ex2 * LISTCAP + p2] = tok * 2 + 1;
                    wgts[tok * 2] = w1; wgts[tok * 2 + 1] = w2;
                }
            }
        }
    }
    grid.sync();
    int* sh_i = (int*)smem;
    {
        __syncthreads();
        if (tid == 0) {
            int ro = 0, tp = 0;
            for (int e = 0; e < NE; ++e) { const int c = (int)cnt[e]; sh_i[e] = c; sh_i[64 + e] = ro; sh_i[128 + e] = tp; ro += c; tp += (c + 63) / 64; }
            sh_i[128 + NE] = tp;
        }
        __syncthreads();
        const int total_m = sh_i[128 + NE];
        for (int t = gw; t < total_m * 16; t += nw) {
            const int mt_g = t >> 4, ntile = t & 15;
            int e = 0;
            while (sh_i[128 + e + 1] <= mt_g) ++e;
            const int mt = mt_g - sh_i[128 + e], c = sh_i[e], ro = sh_i[64 + e];
            const int* le = list + e * LISTCAP;
            auto arow = [=](int m) { const int idx = m < c ? m : c - 1; return hn2 + (size_t)(le[idx] >> 1) * D; };
            auto brow = [=](int n) { return ((n & 1) ? WuT : WgT) + ((size_t)e * DE + (n >> 1)) * D; };
            auto epi = [=](int m, int n4, f32x4 v) {
                if (m < c) {
                    const float s0 = v[0] * sigmoidf_(v[0]) * v[1], s1 = v[2] * sigmoidf_(v[2]) * v[3];
                    *(unsigned*)(act + (size_t)(ro + m) * DE + (n4 >> 1)) = pack2(s0, s1);
                }
            };
            wave_gemm_64x64(D, arow, brow, epi, mt * 64, ntile * 64, lane);
        }
    }
    grid.sync();
    {
        const int total_m = sh_i[128 + NE];
        for (int t = gw; t < total_m * 16; t += nw) {
            const int mt_g = t >> 4, ntile = t & 15;
            int e = 0;
            while (sh_i[128 + e + 1] <= mt_g) ++e;
            const int mt = mt_g - sh_i[128 + e], c = sh_i[e], ro = sh_i[64 + e];
            const int* le = list + e * LISTCAP;
            auto arow = [=](int m) { const int idx = m < c ? m : c - 1; return act + (size_t)(ro + idx) * DE; };
            auto brow = [=](int n) { return WdT + ((size_t)e * D + n) * DE; };
            auto epi = [=](int m, int n4, f32x4 v) {
                if (m < c) {
                    const int as = le[m]; const float w = wgts[as];
                    u32x2 o; o[0] = pack2(w * v[0], w * v[1]); o[1] = pack2(w * v[2], w * v[3]);
                    *(u32x2*)(ybuf + (size_t)as * D + n4) = o;
                }
            };
            wave_gemm_64x64(DE, arow, brow, epi, mt * 64, ntile * 64, lane);
        }
    }
    grid.sync();
    {
        for (int r = gw; r < T; r += nw) {
            f32x4 v[4]; load_row(x2 + (size_t)r * D, lane, v);
#pragma unroll
            for (int i = 0; i < 4; ++i) {
                const u32x2 y0 = *(const u32x2*)(ybuf + (size_t)(2 * r) * D + 4 * lane + 256 * i);
                const u32x2 y1 = *(const u32x2*)(ybuf + (size_t)(2 * r + 1) * D + 4 * lane + 256 * i);
                v[i][0] += __uint_as_float(y0[0] << 16) + __uint_as_float(y1[0] << 16);
                v[i][1] += __uint_as_float(y0[0] & 0xffff0000u) + __uint_as_float(y1[0] & 0xffff0000u);
                v[i][2] += __uint_as_float(y0[1] << 16) + __uint_as_float(y1[1] << 16);
                v[i][3] += __uint_as_float(y0[1] & 0xffff0000u) + __uint_as_float(y1[1] & 0xffff0000u);
            }
            const float inv = row_inv_rms(v);
#pragma unroll
            for (int i = 0; i < 4; ++i) {
                const f32x4 gg = *(const f32x4*)(p.fin_g + 4 * lane + 256 * i);
                *(f32x4*)(p.out + (size_t)r * D + 4 * lane + 256 * i) = (f32x4){v[i][0] * inv * gg[0], v[i][1] * inv * gg[1], v[i][2] * inv * gg[2], v[i][3] * inv * gg[3]};
            }
        }
    }
}

extern "C" void kernel_launch(void* const* d_in, const int* in_sizes, int n_in, void* d_out, int out_size, void* d_ws, size_t ws_size, hipStream_t stream) {
    (void)in_sizes; (void)n_in; (void)out_size;
    static int grid_blocks = 0;
    if (!grid_blocks) {
        int dev = 0, cus = 0, per_cu = 0;
        hipGetDevice(&dev);
        hipDeviceGetAttribute(&cus, hipDeviceAttributeMultiprocessorCount, dev);
        hipOccupancyMaxActiveBlocksPerMultiprocessor(&per_cu, fwd_megakernel, NTHREADS, 0);
        if (per_cu > 1) per_cu = 1;
        if (per_cu < 1) per_cu = 1;
        grid_blocks = cus * per_cu;
    }
    if (ws_size < WS_NEED) { fprintf(stderr, "workspace too small: %zu < %zu\n", ws_size, (size_t)WS_NEED); return; }
    Params p{};
    p.x = (const float*)d_in[0]; p.mix_g = (const float*)d_in[1]; p.w_in = (const float*)d_in[2]; p.w_fo = (const float*)d_in[3];
    p.A_re = (const float*)d_in[4]; p.A_im = (const float*)d_in[5]; p.log_dt = (const float*)d_in[6];
    p.B_re = (const float*)d_in[7]; p.B_im = (const float*)d_in[8]; p.C_re = (const float*)d_in[9]; p.C_im = (const float*)d_in[10];
    p.ssm_D = (const float*)d_in[11]; p.w_glu = (const float*)d_in[12]; p.w_sso = (const float*)d_in[13]; p.w_out = (const float*)d_in[14];
    p.ffn_g = (const float*)d_in[15]; p.rg_w = (const float*)d_in[16]; p.rg_b = (const float*)d_in[17]; p.re_w = (const float*)d_in[18]; p.re_b = (const float*)d_in[19];
    p.e_gate = (const float*)d_in[20]; p.e_up = (const float*)d_in[21]; p.e_down = (const float*)d_in[22]; p.fin_g = (const float*)d_in[23];
    p.out = (float*)d_out; p.ws = (unsigned char*)d_ws;
    hipMemsetAsync((unsigned char*)d_ws + OFF_J + J_CNT, 0, 1024, stream);
    void* args[] = {&p};
    hipError_t e = hipLaunchCooperativeKernel((const void*)fwd_megakernel, dim3(grid_blocks), dim3(NTHREADS), args, 0, stream);
    if (e != hipSuccess) fprintf(stderr, "cooperative launch failed: %s (grid %d)\n", hipGetErrorString(e), grid_blocks);
}
```

```cpp
#include <hip/hip_runtime.h>
#include <cstdio>

typedef unsigned short bf16_t;
typedef short bf16x8 __attribute__((ext_vector_type(8)));
typedef float f32x4 __attribute__((ext_vector_type(4)));
typedef float f32x2 __attribute__((ext_vector_type(2)));
typedef unsigned u32x2 __attribute__((ext_vector_type(2)));
typedef unsigned u32x4 __attribute__((ext_vector_type(4)));

constexpr int D = 1024, BATCH = 4, SEQ = 4096, T = BATCH * SEQ;
constexpr int FW = 512, SW = 512, INW = 3072;
constexpr int SG = 32, SC = 16, SN = 64;
constexpr int LC = 32, NCH = SEQ / LC, ROWS = T / LC;
constexpr int UK = 768;
constexpr int NE = 64, DE = 512, LISTCAP = 16384;
constexpr int NTHREADS = 512, NWAVES = 8;
constexpr int SMEM_BYTES = 136 * 1024;

constexpr size_t MiB = 1024 * 1024;
constexpr size_t OFF_WGUT = 0;
constexpr size_t OFF_WDT  = OFF_WGUT + 128 * MiB;
constexpr size_t OFF_WINT = OFF_WDT + 64 * MiB;
constexpr size_t OFF_WPT  = OFF_WINT + 6 * MiB;
constexpr size_t OFF_WGLT = OFF_WPT + 2 * MiB;
constexpr size_t OFF_WSOT = OFF_WGLT + MiB / 2;
constexpr size_t OFF_WOT  = OFF_WSOT + 1 * MiB;
constexpr size_t OFF_BTS  = OFF_WOT + 2 * MiB;
constexpr size_t OFF_BTY  = OFF_BTS + 8 * MiB;
constexpr size_t OFF_C    = OFF_BTY + 24 * MiB;
constexpr size_t OFF_D    = OFF_C + 64 * MiB;
constexpr size_t OFF_E    = OFF_D + 32 * MiB;
constexpr size_t OFF_FG   = OFF_E + 64 * MiB;
constexpr size_t OFF_H    = OFF_FG + 32 * MiB;
constexpr size_t OFF_I    = OFF_H + 24 * MiB;
constexpr size_t OFF_J    = OFF_I + 32 * MiB;
constexpr size_t J_CNT   = 0;
constexpr size_t J_BAR   = 4096;
constexpr size_t J_ZERO_BYTES = 20480;
constexpr size_t J_AL    = 32768;
constexpr size_t J_WGTS  = 64 * 1024;
constexpr size_t J_LIST  = 256 * 1024;
constexpr size_t WS_NEED = OFF_J + 5 * MiB;
constexpr int BAR_LDS_OFF = SMEM_BYTES - 16;

struct Params {
    const float* x; const float* mix_g; const float* w_in; const float* w_fo;
    const float* A_re; const float* A_im; const float* log_dt; const float* B_re; const float* B_im; const float* C_re; const float* C_im;
    const float* ssm_D; const float* w_glu; const float* w_sso; const float* w_out; const float* ffn_g;
    const float* rg_w; const float* rg_b; const float* re_w; const float* re_b;
    const float* e_gate; const float* e_up; const float* e_down; const float* fin_g;
    float* out; unsigned char* ws;
};

__device__ __forceinline__ bf16_t f2bf(float f) { unsigned u = __float_as_uint(f); u += 0x7FFFu + ((u >> 16) & 1u); return (bf16_t)(u >> 16); }
__device__ __forceinline__ float bf2f(bf16_t b) { return __uint_as_float(((unsigned)b) << 16); }
__device__ __forceinline__ unsigned pack2(float lo, float hi) { return (unsigned)f2bf(lo) | ((unsigned)f2bf(hi) << 16); }
__device__ __forceinline__ float sigmoidf_(float v) { return 1.0f / (1.0f + __expf(-v)); }
__device__ __forceinline__ float gelu_tanh(float v) { const float u = 1.5957691216057308f * (v + 0.044715f * v * v * v); return v / (1.0f + __expf(-u)); }
__device__ __forceinline__ float wave_sum(float v) {
#pragma unroll
    for (int o = 32; o > 0; o >>= 1) v += __shfl_xor(v, o);
    return v;
}


#define LAS __attribute__((address_space(3)))
#define XB_TMO      128
#define XB_XCNT(j)  (256  + 64 * (j))
#define XB_XSUB(j)  (1280 + 64 * (j))
#define XB_XGEN(j)  (2304 + 64 * (j))
#define XB_TOP      3328
#define XB_TOPGEN   3392
#define XCD_BAR_WORDS 3456
#define XB_SPIN_CAP (1u << 18)
__device__ __forceinline__ unsigned xb_ld(unsigned* p)              { return __hip_atomic_load(p, __ATOMIC_RELAXED, __HIP_MEMORY_SCOPE_AGENT); }
__device__ __forceinline__ unsigned xb_add(unsigned* p, unsigned v) { return __hip_atomic_fetch_add(p, v, __ATOMIC_RELAXED, __HIP_MEMORY_SCOPE_AGENT); }
__device__ __forceinline__ unsigned xb_xcc_id() { return (unsigned)__builtin_amdgcn_s_getreg((3 << 11) | 20) & 0xFu; }
#define XB_SPIN(cond, bar) do { unsigned _sp = 0; while (cond) { __builtin_amdgcn_s_sleep(1); \
    if ((++_sp & 255u) == 0u) { if (xb_ld(&(bar)[XB_TMO])) break; if (_sp > XB_SPIN_CAP) { atomicAdd(&(bar)[XB_TMO], 1u); break; } } } } while (0)
struct XcdBarrier { unsigned* bar; unsigned x; volatile LAS unsigned* st; };
__device__ __forceinline__ XcdBarrier xcd_barrier_post(unsigned* bar, volatile LAS unsigned* st) {
    XcdBarrier b; b.bar = bar; b.x = xb_xcc_id(); b.st = st;
    if (threadIdx.x == 0) (void)xb_add(&bar[XB_XCNT(b.x)], 1u);
    return b;
}
__device__ __forceinline__ void xcd_barrier_complete(unsigned* bar, unsigned x, unsigned& nloc, unsigned& nx) {
    const unsigned G = gridDim.x * gridDim.y * gridDim.z;
    unsigned sum, cnt, mine, sp = 0u;
    for (;;) {
        sum = 0u; cnt = 0u; mine = 0u;
#pragma unroll
        for (unsigned j = 0; j < 16; ++j) { const unsigned c = xb_ld(&bar[XB_XCNT(j)]); sum += c; cnt += (c > 0u) ? 1u : 0u; mine = (j == x) ? c : mine; }
        if (sum == G) break;
        __builtin_amdgcn_s_sleep(1);
        if ((++sp & 255u) == 0u) { if (xb_ld(&bar[XB_TMO])) break; if (sp > XB_SPIN_CAP) { atomicAdd(&bar[XB_TMO], 1u); break; } }
    }
    nloc = mine > 0u ? mine : 1u; nx = cnt > 0u ? cnt : 1u;
}
__device__ __forceinline__ void xcd_barrier(const XcdBarrier& b) {
    asm volatile("s_waitcnt vmcnt(0)" ::: "memory");
    __syncthreads();
    if (threadIdx.x == 0) {
        unsigned* bar = b.bar;
        __builtin_amdgcn_s_waitcnt(0);
        unsigned nloc = b.st[0], nx = b.st[1];
        if (nloc == 0u) { xcd_barrier_complete(bar, b.x, nloc, nx); b.st[0] = nloc; b.st[1] = nx; }
        const unsigned old = xb_add(&bar[XB_XSUB(b.x)], 1u);
        const unsigned gen = old / nloc;
        if (old + 1u == (gen + 1u) * nloc) {
            __builtin_amdgcn_fence(__ATOMIC_RELEASE, "agent");
            asm volatile("s_waitcnt vmcnt(0)" ::: "memory");
            const unsigned og = xb_add(&bar[XB_TOP], 1u);
            const unsigned tg = og / nx;
            if (og + 1u == (tg + 1u) * nx) xb_add(&bar[XB_TOPGEN], 1u);
            else XB_SPIN(xb_ld(&bar[XB_TOPGEN]) == tg, bar);
            __builtin_amdgcn_fence(__ATOMIC_ACQUIRE, "agent");
            xb_add(&bar[XB_XGEN(b.x)], 1u);
            asm volatile("s_waitcnt vmcnt(0)" ::: "memory");
        } else {
            XB_SPIN(xb_ld(&bar[XB_XGEN(b.x)]) == gen, bar);
            __builtin_amdgcn_fence(__ATOMIC_ACQUIRE, "agent");
            asm volatile("s_waitcnt vmcnt(0)" ::: "memory");
        }
    }
    __syncthreads();
}

template <class AF, class BF, class EF>
__device__ __forceinline__ void wave_gemm_64x64(const int K, const AF& arow, const BF& brow, const EF& epi, const int m0, const int n0, const int lane) {
    const int fr = lane & 15, fq = lane >> 4;
    const bf16_t* ap0 = arow(m0 + fr) + fq * 8;
    const bf16_t* ap1 = arow(m0 + 16 + fr) + fq * 8;
    const bf16_t* ap2 = arow(m0 + 32 + fr) + fq * 8;
    const bf16_t* ap3 = arow(m0 + 48 + fr) + fq * 8;
    const bf16_t* bp0 = brow(n0 + fr) + fq * 8;
    const bf16_t* bp1 = brow(n0 + 16 + fr) + fq * 8;
    const bf16_t* bp2 = brow(n0 + 32 + fr) + fq * 8;
    const bf16_t* bp3 = brow(n0 + 48 + fr) + fq * 8;
    f32x4 acc[4][4];
#pragma unroll
    for (int i = 0; i < 4; ++i)
#pragma unroll
        for (int j = 0; j < 4; ++j) acc[i][j] = (f32x4){0.f, 0.f, 0.f, 0.f};
    bf16x8 a[4], b[4];
    a[0] = *(const bf16x8*)ap0; a[1] = *(const bf16x8*)ap1; a[2] = *(const bf16x8*)ap2; a[3] = *(const bf16x8*)ap3;
    b[0] = *(const bf16x8*)bp0; b[1] = *(const bf16x8*)bp1; b[2] = *(const bf16x8*)bp2; b[3] = *(const bf16x8*)bp3;
    for (int k = 0; k < K; k += 32) {
        bf16x8 an[4], bn[4];
        const int kn = (k + 32 < K) ? k + 32 : k;
        an[0] = *(const bf16x8*)(ap0 + kn); an[1] = *(const bf16x8*)(ap1 + kn); an[2] = *(const bf16x8*)(ap2 + kn); an[3] = *(const bf16x8*)(ap3 + kn);
        bn[0] = *(const bf16x8*)(bp0 + kn); bn[1] = *(const bf16x8*)(bp1 + kn); bn[2] = *(const bf16x8*)(bp2 + kn); bn[3] = *(const bf16x8*)(bp3 + kn);
#pragma unroll
        for (int i = 0; i < 4; ++i)
#pragma unroll
            for (int j = 0; j < 4; ++j) acc[i][j] = __builtin_amdgcn_mfma_f32_16x16x32_bf16(b[j], a[i], acc[i][j], 0, 0, 0);
#pragma unroll
        for (int i = 0; i < 4; ++i) { a[i] = an[i]; b[i] = bn[i]; }
    }
#pragma unroll
    for (int i = 0; i < 4; ++i)
#pragma unroll
        for (int j = 0; j < 4; ++j) epi(m0 + 16 * i + fr, n0 + 16 * j + 4 * fq, acc[i][j]);
}

template <class AF, class BF, class EF>
__device__ __forceinline__ void gemm_phase_simple(const int M, const int N, const int K, const AF& arow, const BF& brow, const EF& epi) {
    const int lane = threadIdx.x & 63, wid = threadIdx.x >> 6;
    const int gw = blockIdx.x * NWAVES + wid, nw = gridDim.x * NWAVES;
    const int tn = N / 64, tiles = (M / 64) * tn;
    for (int t = gw; t < tiles; t += nw) wave_gemm_64x64(K, arow, brow, epi, (t / tn) * 64, (t % tn) * 64, lane);
}


namespace g8 {
constexpr int BM = 256, BK = 64, HALF = 128, HTB = HALF * BK * 2, STAGE_BYTES = 8 * HTB;
__device__ __forceinline__ int lds_byte(int r, int c) { const int st = (r >> 4) * 2 + (c >> 5), rr = r & 15, cc = c & 31, ob = rr * 64 + cc * 2; return st * 1024 + (ob ^ (((ob >> 9) & 1) << 5)); }
__device__ __forceinline__ void stage_rc(int b, int& R, int& C) { const int st = b / 1024, sb = b % 1024, swz = sb ^ (((sb >> 9) & 1) << 5); R = (st >> 1) * 16 + swz / 64; C = (st & 1) * 32 + (swz % 64) / 2; }
struct Unit { const char* A; const char* B; int r0, c0, aux, nrows; };

struct DenseSched {
    const char* A; const char* B; size_t gsA, gsB; int lda, ldb, nM, nN, nG, G, c;
    __device__ __forceinline__ bool next(int i, Unit& u) const {
        const int nMt = nM * nG, nwg = nMt * nN;
        const long L = (long)i * G + c; if (L >= nwg) return false;
        int wgid = (int)L; { const int q = nwg / 8, r = nwg % 8, xcd = wgid % 8, off = wgid / 8; wgid = (xcd < r ? xcd * (q + 1) : r * (q + 1) + (xcd - r) * q) + off; }
        const int nig = 8 * nN, gid = wgid / nig, fm = gid * 8, gsz = (nMt - fm) < 8 ? (nMt - fm) : 8;
        const int pmt = fm + ((wgid % nig) % gsz), pn = (wgid % nig) / gsz;
        const int g = pmt / nM, pm = pmt % nM;
        u.A = A + (size_t)g * gsA + (size_t)pm * BM * lda * 2; u.B = B + (size_t)g * gsB + (size_t)pn * BM * ldb * 2;
        u.r0 = pm * BM; u.c0 = pn * BM; u.aux = g; u.nrows = BM; return true;
    }
};

template <class Sched, class Epi>
__device__ __forceinline__ void gemm_phase(LAS unsigned char* lds, const int K, const int lda, const int ldb, const Sched& S, const Epi& E) {
    const int tid = threadIdx.x, wid = __builtin_amdgcn_readfirstlane(tid >> 6), lane = tid & 63, wr = wid >> 2, wc = wid & 3, fr = lane & 15, fq = lane >> 4;
    const int nt = K / BK;
    unsigned voffA[2], voffB[2];
#pragma unroll
    for (int i = 0; i < 2; ++i) { int R, C; stage_rc(tid * 16 + i * 8192, R, C); voffA[i] = (unsigned)(R * lda + C) * 2u; voffB[i] = (unsigned)(R * ldb + C) * 2u; }
    const size_t kstep = (size_t)(BK * 2);
    const size_t hstepA = (size_t)HALF * lda * 2, hstepB = (size_t)HALF * ldb * 2;
    const unsigned ldsw = (unsigned)wid * 1024u;
    const int aoff = lds_byte(wr * 64 + fr, fq * 8), boff = lds_byte(wc * 32 + fr, fq * 8);
#define G8_SA(b, h) (((b) * 2 + (h)) * HTB)
#define G8_SB(b, h) ((4 + (b) * 2 + (h)) * HTB)
#define G8_STAGE(bufoff, gbase, voff) do { _Pragma("unroll") for (int _i = 0; _i < 2; ++_i) \
        __builtin_amdgcn_global_load_lds((const unsigned*)((const char*)(gbase) + (voff)[_i]), (LAS unsigned*)(lds + (bufoff) + ldsw + _i * 8192), 16, 0, 0); } while (0)
#define G8_LDA(dst, b, h) do { _Pragma("unroll") for (int m = 0; m < 4; ++m) _Pragma("unroll") for (int k = 0; k < 2; ++k) dst[m][k] = *(const LAS bf16x8*)(lds + G8_SA(b, h) + aoff + m * 2048 + k * 1024); } while (0)
#define G8_LDB(dst, b, h) do { _Pragma("unroll") for (int n = 0; n < 2; ++n) _Pragma("unroll") for (int k = 0; k < 2; ++k) dst[n][k] = *(const LAS bf16x8*)(lds + G8_SB(b, h) + boff + n * 2048 + k * 1024); } while (0)
#define G8_MMA(ai, bj, At, Bt) do { __builtin_amdgcn_s_setprio(1); _Pragma("unroll") for (int m = 0; m < 4; ++m) _Pragma("unroll") for (int n = 0; n < 2; ++n) _Pragma("unroll") for (int k = 0; k < 2; ++k) \
        acc[ai][bj][m][n] = __builtin_amdgcn_mfma_f32_16x16x32_bf16(Bt[n][k], At[m][k], acc[ai][bj][m][n], 0, 0, 0); __builtin_amdgcn_s_setprio(0); } while (0)
#define G8_WAIT_V(n) asm volatile("s_waitcnt vmcnt(" #n ")" ::: "memory")
#define G8_WAIT_L(n) asm volatile("s_waitcnt lgkmcnt(" #n ")" ::: "memory")
#define G8_BAR __builtin_amdgcn_s_barrier()
#define G8_SCHED __builtin_amdgcn_sched_barrier(0)
    Unit cur, nxt; int ui = 0;
    if (!S.next(0, cur)) return;
    f32x4 acc[2][2][4][2];
#pragma unroll
    for (int a = 0; a < 2; ++a)
#pragma unroll
        for (int b = 0; b < 2; ++b)
#pragma unroll
            for (int m = 0; m < 4; ++m)
#pragma unroll
                for (int n = 0; n < 2; ++n) acc[a][b][m][n] = (f32x4){0.f, 0.f, 0.f, 0.f};
    bf16x8 At[4][2], B0[2][2], B1[2][2];
    const char* cA = cur.A; const char* cB = cur.B;
    G8_STAGE(G8_SB(0, 0), cB, voffB); G8_STAGE(G8_SA(0, 0), cA, voffA); G8_STAGE(G8_SB(0, 1), cB + hstepB, voffB); G8_STAGE(G8_SA(0, 1), cA + hstepA, voffA);
    if (wr == 1) G8_BAR;
    G8_WAIT_V(4); G8_BAR;
    G8_STAGE(G8_SB(1, 0), cB + kstep, voffB); G8_STAGE(G8_SA(1, 0), cA + kstep, voffA); G8_STAGE(G8_SB(1, 1), cB + hstepB + kstep, voffB);
    G8_WAIT_V(6); G8_BAR;
    for (;;) {
        const bool has_next = S.next(ui + 1, nxt);
        const char* nA = has_next ? nxt.A : cA; const char* nB = has_next ? nxt.B : cB;
        for (int t = 0; t < nt; t += 2) {
            const bool last = (t == nt - 2);
            const char* a1 = cA + (size_t)(t + 1) * kstep;
            const char* a2 = last ? nA : cA + (size_t)(t + 2) * kstep; const char* b2 = last ? nB : cB + (size_t)(t + 2) * kstep;
            const char* a3 = a2 + kstep; const char* b3 = b2 + kstep;
            G8_LDB(B0, 0, 0); G8_SCHED; G8_LDA(At, 0, 0); G8_STAGE(G8_SA(1, 1), a1 + hstepA, voffA);
            G8_WAIT_L(8); G8_BAR; G8_WAIT_L(0); G8_MMA(0, 0, At, B0); G8_BAR; G8_SCHED;
            G8_LDB(B1, 0, 1); G8_STAGE(G8_SB(0, 0), b2, voffB);
            G8_BAR; G8_WAIT_L(0); G8_MMA(0, 1, At, B1); G8_BAR;
            G8_LDA(At, 0, 1); G8_STAGE(G8_SA(0, 0), a2, voffA);
            G8_BAR; G8_WAIT_L(0); G8_MMA(1, 0, At, B0); G8_BAR; G8_SCHED;
            G8_STAGE(G8_SB(0, 1), b2 + hstepB, voffB);
            G8_WAIT_V(6); G8_BAR; G8_MMA(1, 1, At, B1); G8_BAR;
            G8_LDB(B0, 1, 0); G8_SCHED; G8_LDA(At, 1, 0); G8_STAGE(G8_SA(0, 1), a2 + hstepA, voffA);
            G8_WAIT_L(8); G8_BAR; G8_WAIT_L(0); G8_MMA(0, 0, At, B0); G8_BAR; G8_SCHED;
            G8_LDB(B1, 1, 1); G8_STAGE(G8_SB(1, 0), b3, voffB);
            G8_BAR; G8_WAIT_L(0); G8_MMA(0, 1, At, B1); G8_BAR;
            G8_LDA(At, 1, 1); G8_STAGE(G8_SA(1, 0), a3, voffA);
            G8_BAR; G8_WAIT_L(0); G8_MMA(1, 0, At, B0); G8_BAR; G8_SCHED;
            G8_STAGE(G8_SB(1, 1), b3 + hstepB, voffB);
            G8_WAIT_V(6); G8_BAR; G8_MMA(1, 1, At, B1); G8_BAR;
        }
#pragma unroll
        for (int ai = 0; ai < 2; ++ai)
#pragma unroll
            for (int m = 0; m < 4; ++m)
#pragma unroll
                for (int bj = 0; bj < 2; ++bj)
#pragma unroll
                    for (int n = 0; n < 2; ++n) E(cur, ai * HALF + wr * 64 + m * 16 + fr, bj * HALF + wc * 32 + n * 16 + 4 * fq, acc[ai][bj][m][n]);
        if (!has_next) break;
#pragma unroll
        for (int a = 0; a < 2; ++a)
#pragma unroll
            for (int b = 0; b < 2; ++b)
#pragma unroll
                for (int m = 0; m < 4; ++m)
#pragma unroll
                    for (int n = 0; n < 2; ++n) acc[a][b][m][n] = (f32x4){0.f, 0.f, 0.f, 0.f};
        cur = nxt; cA = nA; cB = nB; ++ui;
    }
    G8_WAIT_V(0);
    if (wr == 0) G8_BAR;
    G8_BAR;
#undef G8_SA
#undef G8_SB
#undef G8_STAGE
#undef G8_LDA
#undef G8_LDB
#undef G8_MMA
#undef G8_WAIT_V
#undef G8_WAIT_L
#undef G8_BAR
#undef G8_SCHED
}
}

template <class Epi>
__device__ __forceinline__ void dense_gemm(LAS unsigned char* lds, const bf16_t* A, const bf16_t* B, int M, int N, int K, int lda, int ldb, int nG, size_t gsA, size_t gsB, const Epi& E) {
    g8::DenseSched S; S.A = (const char*)A; S.B = (const char*)B; S.gsA = gsA * 2; S.gsB = gsB * 2; S.lda = lda; S.ldb = ldb; S.nM = M / 256; S.nN = N / 256; S.nG = nG; S.G = gridDim.x; S.c = blockIdx.x;
    g8::gemm_phase(lds, K, lda, ldb, S, E);
}

__device__ __forceinline__ void transpose_cvt_tile_wave(const float* __restrict__ src, bf16_t* __restrict__ dst, const int K, const int N, const int nmul, const int nadd, const int tile, float* lds, const int lane) {
    const int tn = N / 64, k0 = (tile / tn) * 64, n0 = (tile % tn) * 64;
    f32x4 v[16];
#pragma unroll
    for (int i = 0; i < 16; ++i) v[i] = *(const f32x4*)(src + (size_t)(k0 + i * 4 + (lane >> 4)) * N + n0 + (lane & 15) * 4);
#pragma unroll
    for (int i = 0; i < 16; ++i) {
        const int kk = i * 4 + (lane >> 4), c4 = (lane & 15) * 4;
        lds[kk * 65 + c4 + 0] = v[i][0]; lds[kk * 65 + c4 + 1] = v[i][1]; lds[kk * 65 + c4 + 2] = v[i][2]; lds[kk * 65 + c4 + 3] = v[i][3];
    }
    asm volatile("s_waitcnt lgkmcnt(0)" ::: "memory");
    const int kc = (lane & 7) * 8;
#pragma unroll
    for (int it = 0; it < 8; ++it) {
        const int n = it * 8 + (lane >> 3);
        u32x4 w;
        w[0] = pack2(lds[(kc + 0) * 65 + n], lds[(kc + 1) * 65 + n]);
        w[1] = pack2(lds[(kc + 2) * 65 + n], lds[(kc + 3) * 65 + n]);
        w[2] = pack2(lds[(kc + 4) * 65 + n], lds[(kc + 5) * 65 + n]);
        w[3] = pack2(lds[(kc + 6) * 65 + n], lds[(kc + 7) * 65 + n]);
        *(u32x4*)(dst + (size_t)((n0 + n) * nmul + nadd) * K + k0 + kc) = w;
    }
    asm volatile("s_waitcnt lgkmcnt(0)" ::: "memory");
}

__device__ void ssm_prep_group(const Params& p, const int g, float* lds) {
    f32x2* pw = (f32x2*)lds;
    f32x2* bb = pw + 4224;
    f32x2* cm = bb + 2048;
    float* kt = (float*)(cm + 2048);
    const int t = threadIdx.x;
    bf16_t* BtS = (bf16_t*)(p.ws + OFF_BTS) + (size_t)g * 256 * 512;
    bf16_t* BtY = (bf16_t*)(p.ws + OFF_BTY) + (size_t)g * 512 * UK;
    f32x2* aL = (f32x2*)(p.ws + OFF_J + J_AL);
    __syncthreads();
    for (int i = t; i < 2 * 64 * 33; i += NTHREADS) {
        const int dir = i / (64 * 33), n = (i / 33) % 64, tau = i % 33;
        const double are = (double)p.A_re[(dir * SG + g) * SN + n], aim = (double)p.A_im[(dir * SG + g) * SN + n];
        const double dt = exp((double)p.log_dt[dir * SG + g]);
        const double mag = exp(are * dt * tau), ang = aim * dt * tau;
        pw[i] = (f32x2){(float)(mag * cos(ang)), (float)(mag * sin(ang))};
        if (tau == 32) aL[(dir * SG + g) * SN + n] = pw[i];
    }
    for (int i = t; i < 2 * 64 * 16; i += NTHREADS) {
        const int dir = i / 1024, n = (i / 16) % 64, ci = i % 16;
        const double are = (double)p.A_re[(dir * SG + g) * SN + n], aim = (double)p.A_im[(dir * SG + g) * SN + n];
        const double dt = exp((double)p.log_dt[dir * SG + g]);
        const double mag = exp(are * dt), ang = aim * dt;
        const double nr = mag * cos(ang) - 1.0, ni = mag * sin(ang);
        const double den = are * are + aim * aim;
        const double qr = (nr * are + ni * aim) / den, qi = (ni * are - nr * aim) / den;
        const size_t bi = ((size_t)(dir * SG + g) * SN + n) * SC + ci;
        const double br = (double)p.B_re[bi], bim = (double)p.B_im[bi];
        bb[i] = (f32x2){(float)(qr * br - qi * bim), (float)(qr * bim + qi * br)};
    }
    for (int i = t; i < 2 * 16 * 64; i += NTHREADS) {
        const int dir = i / 1024, co = (i / 64) % 16, n = i % 64;
        const size_t ci_ = ((size_t)(dir * SG + g) * SC + co) * SN + n;
        cm[i] = (f32x2){p.C_re[ci_], p.C_im[ci_]};
    }
    __syncthreads();
    for (int i = t; i < 2 * 32 * 256; i += NTHREADS) {
        const int dir = i / 8192, tau = (i / 256) % 32, co = (i / 16) % 16, ci = i % 16;
        float s = 0.f;
        for (int n = 0; n < 64; ++n) {
            const f32x2 c = cm[(dir * 16 + co) * 64 + n], a = pw[(dir * 64 + n) * 33 + tau], b = bb[(dir * 64 + n) * 16 + ci];
            const float zr = c[0] * a[0] - c[1] * a[1], zi = c[0] * a[1] + c[1] * a[0];
            s += zr * b[0] - zi * b[1];
        }
        kt[i] = s;
    }
    __syncthreads();
    for (int i = t; i < 256 * 512; i += NTHREADS) {
        const int row = i / 512, col = i % 512;
        const int dir = row / 128, n = (row / 2) % 64, ri = row & 1, s = col / 16, ci = col % 16;
        const int tau = dir == 0 ? (LC - 1 - s) : s;
        const f32x2 a = pw[(dir * 64 + n) * 33 + tau], b = bb[(dir * 64 + n) * 16 + ci];
        const float v = ri == 0 ? (a[0] * b[0] - a[1] * b[1]) : (a[0] * b[1] + a[1] * b[0]);
        BtS[i] = f2bf(v);
    }
    for (int i = t; i < 512 * UK; i += NTHREADS) {
        const int row = i / UK, kk = i % UK;
        const int tt = row / 16, co = row % 16;
        float v;
        if (kk < 512) {
            const int s = kk / 16, ci = kk % 16;
            if (s < tt) v = kt[((0 * 32 + (tt - s)) * 16 + co) * 16 + ci];
            else if (s > tt) v = kt[((1 * 32 + (s - tt)) * 16 + co) * 16 + ci];
            else v = kt[((0 * 32 + 0) * 16 + co) * 16 + ci] + kt[((1 * 32 + 0) * 16 + co) * 16 + ci];
        } else {
            const int q = kk - 512, dir = q / 128, n = (q / 2) % 64, ri = q & 1;
            const int tau = dir == 0 ? (tt + 1) : (LC - tt);
            const f32x2 c = cm[(dir * 16 + co) * 64 + n], a = pw[(dir * 64 + n) * 33 + tau];
            const float zr = c[0] * a[0] - c[1] * a[1], zi = c[0] * a[1] + c[1] * a[0];
            v = ri == 0 ? zr : -zi;
        }
        BtY[i] = f2bf(v);
    }
}

__device__ __forceinline__ void load_row(const float* row, const int lane, f32x4 (&v)[4]) {
#pragma unroll
    for (int i = 0; i < 4; ++i) v[i] = *(const f32x4*)(row + 4 * lane + 256 * i);
}
__device__ __forceinline__ float row_inv_rms(const f32x4 (&v)[4]) {
    float s = 0.f;
#pragma unroll
    for (int i = 0; i < 4; ++i) s += v[i][0] * v[i][0] + v[i][1] * v[i][1] + v[i][2] * v[i][2] + v[i][3] * v[i][3];
    s = wave_sum(s);
    return 1.0f / sqrtf(s * (1.0f / 1024.0f) + 1e-6f);
}

__global__ void __launch_bounds__(NTHREADS) fwd_megakernel(const Params p) {
    __shared__ __attribute__((aligned(16))) unsigned char smem[SMEM_BYTES];
    const int tid = threadIdx.x, lane = tid & 63, wid = tid >> 6;
    const int gw = blockIdx.x * NWAVES + wid, nw = gridDim.x * NWAVES;
    const int gt = blockIdx.x * NTHREADS + tid, nt = gridDim.x * NTHREADS;
    unsigned char* ws = p.ws;
    bf16_t* WguT = (bf16_t*)(ws + OFF_WGUT); bf16_t* WdT = (bf16_t*)(ws + OFF_WDT);
    bf16_t* WinT = (bf16_t*)(ws + OFF_WINT); bf16_t* WpT = (bf16_t*)(ws + OFF_WPT); bf16_t* WglT = (bf16_t*)(ws + OFF_WGLT);
    bf16_t* WsoT = (bf16_t*)(ws + OFF_WSOT); bf16_t* WoT = (bf16_t*)(ws + OFF_WOT);
    bf16_t* BtS = (bf16_t*)(ws + OFF_BTS); bf16_t* BtY = (bf16_t*)(ws + OFF_BTY);
    bf16_t* DT = (bf16_t*)(ws + OFF_C); bf16_t* ybuf = (bf16_t*)(ws + OFF_C);
    bf16_t* hn = (bf16_t*)(ws + OFF_D); bf16_t* Fb = (bf16_t*)(ws + OFF_D); bf16_t* hn2 = (bf16_t*)(ws + OFF_D);
    bf16_t* gates = (bf16_t*)(ws + OFF_E); bf16_t* act = (bf16_t*)(ws + OFF_E);
    bf16_t* uT = (bf16_t*)(ws + OFF_FG); float* Sst = (float*)(ws + OFF_FG + 16 * MiB); bf16_t* m1 = (bf16_t*)(ws + OFF_FG);
    bf16_t* Ucomb = (bf16_t*)(ws + OFF_H);
    bf16_t* yg = (bf16_t*)(ws + OFF_I); bf16_t* ys2 = (bf16_t*)(ws + OFF_I + 16 * MiB);
    unsigned* cnt = (unsigned*)(ws + OFF_J + J_CNT);
    const f32x2* aL = (const f32x2*)(ws + OFF_J + J_AL);
    float* wgts = (float*)(ws + OFF_J + J_WGTS);
    int* list = (int*)(ws + OFF_J + J_LIST);
    float* x2 = p.out;
    LAS unsigned char* ldsp = (LAS unsigned char*)smem;
    if (tid == 0) { ((volatile LAS unsigned*)(ldsp + BAR_LDS_OFF))[0] = 0u; ((volatile LAS unsigned*)(ldsp + BAR_LDS_OFF))[1] = 0u; }
    __syncthreads();
    const XcdBarrier bar = xcd_barrier_post((unsigned*)(ws + OFF_J + J_BAR), (volatile LAS unsigned*)(ldsp + BAR_LDS_OFF));
#define GRID_SYNC() xcd_barrier(bar)

    {
        {
            float* ldsw = (float*)smem + (size_t)wid * (64 * 65);
            const int T_WIN = 16 * 48, T_GLU = 8 * 8, T_SSO = 8 * 16, T_WO = 16 * 16, T_EG = 64 * 16 * 8, T_ED = 64 * 8 * 16;
            const int total = T_WIN + T_GLU + T_SSO + T_WO + 2 * T_EG + T_ED;
            for (int j = gw; j < total; j += nw) {
                int q = j;
                if (q < T_WIN) { transpose_cvt_tile_wave(p.w_in, WinT, 1024, 3072, 1, 0, q, ldsw, lane); continue; } q -= T_WIN;
                if (q < T_GLU) { transpose_cvt_tile_wave(p.w_glu, WglT, 512, 512, 1, 0, q, ldsw, lane); continue; } q -= T_GLU;
                if (q < T_SSO) { transpose_cvt_tile_wave(p.w_sso, WsoT, 512, 1024, 1, 0, q, ldsw, lane); continue; } q -= T_SSO;
                if (q < T_WO) { transpose_cvt_tile_wave(p.w_out, WoT, 1024, 1024, 1, 0, q, ldsw, lane); continue; } q -= T_WO;
                if (q < T_EG) { const int e = q / 128; transpose_cvt_tile_wave(p.e_gate + (size_t)e * 1024 * 512, WguT + (size_t)e * 1024 * 1024, 1024, 512, 2, 0, q % 128, ldsw, lane); continue; } q -= T_EG;
                if (q < T_EG) { const int e = q / 128; transpose_cvt_tile_wave(p.e_up + (size_t)e * 1024 * 512, WguT + (size_t)e * 1024 * 1024, 1024, 512, 2, 1, q % 128, ldsw, lane); continue; } q -= T_EG;
                { const int e = q / 128; transpose_cvt_tile_wave(p.e_down + (size_t)e * 512 * 1024, WdT + (size_t)e * 1024 * 512, 512, 1024, 1, 0, q % 128, ldsw, lane); }
            }
        }
        __syncthreads();
        for (int i = gt; i < 1024 * 1024; i += nt) {
            const int d = i & 1023, kk = i >> 10;
            const int g = kk >> 8, c = (kk >> 1) & 127, ri = kk & 1;
            float s = 0.f;
            for (int m = 0; m < 128; ++m) {
                const float ang = (float)((c * m) & 127) * (1.0f / 64.0f);
                const float f = ri ? sinpif(ang) : cospif(ang);
                s += f * p.w_fo[(size_t)(g * 128 + m) * 1024 + d];
            }
            WpT[(size_t)d * 1024 + kk] = f2bf(s * 0.08838834764831845f);
        }
        for (int i = gt; i < 8192 * 512; i += nt) {
            const int row = i >> 9, l0 = (i & 511) * 8;
            const int k = row >> 1, ri = row & 1;
            unsigned w[4];
#pragma unroll
            for (int j = 0; j < 4; ++j) {
                float v[2];
#pragma unroll
                for (int h = 0; h < 2; ++h) {
                    const int l = l0 + 2 * j + h;
                    const float ang = (float)((k * l) & 4095) * (1.0f / 2048.0f);
                    v[h] = (ri ? -sinpif(ang) : cospif(ang)) * (1.0f / 64.0f);
                }
                w[j] = pack2(v[0], v[1]);
            }
            *(u32x4*)(DT + (size_t)row * 4096 + l0) = (u32x4){w[0], w[1], w[2], w[3]};
        }
        for (int g = blockIdx.x; g < SG; g += gridDim.x) ssm_prep_group(p, g, (float*)smem);
        for (int r = gw; r < T; r += nw) {
            f32x4 v[4]; load_row(p.x + (size_t)r * D, lane, v);
            const float inv = row_inv_rms(v);
#pragma unroll
            for (int i = 0; i < 4; ++i) {
                const f32x4 gg = *(const f32x4*)(p.mix_g + 4 * lane + 256 * i);
                u32x2 w; w[0] = pack2(v[i][0] * inv * gg[0], v[i][1] * inv * gg[1]); w[1] = pack2(v[i][2] * inv * gg[2], v[i][3] * inv * gg[3]);
                *(u32x2*)(hn + (size_t)r * D + 4 * lane + 256 * i) = w;
            }
        }
    }
    GRID_SYNC();
    {
        auto arow = [=](int m) { return hn + (size_t)m * D; };
        auto brow = [=](int n) { return WinT + (size_t)n * D; };
        auto epi = [=](int m, int n4, f32x4 v) {
            if (n4 < FW) {
                const int b = m >> 12, l = m & 4095;
#pragma unroll
                for (int j = 0; j < 4; ++j) uT[((size_t)(b * FW + n4 + j) << 12) + l] = f2bf(v[j]);
            } else if (n4 < FW + SW) {
                const int ch = n4 - FW, g = ch >> 4, ci = ch & 15;
                u32x2 w; w[0] = pack2(v[0], v[1]); w[1] = pack2(v[2], v[3]);
                *(u32x2*)(Ucomb + ((size_t)(g * ROWS + (m >> 5))) * UK + (m & 31) * 16 + ci) = w;
            } else {
                u32x2 w; w[0] = pack2(sigmoidf_(v[0]), sigmoidf_(v[1])); w[1] = pack2(sigmoidf_(v[2]), sigmoidf_(v[3]));
                *(u32x2*)(gates + (size_t)m * 2048 + (n4 - 1024)) = w;
            }
        };
        auto E = [=](const g8::Unit& u, int rl, int cl, f32x4 v) { epi(u.r0 + rl, u.c0 + cl, v); };
        dense_gemm(ldsp, hn, WinT, T, INW, D, D, D, 1, 0, 0, E);
    }
    GRID_SYNC();
    {
        {
            auto E = [=](const g8::Unit& u, int rl, int cl, f32x4 v) {
                const int b = u.aux, m = u.r0 + rl, k0 = (u.c0 + cl) >> 1;
                *(unsigned*)(Fb + ((size_t)(b * SEQ + k0)) * 1024 + 2 * m) = pack2(v[0], v[1]);
                *(unsigned*)(Fb + ((size_t)(b * SEQ + k0 + 1)) * 1024 + 2 * m) = pack2(v[2], v[3]);
            };
            dense_gemm(ldsp, uT, DT, FW, 2 * SEQ, SEQ, SEQ, SEQ, BATCH, (size_t)FW * SEQ, 0, E);
        }
        {
            auto E = [=](const g8::Unit& u, int rl, int cl, f32x4 v) { *(f32x4*)(Sst + (size_t)(u.aux * ROWS + u.r0 + rl) * 256 + u.c0 + cl) = v; };
            dense_gemm(ldsp, Ucomb, BtS, ROWS, 256, 512, UK, 512, SG, (size_t)ROWS * UK, (size_t)256 * 512, E);
        }
    }
    GRID_SYNC();
    {
        for (int i = gt; i < BATCH * SG * 2 * SN; i += nt) {
            const int n = i & 63, dir = (i >> 6) & 1, g = (i >> 7) & 31, b = i >> 12;
            const f32x2 a = aL[(dir * SG + g) * SN + n];
            float hr = 0.f, hi = 0.f;
            for (int j0 = 0; j0 < NCH; j0 += 16) {
                f32x2 s[16];
#pragma unroll
                for (int q = 0; q < 16; ++q) {
                    const int jj = j0 + q, j = dir == 0 ? jj : (NCH - 1 - jj);
                    s[q] = *(const f32x2*)(Sst + ((size_t)g * ROWS + b * NCH + j) * 256 + (dir * 64 + n) * 2);
                }
#pragma unroll
                for (int q = 0; q < 16; ++q) {
                    const int jj = j0 + q, j = dir == 0 ? jj : (NCH - 1 - jj);
                    const size_t row = (size_t)g * ROWS + b * NCH + j;
                    *(unsigned*)(Ucomb + row * UK + 512 + (dir * 64 + n) * 2) = pack2(hr, hi);
                    const float nr = a[0] * hr - a[1] * hi + s[q][0], ni = a[0] * hi + a[1] * hr + s[q][1];
                    hr = nr; hi = ni;
                }
            }
        }
    }
    GRID_SYNC();
    {
        {
            auto E = [=](const g8::Unit& u, int rl, int cl, f32x4 v) {
                const int g = u.aux, m = u.r0 + rl, n4 = u.c0 + cl;
                const int tt = n4 >> 4, co = n4 & 15, tok = m * LC + tt, ch = g * 16 + co;
                const u32x2 uu = *(const u32x2*)(Ucomb + (size_t)(g * ROWS + m) * UK + n4);
                const f32x4 dd = *(const f32x4*)(p.ssm_D + ch);
                const float u0 = __uint_as_float(uu[0] << 16), u1 = __uint_as_float(uu[0] & 0xffff0000u), u2 = __uint_as_float(uu[1] << 16), u3 = __uint_as_float(uu[1] & 0xffff0000u);
                u32x2 w; w[0] = pack2(gelu_tanh(v[0] + dd[0] * u0), gelu_tanh(v[1] + dd[1] * u1)); w[1] = pack2(gelu_tanh(v[2] + dd[2] * u2), gelu_tanh(v[3] + dd[3] * u3));
                *(u32x2*)(yg + (size_t)tok * SW + ch) = w;
            };
            dense_gemm(ldsp, Ucomb, BtY, ROWS, 512, UK, UK, UK, SG, (size_t)ROWS * UK, (size_t)512 * UK, E);
        }
        {
            auto arow = [=](int m) { return Fb + (size_t)m * 1024; };
            auto brow = [=](int n) { return WpT + (size_t)n * 1024; };
            auto epi = [=](int m, int n4, f32x4 v) {
                const u32x2 gg = *(const u32x2*)(gates + (size_t)m * 2048 + n4);
                const float g0 = __uint_as_float(gg[0] << 16), g1 = __uint_as_float(gg[0] & 0xffff0000u), g2 = __uint_as_float(gg[1] << 16), g3 = __uint_as_float(gg[1] & 0xffff0000u);
                u32x2 w; w[0] = pack2(g0 * v[0], g1 * v[1]); w[1] = pack2(g2 * v[2], g3 * v[3]);
                *(u32x2*)(m1 + (size_t)m * D + n4) = w;
            };
            auto E = [=](const g8::Unit& u, int rl, int cl, f32x4 v) { epi(u.r0 + rl, u.c0 + cl, v); };
            dense_gemm(ldsp, Fb, WpT, T, D, 1024, 1024, 1024, 1, 0, 0, E);
        }
    }
    GRID_SYNC();
    {
        auto arow = [=](int m) { return yg + (size_t)m * SW; };
        auto brow = [=](int n) { return WglT + (size_t)n * SW; };
        auto epi = [=](int m, int n4, f32x4 v) {
            const u32x2 yy = *(const u32x2*)(yg + (size_t)m * SW + n4);
            const float y0 = __uint_as_float(yy[0] << 16), y1 = __uint_as_float(yy[0] & 0xffff0000u), y2 = __uint_as_float(yy[1] << 16), y3 = __uint_as_float(yy[1] & 0xffff0000u);
            u32x2 w; w[0] = pack2(y0 * sigmoidf_(v[0]), y1 * sigmoidf_(v[1])); w[1] = pack2(y2 * sigmoidf_(v[2]), y3 * sigmoidf_(v[3]));
            *(u32x2*)(ys2 + (size_t)m * SW + n4) = w;
        };
        auto E = [=](const g8::Unit& u, int rl, int cl, f32x4 v) { epi(u.r0 + rl, u.c0 + cl, v); };
        dense_gemm(ldsp, yg, WglT, T, SW, SW, SW, SW, 1, 0, 0, E);
    }
    GRID_SYNC();
    {
        auto arow = [=](int m) { return ys2 + (size_t)m * SW; };
        auto brow = [=](int n) { return WsoT + (size_t)n * SW; };
        auto epi = [=](int m, int n4, f32x4 v) {
            const u32x2 gg = *(const u32x2*)(gates + (size_t)m * 2048 + 1024 + n4);
            const u32x2 mm = *(const u32x2*)(m1 + (size_t)m * D + n4);
            const float g0 = __uint_as_float(gg[0] << 16), g1 = __uint_as_float(gg[0] & 0xffff0000u), g2 = __uint_as_float(gg[1] << 16), g3 = __uint_as_float(gg[1] & 0xffff0000u);
            const float a0 = __uint_as_float(mm[0] << 16), a1 = __uint_as_float(mm[0] & 0xffff0000u), a2 = __uint_as_float(mm[1] << 16), a3 = __uint_as_float(mm[1] & 0xffff0000u);
            u32x2 w; w[0] = pack2(a0 + g0 * v[0], a1 + g1 * v[1]); w[1] = pack2(a2 + g2 * v[2], a3 + g3 * v[3]);
            *(u32x2*)(m1 + (size_t)m * D + n4) = w;
        };
        auto E = [=](const g8::Unit& u, int rl, int cl, f32x4 v) { epi(u.r0 + rl, u.c0 + cl, v); };
        dense_gemm(ldsp, ys2, WsoT, T, D, SW, SW, SW, 1, 0, 0, E);
    }
    GRID_SYNC();
    {
        auto arow = [=](int m) { return m1 + (size_t)m * D; };
        auto brow = [=](int n) { return WoT + (size_t)n * D; };
        auto epi = [=](int m, int n4, f32x4 v) {
            const f32x4 xx = *(const f32x4*)(p.x + (size_t)m * D + n4);
            *(f32x4*)(x2 + (size_t)m * D + n4) = xx + v;
        };
        auto E = [=](const g8::Unit& u, int rl, int cl, f32x4 v) { epi(u.r0 + rl, u.c0 + cl, v); };
        dense_gemm(ldsp, m1, WoT, T, D, D, D, D, 1, 0, 0, E);
    }
    GRID_SYNC();
    {
        float* rows = (float*)smem + (size_t)wid * 4 * 1024;
        for (int t0 = gw * 4; t0 < T; t0 += nw * 4) {
#pragma unroll
            for (int q = 0; q < 4; ++q) {
                const int r = t0 + q;
                f32x4 v[4]; load_row(x2 + (size_t)r * D, lane, v);
                const float inv = row_inv_rms(v);
#pragma unroll
                for (int i = 0; i < 4; ++i) {
                    const f32x4 gg = *(const f32x4*)(p.ffn_g + 4 * lane + 256 * i);
                    const f32x4 h = (f32x4){v[i][0] * inv * gg[0], v[i][1] * inv * gg[1], v[i][2] * inv * gg[2], v[i][3] * inv * gg[3]};
                    *(f32x4*)(rows + q * 1024 + 4 * lane + 256 * i) = h;
                    u32x2 w; w[0] = pack2(h[0], h[1]); w[1] = pack2(h[2], h[3]);
                    *(u32x2*)(hn2 + (size_t)r * D + 4 * lane + 256 * i) = w;
                }
            }
            asm volatile("s_waitcnt lgkmcnt(0)" ::: "memory");
            float ae[4] = {0.f, 0.f, 0.f, 0.f}, ag[4] = {0.f, 0.f, 0.f, 0.f};
            const int gl = lane & 7;
            for (int k = 0; k < 1024; ++k) {
                const float we = p.re_w[k * 64 + lane], wg = p.rg_w[k * 8 + gl];
#pragma unroll
                for (int q = 0; q < 4; ++q) { const float h = rows[q * 1024 + k]; ae[q] += h * we; ag[q] += h * wg; }
            }
            const float be = p.re_b[lane], bg = p.rg_b[gl];
#pragma unroll
            for (int q = 0; q < 4; ++q) {
                const float le = ae[q] + be, lg = ag[q] + bg;
                float gv[8];
#pragma unroll
                for (int i = 0; i < 8; ++i) gv[i] = __shfl(lg, i);
                int gi = 0; float gm = gv[0];
#pragma unroll
                for (int i = 1; i < 8; ++i) if (gv[i] > gm) { gm = gv[i]; gi = i; }
                float den = 0.f;
#pragma unroll
                for (int i = 0; i < 8; ++i) den += __expf(gv[i] - gm);
                const float pg = 1.0f / den;
                float ev[8];
#pragma unroll
                for (int i = 0; i < 8; ++i) ev[i] = __shfl(le, gi * 8 + i);
                int i1 = 0; float v1 = ev[0];
#pragma unroll
                for (int i = 1; i < 8; ++i) if (ev[i] > v1) { v1 = ev[i]; i1 = i; }
                int i2 = -1; float v2 = -3.0e38f;
#pragma unroll
                for (int i = 0; i < 8; ++i) if (i != i1 && ev[i] > v2) { v2 = ev[i]; i2 = i; }
                const float e2 = __expf(v2 - v1), w1 = pg / (1.0f + e2), w2 = pg * e2 / (1.0f + e2);
                if (lane == 0) {
                    const int tok = t0 + q, ex1 = gi * 8 + i1, ex2 = gi * 8 + i2;
                    const unsigned p1 = atomicAdd(&cnt[ex1], 1u), p2 = atomicAdd(&cnt[ex2], 1u);
                    list[ex1 * LISTCAP + p1] = tok * 2; list[ex2 * LISTCAP + p2] = tok * 2 + 1;
                    wgts[tok * 2] = w1; wgts[tok * 2 + 1] = w2;
                }
            }
        }
    }
    GRID_SYNC();
    int* sh_i = (int*)smem;
    {
        __syncthreads();
        if (tid == 0) {
            int ro = 0, tp = 0;
            for (int e = 0; e < NE; ++e) { const int c = (int)cnt[e]; sh_i[e] = c; sh_i[64 + e] = ro; sh_i[128 + e] = tp; ro += c; tp += (c + 63) / 64; }
            sh_i[128 + NE] = tp;
        }
        __syncthreads();
        const int total_m = sh_i[128 + NE];
        for (int t = gw; t < total_m * 16; t += nw) {
            const int mt_g = t >> 4, ntile = t & 15;
            int e = 0;
            while (sh_i[128 + e + 1] <= mt_g) ++e;
            const int mt = mt_g - sh_i[128 + e], c = sh_i[e], ro = sh_i[64 + e];
            const int* le = list + e * LISTCAP;
            auto arow = [=](int m) { const int idx = m < c ? m : c - 1; return hn2 + (size_t)(le[idx] >> 1) * D; };
            auto brow = [=](int n) { return WguT + ((size_t)e * 1024 + n) * D; };
            auto epi = [=](int m, int n4, f32x4 v) {
                if (m < c) {
                    const float s0 = v[0] * sigmoidf_(v[0]) * v[1], s1 = v[2] * sigmoidf_(v[2]) * v[3];
                    *(unsigned*)(act + (size_t)(ro + m) * DE + (n4 >> 1)) = pack2(s0, s1);
                }
            };
            wave_gemm_64x64(D, arow, brow, epi, mt * 64, ntile * 64, lane);
        }
    }
    GRID_SYNC();
    {
        const int total_m = sh_i[128 + NE];
        for (int t = gw; t < total_m * 16; t += nw) {
            const int mt_g = t >> 4, ntile = t & 15;
            int e = 0;
            while (sh_i[128 + e + 1] <= mt_g) ++e;
            const int mt = mt_g - sh_i[128 + e], c = sh_i[e], ro = sh_i[64 + e];
            const int* le = list + e * LISTCAP;
            auto arow = [=](int m) { const int idx = m < c ? m : c - 1; return act + (size_t)(ro + idx) * DE; };
            auto brow = [=](int n) { return WdT + ((size_t)e * D + n) * DE; };
            auto epi = [=](int m, int n4, f32x4 v) {
                if (m < c) {
                    const int as = le[m]; const float w = wgts[as];
                    u32x2 o; o[0] = pack2(w * v[0], w * v[1]); o[1] = pack2(w * v[2], w * v[3]);
                    *(u32x2*)(ybuf + (size_t)as * D + n4) = o;
                }
            };
            wave_gemm_64x64(DE, arow, brow, epi, mt * 64, ntile * 64, lane);
        }
    }
    GRID_SYNC();
    {
        for (int r = gw; r < T; r += nw) {
            f32x4 v[4]; load_row(x2 + (size_t)r * D, lane, v);
#pragma unroll
            for (int i = 0; i < 4; ++i) {
                const u32x2 y0 = *(const u32x2*)(ybuf + (size_t)(2 * r) * D + 4 * lane + 256 * i);
                const u32x2 y1 = *(const u32x2*)(ybuf + (size_t)(2 * r + 1) * D + 4 * lane + 256 * i);
                v[i][0] += __uint_as_float(y0[0] << 16) + __uint_as_float(y1[0] << 16);
                v[i][1] += __uint_as_float(y0[0] & 0xffff0000u) + __uint_as_float(y1[0] & 0xffff0000u);
                v[i][2] += __uint_as_float(y0[1] << 16) + __uint_as_float(y1[1] << 16);
                v[i][3] += __uint_as_float(y0[1] & 0xffff0000u) + __uint_as_float(y1[1] & 0xffff0000u);
            }
            const float inv = row_inv_rms(v);
#pragma unroll
            for (int i = 0; i < 4; ++i) {
                const f32x4 gg = *(const f32x4*)(p.fin_g + 4 * lane + 256 * i);
                *(f32x4*)(p.out + (size_t)r * D + 4 * lane + 256 * i) = (f32x4){v[i][0] * inv * gg[0], v[i][1] * inv * gg[1], v[i][2] * inv * gg[2], v[i][3] * inv * gg[3]};
            }
        }
    }
}

extern "C" void kernel_launch(void* const* d_in, const int* in_sizes, int n_in, void* d_out, int out_size, void* d_ws, size_t ws_size, hipStream_t stream) {
    (void)in_sizes; (void)n_in; (void)out_size;
    static int grid_blocks = 0;
    if (!grid_blocks) {
        int dev = 0, cus = 0, per_cu = 0;
        (void)hipGetDevice(&dev);
        (void)hipDeviceGetAttribute(&cus, hipDeviceAttributeMultiprocessorCount, dev);
        (void)hipOccupancyMaxActiveBlocksPerMultiprocessor(&per_cu, fwd_megakernel, NTHREADS, 0);
        if (per_cu > 1) per_cu = 1;
        if (per_cu < 1) per_cu = 1;
        grid_blocks = cus * per_cu;
    }
    if (ws_size < WS_NEED) { fprintf(stderr, "workspace too small: %zu < %zu\n", ws_size, (size_t)WS_NEED); return; }
    Params p{};
    p.x = (const float*)d_in[0]; p.mix_g = (const float*)d_in[1]; p.w_in = (const float*)d_in[2]; p.w_fo = (const float*)d_in[3];
    p.A_re = (const float*)d_in[4]; p.A_im = (const float*)d_in[5]; p.log_dt = (const float*)d_in[6];
    p.B_re = (const float*)d_in[7]; p.B_im = (const float*)d_in[8]; p.C_re = (const float*)d_in[9]; p.C_im = (const float*)d_in[10];
    p.ssm_D = (const float*)d_in[11]; p.w_glu = (const float*)d_in[12]; p.w_sso = (const float*)d_in[13]; p.w_out = (const float*)d_in[14];
    p.ffn_g = (const float*)d_in[15]; p.rg_w = (const float*)d_in[16]; p.rg_b = (const float*)d_in[17]; p.re_w = (const float*)d_in[18]; p.re_b = (const float*)d_in[19];
    p.e_gate = (const float*)d_in[20]; p.e_up = (const float*)d_in[21]; p.e_down = (const float*)d_in[22]; p.fin_g = (const float*)d_in[23];
    p.out = (float*)d_out; p.ws = (unsigned char*)d_ws;
    (void)hipMemsetAsync((unsigned char*)d_ws + OFF_J, 0, J_ZERO_BYTES, stream);
    void* args[] = {&p};
    hipError_t e = hipLaunchCooperativeKernel((const void*)fwd_megakernel, dim3(grid_blocks), dim3(NTHREADS), args, 0, stream);
    if (e != hipSuccess) fprintf(stderr, "cooperative launch failed: %s (grid %d)\n", hipGetErrorString(e), grid_blocks);
}
```

```cpp
#include <hip/hip_runtime.h>
#include <cstdio>

typedef unsigned short bf16_t;
typedef short bf16x8 __attribute__((ext_vector_type(8)));
typedef float f32x4 __attribute__((ext_vector_type(4)));
typedef float f32x2 __attribute__((ext_vector_type(2)));
typedef unsigned u32x2 __attribute__((ext_vector_type(2)));
typedef unsigned u32x4 __attribute__((ext_vector_type(4)));

constexpr int D = 1024, BATCH = 4, SEQ = 4096, T = BATCH * SEQ;
constexpr int FW = 512, SW = 512, INW = 3072;
constexpr int SG = 32, SC = 16, SN = 64;
constexpr int LC = 32, NCH = SEQ / LC, ROWS = T / LC;
constexpr int UK = 768;
constexpr int NE = 64, DE = 512, LISTCAP = 16384;
constexpr int NTHREADS = 512, NWAVES = 8;
constexpr int SMEM_BYTES = 136 * 1024;

constexpr size_t MiB = 1024 * 1024;
constexpr size_t OFF_WGUT = 0;
constexpr size_t OFF_WDT  = OFF_WGUT + 128 * MiB;
constexpr size_t OFF_WINT = OFF_WDT + 64 * MiB;
constexpr size_t OFF_WPT  = OFF_WINT + 6 * MiB;
constexpr size_t OFF_WGLT = OFF_WPT + 2 * MiB;
constexpr size_t OFF_WSOT = OFF_WGLT + MiB / 2;
constexpr size_t OFF_WOT  = OFF_WSOT + 1 * MiB;
constexpr size_t OFF_BTS  = OFF_WOT + 2 * MiB;
constexpr size_t OFF_BTY  = OFF_BTS + 8 * MiB;
constexpr size_t OFF_C    = OFF_BTY + 24 * MiB;
constexpr size_t OFF_D    = OFF_C + 64 * MiB;
constexpr size_t OFF_E    = OFF_D + 32 * MiB;
constexpr size_t OFF_FG   = OFF_E + 64 * MiB;
constexpr size_t OFF_H    = OFF_FG + 32 * MiB;
constexpr size_t OFF_I    = OFF_H + 24 * MiB;
constexpr size_t OFF_J    = OFF_I + 32 * MiB;
constexpr size_t J_CNT   = 0;
constexpr size_t J_BAR   = 4096;
constexpr size_t J_ZERO_BYTES = 20480;
constexpr size_t J_AL    = 32768;
constexpr size_t J_TOKW    = 65536;
constexpr size_t J_TOKINFO = 196608;
constexpr size_t J_SLOTASG = 458752;
constexpr size_t J_SLOTW   = 655360;
constexpr size_t J_WRT     = 1048576;
constexpr size_t WS_NEED = OFF_J + 2 * MiB;
constexpr int TAB_LDS_OFF = 131072;
constexpr int BAR_LDS_OFF = SMEM_BYTES - 16;

struct Params {
    const float* x; const float* mix_g; const float* w_in; const float* w_fo;
    const float* A_re; const float* A_im; const float* log_dt; const float* B_re; const float* B_im; const float* C_re; const float* C_im;
    const float* ssm_D; const float* w_glu; const float* w_sso; const float* w_out; const float* ffn_g;
    const float* rg_w; const float* rg_b; const float* re_w; const float* re_b;
    const float* e_gate; const float* e_up; const float* e_down; const float* fin_g;
    float* out; unsigned char* ws;
};

__device__ __forceinline__ bf16_t f2bf(float f) { unsigned u = __float_as_uint(f); u += 0x7FFFu + ((u >> 16) & 1u); return (bf16_t)(u >> 16); }
__device__ __forceinline__ float bf2f(bf16_t b) { return __uint_as_float(((unsigned)b) << 16); }
__device__ __forceinline__ unsigned pack2(float lo, float hi) { return (unsigned)f2bf(lo) | ((unsigned)f2bf(hi) << 16); }
__device__ __forceinline__ float sigmoidf_(float v) { return 1.0f / (1.0f + __expf(-v)); }
__device__ __forceinline__ float gelu_tanh(float v) { const float u = 1.5957691216057308f * (v + 0.044715f * v * v * v); return v / (1.0f + __expf(-u)); }
__device__ __forceinline__ float wave_sum(float v) {
#pragma unroll
    for (int o = 32; o > 0; o >>= 1) v += __shfl_xor(v, o);
    return v;
}


#define LAS __attribute__((address_space(3)))
#define XB_TMO      128
#define XB_XCNT(j)  (256  + 64 * (j))
#define XB_XSUB(j)  (1280 + 64 * (j))
#define XB_XGEN(j)  (2304 + 64 * (j))
#define XB_TOP      3328
#define XB_TOPGEN   3392
#define XCD_BAR_WORDS 3456
#define XB_SPIN_CAP (1u << 18)
__device__ __forceinline__ unsigned xb_ld(unsigned* p)              { return __hip_atomic_load(p, __ATOMIC_RELAXED, __HIP_MEMORY_SCOPE_AGENT); }
__device__ __forceinline__ unsigned xb_add(unsigned* p, unsigned v) { return __hip_atomic_fetch_add(p, v, __ATOMIC_RELAXED, __HIP_MEMORY_SCOPE_AGENT); }
__device__ __forceinline__ unsigned xb_xcc_id() { return (unsigned)__builtin_amdgcn_s_getreg((3 << 11) | 20) & 0xFu; }
#define XB_SPIN(cond, bar) do { unsigned _sp = 0; while (cond) { __builtin_amdgcn_s_sleep(1); \
    if ((++_sp & 255u) == 0u) { if (xb_ld(&(bar)[XB_TMO])) break; if (_sp > XB_SPIN_CAP) { atomicAdd(&(bar)[XB_TMO], 1u); break; } } } } while (0)
struct XcdBarrier { unsigned* bar; unsigned x; volatile LAS unsigned* st; };
__device__ __forceinline__ XcdBarrier xcd_barrier_post(unsigned* bar, volatile LAS unsigned* st) {
    XcdBarrier b; b.bar = bar; b.x = xb_xcc_id(); b.st = st;
    if (threadIdx.x == 0) (void)xb_add(&bar[XB_XCNT(b.x)], 1u);
    return b;
}
__device__ __forceinline__ void xcd_barrier_complete(unsigned* bar, unsigned x, unsigned& nloc, unsigned& nx) {
    const unsigned G = gridDim.x * gridDim.y * gridDim.z;
    unsigned sum, cnt, mine, sp = 0u;
    for (;;) {
        sum = 0u; cnt = 0u; mine = 0u;
#pragma unroll
        for (unsigned j = 0; j < 16; ++j) { const unsigned c = xb_ld(&bar[XB_XCNT(j)]); sum += c; cnt += (c > 0u) ? 1u : 0u; mine = (j == x) ? c : mine; }
        if (sum == G) break;
        __builtin_amdgcn_s_sleep(1);
        if ((++sp & 255u) == 0u) { if (xb_ld(&bar[XB_TMO])) break; if (sp > XB_SPIN_CAP) { atomicAdd(&bar[XB_TMO], 1u); break; } }
    }
    nloc = mine > 0u ? mine : 1u; nx = cnt > 0u ? cnt : 1u;
}
__device__ __forceinline__ void xcd_barrier(const XcdBarrier& b) {
    asm volatile("s_waitcnt vmcnt(0)" ::: "memory");
    __syncthreads();
    if (threadIdx.x == 0) {
        unsigned* bar = b.bar;
        __builtin_amdgcn_s_waitcnt(0);
        unsigned nloc = b.st[0], nx = b.st[1];
        if (nloc == 0u) { xcd_barrier_complete(bar, b.x, nloc, nx); b.st[0] = nloc; b.st[1] = nx; }
        const unsigned old = xb_add(&bar[XB_XSUB(b.x)], 1u);
        const unsigned gen = old / nloc;
        if (old + 1u == (gen + 1u) * nloc) {
            __builtin_amdgcn_fence(__ATOMIC_RELEASE, "agent");
            asm volatile("s_waitcnt vmcnt(0)" ::: "memory");
            const unsigned og = xb_add(&bar[XB_TOP], 1u);
            const unsigned tg = og / nx;
            if (og + 1u == (tg + 1u) * nx) xb_add(&bar[XB_TOPGEN], 1u);
            else XB_SPIN(xb_ld(&bar[XB_TOPGEN]) == tg, bar);
            __builtin_amdgcn_fence(__ATOMIC_ACQUIRE, "agent");
            xb_add(&bar[XB_XGEN(b.x)], 1u);
            asm volatile("s_waitcnt vmcnt(0)" ::: "memory");
        } else {
            XB_SPIN(xb_ld(&bar[XB_XGEN(b.x)]) == gen, bar);
            __builtin_amdgcn_fence(__ATOMIC_ACQUIRE, "agent");
            asm volatile("s_waitcnt vmcnt(0)" ::: "memory");
        }
    }
    __syncthreads();
}

template <class AF, class BF, class EF>
__device__ __forceinline__ void wave_gemm_64x64(const int K, const AF& arow, const BF& brow, const EF& epi, const int m0, const int n0, const int lane) {
    const int fr = lane & 15, fq = lane >> 4;
    const bf16_t* ap0 = arow(m0 + fr) + fq * 8;
    const bf16_t* ap1 = arow(m0 + 16 + fr) + fq * 8;
    const bf16_t* ap2 = arow(m0 + 32 + fr) + fq * 8;
    const bf16_t* ap3 = arow(m0 + 48 + fr) + fq * 8;
    const bf16_t* bp0 = brow(n0 + fr) + fq * 8;
    const bf16_t* bp1 = brow(n0 + 16 + fr) + fq * 8;
    const bf16_t* bp2 = brow(n0 + 32 + fr) + fq * 8;
    const bf16_t* bp3 = brow(n0 + 48 + fr) + fq * 8;
    f32x4 acc[4][4];
#pragma unroll
    for (int i = 0; i < 4; ++i)
#pragma unroll
        for (int j = 0; j < 4; ++j) acc[i][j] = (f32x4){0.f, 0.f, 0.f, 0.f};
    bf16x8 a[4], b[4];
    a[0] = *(const bf16x8*)ap0; a[1] = *(const bf16x8*)ap1; a[2] = *(const bf16x8*)ap2; a[3] = *(const bf16x8*)ap3;
    b[0] = *(const bf16x8*)bp0; b[1] = *(const bf16x8*)bp1; b[2] = *(const bf16x8*)bp2; b[3] = *(const bf16x8*)bp3;
    for (int k = 0; k < K; k += 32) {
        bf16x8 an[4], bn[4];
        const int kn = (k + 32 < K) ? k + 32 : k;
        an[0] = *(const bf16x8*)(ap0 + kn); an[1] = *(const bf16x8*)(ap1 + kn); an[2] = *(const bf16x8*)(ap2 + kn); an[3] = *(const bf16x8*)(ap3 + kn);
        bn[0] = *(const bf16x8*)(bp0 + kn); bn[1] = *(const bf16x8*)(bp1 + kn); bn[2] = *(const bf16x8*)(bp2 + kn); bn[3] = *(const bf16x8*)(bp3 + kn);
#pragma unroll
        for (int i = 0; i < 4; ++i)
#pragma unroll
            for (int j = 0; j < 4; ++j) acc[i][j] = __builtin_amdgcn_mfma_f32_16x16x32_bf16(b[j], a[i], acc[i][j], 0, 0, 0);
#pragma unroll
        for (int i = 0; i < 4; ++i) { a[i] = an[i]; b[i] = bn[i]; }
    }
#pragma unroll
    for (int i = 0; i < 4; ++i)
#pragma unroll
        for (int j = 0; j < 4; ++j) epi(m0 + 16 * i + fr, n0 + 16 * j + 4 * fq, acc[i][j]);
}

template <class AF, class BF, class EF>
__device__ __forceinline__ void gemm_phase_simple(const int M, const int N, const int K, const AF& arow, const BF& brow, const EF& epi) {
    const int lane = threadIdx.x & 63, wid = threadIdx.x >> 6;
    const int gw = blockIdx.x * NWAVES + wid, nw = gridDim.x * NWAVES;
    const int tn = N / 64, tiles = (M / 64) * tn;
    for (int t = gw; t < tiles; t += nw) wave_gemm_64x64(K, arow, brow, epi, (t / tn) * 64, (t % tn) * 64, lane);
}


namespace g8 {
constexpr int BM = 256, BK = 64, HALF = 128, HTB = HALF * BK * 2, STAGE_BYTES = 8 * HTB;
__device__ __forceinline__ int lds_byte(int r, int c) { const int st = (r >> 4) * 2 + (c >> 5), rr = r & 15, cc = c & 31, ob = rr * 64 + cc * 2; return st * 1024 + (ob ^ (((ob >> 9) & 1) << 5)); }
__device__ __forceinline__ void stage_rc(int b, int& R, int& C) { const int st = b / 1024, sb = b % 1024, swz = sb ^ (((sb >> 9) & 1) << 5); R = (st >> 1) * 16 + swz / 64; C = (st & 1) * 32 + (swz % 64) / 2; }
struct Unit { const char* A; const char* B; int r0, c0, aux, nrows; };

struct DenseSched {
    const char* A; const char* B; size_t gsA, gsB; int lda, ldb, nM, nN, nG, G, c;
    __device__ __forceinline__ bool next(int i, Unit& u) const {
        const int nMt = nM * nG, nwg = nMt * nN;
        const long L = (long)i * G + c; if (L >= nwg) return false;
        int wgid = (int)L; { const int q = nwg / 8, r = nwg % 8, xcd = wgid % 8, off = wgid / 8; wgid = (xcd < r ? xcd * (q + 1) : r * (q + 1) + (xcd - r) * q) + off; }
        const int nig = 8 * nN, gid = wgid / nig, fm = gid * 8, gsz = (nMt - fm) < 8 ? (nMt - fm) : 8;
        const int pmt = fm + ((wgid % nig) % gsz), pn = (wgid % nig) / gsz;
        const int g = pmt / nM, pm = pmt % nM;
        u.A = A + (size_t)g * gsA + (size_t)pm * BM * lda * 2; u.B = B + (size_t)g * gsB + (size_t)pn * BM * ldb * 2;
        u.r0 = pm * BM; u.c0 = pn * BM; u.aux = g; u.nrows = BM; return true;
    }
};

struct RaggedSched {
    const char* A; const char* B; const LAS int* tab; size_t gsB; int lda, ldb, nN, G, c;
    __device__ __forceinline__ bool next(int i, Unit& u) const {
        const int nwg = tab[128 + 64] * nN;
        const long L = (long)i * G + c; if (L >= nwg) return false;
        int wgid = (int)L; { const int q = nwg / 8, r = nwg % 8, xcd = wgid % 8, off = wgid / 8; wgid = (xcd < r ? xcd * (q + 1) : r * (q + 1) + (xcd - r) * q) + off; }
        const int rt = wgid / nN, pn = wgid % nN;
        int e = 0;
        while (tab[128 + e + 1] <= rt) ++e;
        const int mt = rt - tab[128 + e], cnt = tab[e], ro = tab[64 + e] + mt * BM;
        u.A = A + (size_t)ro * lda * 2; u.B = B + (size_t)e * gsB + (size_t)pn * BM * ldb * 2;
        u.r0 = ro; u.c0 = pn * BM; u.aux = e; u.nrows = (cnt - mt * BM) < BM ? (cnt - mt * BM) : BM; return true;
    }
};

template <class Sched, class Epi>
__device__ __forceinline__ void gemm_phase(LAS unsigned char* lds, const int K, const int lda, const int ldb, const Sched& S, const Epi& E) {
    const int tid = threadIdx.x, wid = __builtin_amdgcn_readfirstlane(tid >> 6), lane = tid & 63, wr = wid >> 2, wc = wid & 3, fr = lane & 15, fq = lane >> 4;
    const int nt = K / BK;
    unsigned voffA[2], voffB[2];
#pragma unroll
    for (int i = 0; i < 2; ++i) { int R, C; stage_rc(tid * 16 + i * 8192, R, C); voffA[i] = (unsigned)(R * lda + C) * 2u; voffB[i] = (unsigned)(R * ldb + C) * 2u; }
    const size_t kstep = (size_t)(BK * 2);
    const size_t hstepA = (size_t)HALF * lda * 2, hstepB = (size_t)HALF * ldb * 2;
    const unsigned ldsw = (unsigned)wid * 1024u;
    const int aoff = lds_byte(wr * 64 + fr, fq * 8), boff = lds_byte(wc * 32 + fr, fq * 8);
#define G8_SA(b, h) (((b) * 2 + (h)) * HTB)
#define G8_SB(b, h) ((4 + (b) * 2 + (h)) * HTB)
#define G8_STAGE(bufoff, gbase, voff) do { _Pragma("unroll") for (int _i = 0; _i < 2; ++_i) \
        __builtin_amdgcn_global_load_lds((const unsigned*)((const char*)(gbase) + (voff)[_i]), (LAS unsigned*)(lds + (bufoff) + ldsw + _i * 8192), 16, 0, 0); } while (0)
#define G8_LDA(dst, b, h) do { _Pragma("unroll") for (int m = 0; m < 4; ++m) _Pragma("unroll") for (int k = 0; k < 2; ++k) dst[m][k] = *(const LAS bf16x8*)(lds + G8_SA(b, h) + aoff + m * 2048 + k * 1024); } while (0)
#define G8_LDB(dst, b, h) do { _Pragma("unroll") for (int n = 0; n < 2; ++n) _Pragma("unroll") for (int k = 0; k < 2; ++k) dst[n][k] = *(const LAS bf16x8*)(lds + G8_SB(b, h) + boff + n * 2048 + k * 1024); } while (0)
#define G8_MMA(ai, bj, At, Bt) do { __builtin_amdgcn_s_setprio(1); _Pragma("unroll") for (int m = 0; m < 4; ++m) _Pragma("unroll") for (int n = 0; n < 2; ++n) _Pragma("unroll") for (int k = 0; k < 2; ++k) \
        acc[ai][bj][m][n] = __builtin_amdgcn_mfma_f32_16x16x32_bf16(Bt[n][k], At[m][k], acc[ai][bj][m][n], 0, 0, 0); __builtin_amdgcn_s_setprio(0); } while (0)
#define G8_WAIT_V(n) asm volatile("s_waitcnt vmcnt(" #n ")" ::: "memory")
#define G8_WAIT_L(n) asm volatile("s_waitcnt lgkmcnt(" #n ")" ::: "memory")
#define G8_BAR __builtin_amdgcn_s_barrier()
#define G8_SCHED __builtin_amdgcn_sched_barrier(0)
    Unit cur, nxt; int ui = 0;
    if (!S.next(0, cur)) return;
    f32x4 acc[2][2][4][2];
#pragma unroll
    for (int a = 0; a < 2; ++a)
#pragma unroll
        for (int b = 0; b < 2; ++b)
#pragma unroll
            for (int m = 0; m < 4; ++m)
#pragma unroll
                for (int n = 0; n < 2; ++n) acc[a][b][m][n] = (f32x4){0.f, 0.f, 0.f, 0.f};
    bf16x8 At[4][2], B0[2][2], B1[2][2];
    const char* cA = cur.A; const char* cB = cur.B;
    G8_STAGE(G8_SB(0, 0), cB, voffB); G8_STAGE(G8_SA(0, 0), cA, voffA); G8_STAGE(G8_SB(0, 1), cB + hstepB, voffB); G8_STAGE(G8_SA(0, 1), cA + hstepA, voffA);
    if (wr == 1) G8_BAR;
    G8_WAIT_V(4); G8_BAR;
    G8_STAGE(G8_SB(1, 0), cB + kstep, voffB); G8_STAGE(G8_SA(1, 0), cA + kstep, voffA); G8_STAGE(G8_SB(1, 1), cB + hstepB + kstep, voffB);
    G8_WAIT_V(6); G8_BAR;
    for (;;) {
        const bool has_next = S.next(ui + 1, nxt);
        const char* nA = has_next ? nxt.A : cA; const char* nB = has_next ? nxt.B : cB;
        for (int t = 0; t < nt; t += 2) {
            const bool last = (t == nt - 2);
            const char* a1 = cA + (size_t)(t + 1) * kstep;
            const char* a2 = last ? nA : cA + (size_t)(t + 2) * kstep; const char* b2 = last ? nB : cB + (size_t)(t + 2) * kstep;
            const char* a3 = a2 + kstep; const char* b3 = b2 + kstep;
            G8_LDB(B0, 0, 0); G8_SCHED; G8_LDA(At, 0, 0); G8_STAGE(G8_SA(1, 1), a1 + hstepA, voffA);
            G8_WAIT_L(8); G8_BAR; G8_WAIT_L(0); G8_MMA(0, 0, At, B0); G8_BAR; G8_SCHED;
            G8_LDB(B1, 0, 1); G8_STAGE(G8_SB(0, 0), b2, voffB);
            G8_BAR; G8_WAIT_L(0); G8_MMA(0, 1, At, B1); G8_BAR;
            G8_LDA(At, 0, 1); G8_STAGE(G8_SA(0, 0), a2, voffA);
            G8_BAR; G8_WAIT_L(0); G8_MMA(1, 0, At, B0); G8_BAR; G8_SCHED;
            G8_STAGE(G8_SB(0, 1), b2 + hstepB, voffB);
            G8_WAIT_V(6); G8_BAR; G8_MMA(1, 1, At, B1); G8_BAR;
            G8_LDB(B0, 1, 0); G8_SCHED; G8_LDA(At, 1, 0); G8_STAGE(G8_SA(0, 1), a2 + hstepA, voffA);
            G8_WAIT_L(8); G8_BAR; G8_WAIT_L(0); G8_MMA(0, 0, At, B0); G8_BAR; G8_SCHED;
            G8_LDB(B1, 1, 1); G8_STAGE(G8_SB(1, 0), b3, voffB);
            G8_BAR; G8_WAIT_L(0); G8_MMA(0, 1, At, B1); G8_BAR;
            G8_LDA(At, 1, 1); G8_STAGE(G8_SA(1, 0), a3, voffA);
            G8_BAR; G8_WAIT_L(0); G8_MMA(1, 0, At, B0); G8_BAR; G8_SCHED;
            G8_STAGE(G8_SB(1, 1), b3 + hstepB, voffB);
            G8_WAIT_V(6); G8_BAR; G8_MMA(1, 1, At, B1); G8_BAR;
        }
#pragma unroll
        for (int ai = 0; ai < 2; ++ai)
#pragma unroll
            for (int m = 0; m < 4; ++m)
#pragma unroll
                for (int bj = 0; bj < 2; ++bj)
#pragma unroll
                    for (int n = 0; n < 2; ++n) E(cur, ai * HALF + wr * 64 + m * 16 + fr, bj * HALF + wc * 32 + n * 16 + 4 * fq, acc[ai][bj][m][n]);
        if (!has_next) break;
#pragma unroll
        for (int a = 0; a < 2; ++a)
#pragma unroll
            for (int b = 0; b < 2; ++b)
#pragma unroll
                for (int m = 0; m < 4; ++m)
#pragma unroll
                    for (int n = 0; n < 2; ++n) acc[a][b][m][n] = (f32x4){0.f, 0.f, 0.f, 0.f};
        cur = nxt; cA = nA; cB = nB; ++ui;
    }
    G8_WAIT_V(0);
    if (wr == 0) G8_BAR;
    G8_BAR;
#undef G8_SA
#undef G8_SB
#undef G8_STAGE
#undef G8_LDA
#undef G8_LDB
#undef G8_MMA
#undef G8_WAIT_V
#undef G8_WAIT_L
#undef G8_BAR
#undef G8_SCHED
}
}

template <class Epi>
__device__ __forceinline__ void dense_gemm(LAS unsigned char* lds, const bf16_t* A, const bf16_t* B, int M, int N, int K, int lda, int ldb, int nG, size_t gsA, size_t gsB, const Epi& E) {
    g8::DenseSched S; S.A = (const char*)A; S.B = (const char*)B; S.gsA = gsA * 2; S.gsB = gsB * 2; S.lda = lda; S.ldb = ldb; S.nM = M / 256; S.nN = N / 256; S.nG = nG; S.G = gridDim.x; S.c = blockIdx.x;
    g8::gemm_phase(lds, K, lda, ldb, S, E);
}

__device__ __forceinline__ void transpose_cvt_tile_wave(const float* __restrict__ src, bf16_t* __restrict__ dst, const int K, const int N, const int nmul, const int nadd, const int tile, float* lds, const int lane) {
    const int tn = N / 64, k0 = (tile / tn) * 64, n0 = (tile % tn) * 64;
    f32x4 v[16];
#pragma unroll
    for (int i = 0; i < 16; ++i) v[i] = *(const f32x4*)(src + (size_t)(k0 + i * 4 + (lane >> 4)) * N + n0 + (lane & 15) * 4);
#pragma unroll
    for (int i = 0; i < 16; ++i) {
        const int kk = i * 4 + (lane >> 4), c4 = (lane & 15) * 4;
        lds[kk * 65 + c4 + 0] = v[i][0]; lds[kk * 65 + c4 + 1] = v[i][1]; lds[kk * 65 + c4 + 2] = v[i][2]; lds[kk * 65 + c4 + 3] = v[i][3];
    }
    asm volatile("s_waitcnt lgkmcnt(0)" ::: "memory");
    const int kc = (lane & 7) * 8;
#pragma unroll
    for (int it = 0; it < 8; ++it) {
        const int n = it * 8 + (lane >> 3);
        u32x4 w;
        w[0] = pack2(lds[(kc + 0) * 65 + n], lds[(kc + 1) * 65 + n]);
        w[1] = pack2(lds[(kc + 2) * 65 + n], lds[(kc + 3) * 65 + n]);
        w[2] = pack2(lds[(kc + 4) * 65 + n], lds[(kc + 5) * 65 + n]);
        w[3] = pack2(lds[(kc + 6) * 65 + n], lds[(kc + 7) * 65 + n]);
        *(u32x4*)(dst + (size_t)((n0 + n) * nmul + nadd) * K + k0 + kc) = w;
    }
    asm volatile("s_waitcnt lgkmcnt(0)" ::: "memory");
}

__device__ void ssm_prep_group(const Params& p, const int g, float* lds) {
    f32x2* pw = (f32x2*)lds;
    f32x2* bb = pw + 4224;
    f32x2* cm = bb + 2048;
    float* kt = (float*)(cm + 2048);
    const int t = threadIdx.x;
    bf16_t* BtS = (bf16_t*)(p.ws + OFF_BTS) + (size_t)g * 256 * 512;
    bf16_t* BtY = (bf16_t*)(p.ws + OFF_BTY) + (size_t)g * 512 * UK;
    f32x2* aL = (f32x2*)(p.ws + OFF_J + J_AL);
    __syncthreads();
    for (int i = t; i < 2 * 64 * 33; i += NTHREADS) {
        const int dir = i / (64 * 33), n = (i / 33) % 64, tau = i % 33;
        const double are = (double)p.A_re[(dir * SG + g) * SN + n], aim = (double)p.A_im[(dir * SG + g) * SN + n];
        const double dt = exp((double)p.log_dt[dir * SG + g]);
        const double mag = exp(are * dt * tau), ang = aim * dt * tau;
        pw[i] = (f32x2){(float)(mag * cos(ang)), (float)(mag * sin(ang))};
        if (tau == 32) aL[(dir * SG + g) * SN + n] = pw[i];
    }
    for (int i = t; i < 2 * 64 * 16; i += NTHREADS) {
        const int dir = i / 1024, n = (i / 16) % 64, ci = i % 16;
        const double are = (double)p.A_re[(dir * SG + g) * SN + n], aim = (double)p.A_im[(dir * SG + g) * SN + n];
        const double dt = exp((double)p.log_dt[dir * SG + g]);
        const double mag = exp(are * dt), ang = aim * dt;
        const double nr = mag * cos(ang) - 1.0, ni = mag * sin(ang);
        const double den = are * are + aim * aim;
        const double qr = (nr * are + ni * aim) / den, qi = (ni * are - nr * aim) / den;
        const size_t bi = ((size_t)(dir * SG + g) * SN + n) * SC + ci;
        const double br = (double)p.B_re[bi], bim = (double)p.B_im[bi];
        bb[i] = (f32x2){(float)(qr * br - qi * bim), (float)(qr * bim + qi * br)};
    }
    for (int i = t; i < 2 * 16 * 64; i += NTHREADS) {
        const int dir = i / 1024, co = (i / 64) % 16, n = i % 64;
        const size_t ci_ = ((size_t)(dir * SG + g) * SC + co) * SN + n;
        cm[i] = (f32x2){p.C_re[ci_], p.C_im[ci_]};
    }
    __syncthreads();
    for (int i = t; i < 2 * 32 * 256; i += NTHREADS) {
        const int dir = i / 8192, tau = (i / 256) % 32, co = (i / 16) % 16, ci = i % 16;
        float s = 0.f;
        for (int n = 0; n < 64; ++n) {
            const f32x2 c = cm[(dir * 16 + co) * 64 + n], a = pw[(dir * 64 + n) * 33 + tau], b = bb[(dir * 64 + n) * 16 + ci];
            const float zr = c[0] * a[0] - c[1] * a[1], zi = c[0] * a[1] + c[1] * a[0];
            s += zr * b[0] - zi * b[1];
        }
        kt[i] = s;
    }
    __syncthreads();
    for (int i = t; i < 256 * 512; i += NTHREADS) {
        const int row = i / 512, col = i % 512;
        const int dir = row / 128, n = (row / 2) % 64, ri = row & 1, s = col / 16, ci = col % 16;
        const int tau = dir == 0 ? (LC - 1 - s) : s;
        const f32x2 a = pw[(dir * 64 + n) * 33 + tau], b = bb[(dir * 64 + n) * 16 + ci];
        const float v = ri == 0 ? (a[0] * b[0] - a[1] * b[1]) : (a[0] * b[1] + a[1] * b[0]);
        BtS[i] = f2bf(v);
    }
    for (int i = t; i < 512 * UK; i += NTHREADS) {
        const int row = i / UK, kk = i % UK;
        const int tt = row / 16, co = row % 16;
        float v;
        if (kk < 512) {
            const int s = kk / 16, ci = kk % 16;
            if (s < tt) v = kt[((0 * 32 + (tt - s)) * 16 + co) * 16 + ci];
            else if (s > tt) v = kt[((1 * 32 + (s - tt)) * 16 + co) * 16 + ci];
            else v = kt[((0 * 32 + 0) * 16 + co) * 16 + ci] + kt[((1 * 32 + 0) * 16 + co) * 16 + ci];
        } else {
            const int q = kk - 512, dir = q / 128, n = (q / 2) % 64, ri = q & 1;
            const int tau = dir == 0 ? (tt + 1) : (LC - tt);
            const f32x2 c = cm[(dir * 16 + co) * 64 + n], a = pw[(dir * 64 + n) * 33 + tau];
            const float zr = c[0] * a[0] - c[1] * a[1], zi = c[0] * a[1] + c[1] * a[0];
            v = ri == 0 ? zr : -zi;
        }
        BtY[i] = f2bf(v);
    }
}

__device__ __forceinline__ void load_row(const float* row, const int lane, f32x4 (&v)[4]) {
#pragma unroll
    for (int i = 0; i < 4; ++i) v[i] = *(const f32x4*)(row + 4 * lane + 256 * i);
}
__device__ __forceinline__ float row_inv_rms(const f32x4 (&v)[4]) {
    float s = 0.f;
#pragma unroll
    for (int i = 0; i < 4; ++i) s += v[i][0] * v[i][0] + v[i][1] * v[i][1] + v[i][2] * v[i][2] + v[i][3] * v[i][3];
    s = wave_sum(s);
    return 1.0f / sqrtf(s * (1.0f / 1024.0f) + 1e-6f);
}

__global__ void __launch_bounds__(NTHREADS) fwd_megakernel(const Params p) {
    __shared__ __attribute__((aligned(16))) unsigned char smem[SMEM_BYTES];
    const int tid = threadIdx.x, lane = tid & 63, wid = tid >> 6;
    const int gw = blockIdx.x * NWAVES + wid, nw = gridDim.x * NWAVES;
    const int gt = blockIdx.x * NTHREADS + tid, nt = gridDim.x * NTHREADS;
    unsigned char* ws = p.ws;
    bf16_t* WguT = (bf16_t*)(ws + OFF_WGUT); bf16_t* WdT = (bf16_t*)(ws + OFF_WDT);
    bf16_t* WinT = (bf16_t*)(ws + OFF_WINT); bf16_t* WpT = (bf16_t*)(ws + OFF_WPT); bf16_t* WglT = (bf16_t*)(ws + OFF_WGLT);
    bf16_t* WsoT = (bf16_t*)(ws + OFF_WSOT); bf16_t* WoT = (bf16_t*)(ws + OFF_WOT);
    bf16_t* BtS = (bf16_t*)(ws + OFF_BTS); bf16_t* BtY = (bf16_t*)(ws + OFF_BTY);
    bf16_t* DT = (bf16_t*)(ws + OFF_C); bf16_t* ybuf = (bf16_t*)(ws + OFF_C);
    bf16_t* hn = (bf16_t*)(ws + OFF_D); bf16_t* Fb = (bf16_t*)(ws + OFF_D); bf16_t* hn2 = (bf16_t*)(ws + OFF_D);
    bf16_t* gates = (bf16_t*)(ws + OFF_E); bf16_t* act = (bf16_t*)(ws + OFF_E + 65 * MiB);
    bf16_t* uT = (bf16_t*)(ws + OFF_FG); float* Sst = (float*)(ws + OFF_FG + 16 * MiB); bf16_t* m1 = (bf16_t*)(ws + OFF_FG);
    bf16_t* Ucomb = (bf16_t*)(ws + OFF_H);
    bf16_t* yg = (bf16_t*)(ws + OFF_I); bf16_t* ys2 = (bf16_t*)(ws + OFF_I + 16 * MiB);
    unsigned* cnt = (unsigned*)(ws + OFF_J + J_CNT);
    const f32x2* aL = (const f32x2*)(ws + OFF_J + J_AL);
    f32x2* tokw = (f32x2*)(ws + OFF_J + J_TOKW);
    int* tokinfo = (int*)(ws + OFF_J + J_TOKINFO);
    int* slot_asg = (int*)(ws + OFF_J + J_SLOTASG);
    float* slot_w = (float*)(ws + OFF_J + J_SLOTW);
    bf16_t* WrT = (bf16_t*)(ws + OFF_J + J_WRT);
    bf16_t* Xg = (bf16_t*)(ws + OFF_E);
    float* x2 = p.out;
    LAS unsigned char* ldsp = (LAS unsigned char*)smem;
    if (tid == 0) { ((volatile LAS unsigned*)(ldsp + BAR_LDS_OFF))[0] = 0u; ((volatile LAS unsigned*)(ldsp + BAR_LDS_OFF))[1] = 0u; }
    __syncthreads();
    const XcdBarrier bar = xcd_barrier_post((unsigned*)(ws + OFF_J + J_BAR), (volatile LAS unsigned*)(ldsp + BAR_LDS_OFF));
#define GRID_SYNC() xcd_barrier(bar)

    {
        {
            float* ldsw = (float*)smem + (size_t)wid * (64 * 65);
            const int T_WIN = 16 * 48, T_GLU = 8 * 8, T_SSO = 8 * 16, T_WO = 16 * 16, T_EG = 64 * 16 * 8, T_ED = 64 * 8 * 16;
            const int total = T_WIN + T_GLU + T_SSO + T_WO + 2 * T_EG + T_ED;
            for (int j = gw; j < total; j += nw) {
                int q = j;
                if (q < T_WIN) { transpose_cvt_tile_wave(p.w_in, WinT, 1024, 3072, 1, 0, q, ldsw, lane); continue; } q -= T_WIN;
                if (q < T_GLU) { transpose_cvt_tile_wave(p.w_glu, WglT, 512, 512, 1, 0, q, ldsw, lane); continue; } q -= T_GLU;
                if (q < T_SSO) { transpose_cvt_tile_wave(p.w_sso, WsoT, 512, 1024, 1, 0, q, ldsw, lane); continue; } q -= T_SSO;
                if (q < T_WO) { transpose_cvt_tile_wave(p.w_out, WoT, 1024, 1024, 1, 0, q, ldsw, lane); continue; } q -= T_WO;
                if (q < T_EG) { const int e = q / 128; transpose_cvt_tile_wave(p.e_gate + (size_t)e * 1024 * 512, WguT + (size_t)e * 1024 * 1024, 1024, 512, 2, 0, q % 128, ldsw, lane); continue; } q -= T_EG;
                if (q < T_EG) { const int e = q / 128; transpose_cvt_tile_wave(p.e_up + (size_t)e * 1024 * 512, WguT + (size_t)e * 1024 * 1024, 1024, 512, 2, 1, q % 128, ldsw, lane); continue; } q -= T_EG;
                { const int e = q / 128; transpose_cvt_tile_wave(p.e_down + (size_t)e * 512 * 1024, WdT + (size_t)e * 1024 * 512, 512, 1024, 1, 0, q % 128, ldsw, lane); }
            }
        }
        __syncthreads();
        for (int i = gt; i < 1024 * 1024; i += nt) {
            const int d = i & 1023, kk = i >> 10;
            const int g = kk >> 8, c = (kk >> 1) & 127, ri = kk & 1;
            float s = 0.f;
            for (int m = 0; m < 128; ++m) {
                const float ang = (float)((c * m) & 127) * (1.0f / 64.0f);
                const float f = ri ? sinpif(ang) : cospif(ang);
                s += f * p.w_fo[(size_t)(g * 128 + m) * 1024 + d];
            }
            WpT[(size_t)d * 1024 + kk] = f2bf(s * 0.08838834764831845f);
        }
        for (int i = gt; i < 80 * 2048; i += nt) {
            const int n = i >> 11, k = i & 2047, kk = k & 1023;
            const float w = n < 64 ? p.re_w[kk * 64 + n] : (n < 72 ? p.rg_w[kk * 8 + (n - 64)] : 0.f);
            const bf16_t hi = f2bf(w);
            WrT[i] = k < 1024 ? hi : f2bf(w - bf2f(hi));
        }
        for (int i = gt; i < 8192 * 512; i += nt) {
            const int row = i >> 9, l0 = (i & 511) * 8;
            const int k = row >> 1, ri = row & 1;
            unsigned w[4];
#pragma unroll
            for (int j = 0; j < 4; ++j) {
                float v[2];
#pragma unroll
                for (int h = 0; h < 2; ++h) {
                    const int l = l0 + 2 * j + h;
                    const float ang = (float)((k * l) & 4095) * (1.0f / 2048.0f);
                    v[h] = (ri ? -sinpif(ang) : cospif(ang)) * (1.0f / 64.0f);
                }
                w[j] = pack2(v[0], v[1]);
            }
            *(u32x4*)(DT + (size_t)row * 4096 + l0) = (u32x4){w[0], w[1], w[2], w[3]};
        }
        for (int g = blockIdx.x; g < SG; g += gridDim.x) ssm_prep_group(p, g, (float*)smem);
        for (int r = gw; r < T; r += nw) {
            f32x4 v[4]; load_row(p.x + (size_t)r * D, lane, v);
            const float inv = row_inv_rms(v);
#pragma unroll
            for (int i = 0; i < 4; ++i) {
                const f32x4 gg = *(const f32x4*)(p.mix_g + 4 * lane + 256 * i);
                u32x2 w; w[0] = pack2(v[i][0] * inv * gg[0], v[i][1] * inv * gg[1]); w[1] = pack2(v[i][2] * inv * gg[2], v[i][3] * inv * gg[3]);
                *(u32x2*)(hn + (size_t)r * D + 4 * lane + 256 * i) = w;
            }
        }
    }
    GRID_SYNC();
    {
        auto arow = [=](int m) { return hn + (size_t)m * D; };
        auto brow = [=](int n) { return WinT + (size_t)n * D; };
        auto epi = [=](int m, int n4, f32x4 v) {
            if (n4 < FW) {
                const int b = m >> 12, l = m & 4095;
#pragma unroll
                for (int j = 0; j < 4; ++j) uT[((size_t)(b * FW + n4 + j) << 12) + l] = f2bf(v[j]);
            } else if (n4 < FW + SW) {
                const int ch = n4 - FW, g = ch >> 4, ci = ch & 15;
                u32x2 w; w[0] = pack2(v[0], v[1]); w[1] = pack2(v[2], v[3]);
                *(u32x2*)(Ucomb + ((size_t)(g * ROWS + (m >> 5))) * UK + (m & 31) * 16 + ci) = w;
            } else {
                u32x2 w; w[0] = pack2(sigmoidf_(v[0]), sigmoidf_(v[1])); w[1] = pack2(sigmoidf_(v[2]), sigmoidf_(v[3]));
                *(u32x2*)(gates + (size_t)m * 2048 + (n4 - 1024)) = w;
            }
        };
        auto E = [=](const g8::Unit& u, int rl, int cl, f32x4 v) { epi(u.r0 + rl, u.c0 + cl, v); };
        dense_gemm(ldsp, hn, WinT, T, INW, D, D, D, 1, 0, 0, E);
    }
    GRID_SYNC();
    {
        {
            auto E = [=](const g8::Unit& u, int rl, int cl, f32x4 v) {
                const int b = u.aux, m = u.r0 + rl, k0 = (u.c0 + cl) >> 1;
                *(unsigned*)(Fb + ((size_t)(b * SEQ + k0)) * 1024 + 2 * m) = pack2(v[0], v[1]);
                *(unsigned*)(Fb + ((size_t)(b * SEQ + k0 + 1)) * 1024 + 2 * m) = pack2(v[2], v[3]);
            };
            dense_gemm(ldsp, uT, DT, FW, 2 * SEQ, SEQ, SEQ, SEQ, BATCH, (size_t)FW * SEQ, 0, E);
        }
        {
            auto E = [=](const g8::Unit& u, int rl, int cl, f32x4 v) { *(f32x4*)(Sst + (size_t)(u.aux * ROWS + u.r0 + rl) * 256 + u.c0 + cl) = v; };
            dense_gemm(ldsp, Ucomb, BtS, ROWS, 256, 512, UK, 512, SG, (size_t)ROWS * UK, (size_t)256 * 512, E);
        }
    }
    GRID_SYNC();
    {
        for (int i = gt; i < BATCH * SG * 2 * SN; i += nt) {
            const int n = i & 63, dir = (i >> 6) & 1, g = (i >> 7) & 31, b = i >> 12;
            const f32x2 a = aL[(dir * SG + g) * SN + n];
            float hr = 0.f, hi = 0.f;
            for (int j0 = 0; j0 < NCH; j0 += 16) {
                f32x2 s[16];
#pragma unroll
                for (int q = 0; q < 16; ++q) {
                    const int jj = j0 + q, j = dir == 0 ? jj : (NCH - 1 - jj);
                    s[q] = *(const f32x2*)(Sst + ((size_t)g * ROWS + b * NCH + j) * 256 + (dir * 64 + n) * 2);
                }
#pragma unroll
                for (int q = 0; q < 16; ++q) {
                    const int jj = j0 + q, j = dir == 0 ? jj : (NCH - 1 - jj);
                    const size_t row = (size_t)g * ROWS + b * NCH + j;
                    *(unsigned*)(Ucomb + row * UK + 512 + (dir * 64 + n) * 2) = pack2(hr, hi);
                    const float nr = a[0] * hr - a[1] * hi + s[q][0], ni = a[0] * hi + a[1] * hr + s[q][1];
                    hr = nr; hi = ni;
                }
            }
        }
    }
    GRID_SYNC();
    {
        {
            auto E = [=](const g8::Unit& u, int rl, int cl, f32x4 v) {
                const int g = u.aux, m = u.r0 + rl, n4 = u.c0 + cl;
                const int tt = n4 >> 4, co = n4 & 15, tok = m * LC + tt, ch = g * 16 + co;
                const u32x2 uu = *(const u32x2*)(Ucomb + (size_t)(g * ROWS + m) * UK + n4);
                const f32x4 dd = *(const f32x4*)(p.ssm_D + ch);
                const float u0 = __uint_as_float(uu[0] << 16), u1 = __uint_as_float(uu[0] & 0xffff0000u), u2 = __uint_as_float(uu[1] << 16), u3 = __uint_as_float(uu[1] & 0xffff0000u);
                u32x2 w; w[0] = pack2(gelu_tanh(v[0] + dd[0] * u0), gelu_tanh(v[1] + dd[1] * u1)); w[1] = pack2(gelu_tanh(v[2] + dd[2] * u2), gelu_tanh(v[3] + dd[3] * u3));
                *(u32x2*)(yg + (size_t)tok * SW + ch) = w;
            };
            dense_gemm(ldsp, Ucomb, BtY, ROWS, 512, UK, UK, UK, SG, (size_t)ROWS * UK, (size_t)512 * UK, E);
        }
        {
            auto arow = [=](int m) { return Fb + (size_t)m * 1024; };
            auto brow = [=](int n) { return WpT + (size_t)n * 1024; };
            auto epi = [=](int m, int n4, f32x4 v) {
                const u32x2 gg = *(const u32x2*)(gates + (size_t)m * 2048 + n4);
                const float g0 = __uint_as_float(gg[0] << 16), g1 = __uint_as_float(gg[0] & 0xffff0000u), g2 = __uint_as_float(gg[1] << 16), g3 = __uint_as_float(gg[1] & 0xffff0000u);
                u32x2 w; w[0] = pack2(g0 * v[0], g1 * v[1]); w[1] = pack2(g2 * v[2], g3 * v[3]);
                *(u32x2*)(m1 + (size_t)m * D + n4) = w;
            };
            auto E = [=](const g8::Unit& u, int rl, int cl, f32x4 v) { epi(u.r0 + rl, u.c0 + cl, v); };
            dense_gemm(ldsp, Fb, WpT, T, D, 1024, 1024, 1024, 1, 0, 0, E);
        }
    }
    GRID_SYNC();
    {
        auto arow = [=](int m) { return yg + (size_t)m * SW; };
        auto brow = [=](int n) { return WglT + (size_t)n * SW; };
        auto epi = [=](int m, int n4, f32x4 v) {
            const u32x2 yy = *(const u32x2*)(yg + (size_t)m * SW + n4);
            const float y0 = __uint_as_float(yy[0] << 16), y1 = __uint_as_float(yy[0] & 0xffff0000u), y2 = __uint_as_float(yy[1] << 16), y3 = __uint_as_float(yy[1] & 0xffff0000u);
            u32x2 w; w[0] = pack2(y0 * sigmoidf_(v[0]), y1 * sigmoidf_(v[1])); w[1] = pack2(y2 * sigmoidf_(v[2]), y3 * sigmoidf_(v[3]));
            *(u32x2*)(ys2 + (size_t)m * SW + n4) = w;
        };
        auto E = [=](const g8::Unit& u, int rl, int cl, f32x4 v) { epi(u.r0 + rl, u.c0 + cl, v); };
        dense_gemm(ldsp, yg, WglT, T, SW, SW, SW, SW, 1, 0, 0, E);
    }
    GRID_SYNC();
    {
        auto arow = [=](int m) { return ys2 + (size_t)m * SW; };
        auto brow = [=](int n) { return WsoT + (size_t)n * SW; };
        auto epi = [=](int m, int n4, f32x4 v) {
            const u32x2 gg = *(const u32x2*)(gates + (size_t)m * 2048 + 1024 + n4);
            const u32x2 mm = *(const u32x2*)(m1 + (size_t)m * D + n4);
            const float g0 = __uint_as_float(gg[0] << 16), g1 = __uint_as_float(gg[0] & 0xffff0000u), g2 = __uint_as_float(gg[1] << 16), g3 = __uint_as_float(gg[1] & 0xffff0000u);
            const float a0 = __uint_as_float(mm[0] << 16), a1 = __uint_as_float(mm[0] & 0xffff0000u), a2 = __uint_as_float(mm[1] << 16), a3 = __uint_as_float(mm[1] & 0xffff0000u);
            u32x2 w; w[0] = pack2(a0 + g0 * v[0], a1 + g1 * v[1]); w[1] = pack2(a2 + g2 * v[2], a3 + g3 * v[3]);
            *(u32x2*)(m1 + (size_t)m * D + n4) = w;
        };
        auto E = [=](const g8::Unit& u, int rl, int cl, f32x4 v) { epi(u.r0 + rl, u.c0 + cl, v); };
        dense_gemm(ldsp, ys2, WsoT, T, D, SW, SW, SW, 1, 0, 0, E);
    }
    GRID_SYNC();
    {
        auto arow = [=](int m) { return m1 + (size_t)m * D; };
        auto brow = [=](int n) { return WoT + (size_t)n * D; };
        auto epi = [=](int m, int n4, f32x4 v) {
            const f32x4 xx = *(const f32x4*)(p.x + (size_t)m * D + n4);
            *(f32x4*)(x2 + (size_t)m * D + n4) = xx + v;
        };
        auto E = [=](const g8::Unit& u, int rl, int cl, f32x4 v) { epi(u.r0 + rl, u.c0 + cl, v); };
        dense_gemm(ldsp, m1, WoT, T, D, D, D, D, 1, 0, 0, E);
    }
    GRID_SYNC();
    {
        LAS unsigned char* hrow = ldsp;
        LAS float* lg = (LAS float*)(ldsp + 66048);
        const int fr = lane & 15, fq = lane >> 4;
        for (int tb = blockIdx.x; tb < T / 32; tb += gridDim.x) {
            const int tok0 = tb * 32;
#pragma unroll
            for (int q = 0; q < 4; ++q) {
                const int rl = wid * 4 + q, r = tok0 + rl;
                f32x4 v[4]; load_row(x2 + (size_t)r * D, lane, v);
                const float inv = row_inv_rms(v);
#pragma unroll
                for (int i = 0; i < 4; ++i) {
                    const f32x4 gg = *(const f32x4*)(p.ffn_g + 4 * lane + 256 * i);
                    u32x2 w; w[0] = pack2(v[i][0] * inv * gg[0], v[i][1] * inv * gg[1]); w[1] = pack2(v[i][2] * inv * gg[2], v[i][3] * inv * gg[3]);
                    *(u32x2*)(hn2 + (size_t)r * D + 4 * lane + 256 * i) = w;
                    *(LAS u32x2*)(hrow + rl * 2064 + (4 * lane + 256 * i) * 2) = w;
                }
            }
            __syncthreads();
            for (int job = wid; job < 10; job += NWAVES) {
                const int ntl = job % 5, mtl = job / 5;
                const LAS unsigned char* ap = hrow + (mtl * 16 + fr) * 2064 + fq * 16;
                const bf16_t* bp = WrT + (size_t)(ntl * 16 + fr) * 2048 + fq * 8;
                f32x4 acc = (f32x4){0.f, 0.f, 0.f, 0.f};
#pragma unroll 8
                for (int ks = 0; ks < 64; ++ks) {
                    const bf16x8 a = *(const LAS bf16x8*)(ap + (ks & 31) * 64);
                    const bf16x8 b = *(const bf16x8*)(bp + ks * 32);
                    acc = __builtin_amdgcn_mfma_f32_16x16x32_bf16(b, a, acc, 0, 0, 0);
                }
                *(LAS f32x4*)(lg + (mtl * 16 + fr) * 80 + ntl * 16 + 4 * fq) = acc;
            }
            __syncthreads();
            if (tid < 32) {
                const LAS float* L = lg + tid * 80;
                float gv[8];
#pragma unroll
                for (int i = 0; i < 8; ++i) gv[i] = L[64 + i] + p.rg_b[i];
                int gi = 0; float gm = gv[0];
#pragma unroll
                for (int i = 1; i < 8; ++i) if (gv[i] > gm) { gm = gv[i]; gi = i; }
                float den = 0.f;
#pragma unroll
                for (int i = 0; i < 8; ++i) den += __expf(gv[i] - gm);
                const float pg = 1.0f / den;
                float ev[8];
#pragma unroll
                for (int i = 0; i < 8; ++i) ev[i] = L[gi * 8 + i] + p.re_b[gi * 8 + i];
                int i1 = 0; float v1 = ev[0];
#pragma unroll
                for (int i = 1; i < 8; ++i) if (ev[i] > v1) { v1 = ev[i]; i1 = i; }
                int i2 = -1; float v2 = -3.0e38f;
#pragma unroll
                for (int i = 0; i < 8; ++i) if (i != i1 && ev[i] > v2) { v2 = ev[i]; i2 = i; }
                const float e2 = __expf(v2 - v1), w1 = pg / (1.0f + e2), w2 = pg * e2 / (1.0f + e2);
                const int tok = tok0 + tid, ex1 = gi * 8 + i1, ex2 = gi * 8 + i2;
                const int p1 = (int)atomicAdd(&cnt[ex1], 1u), p2 = (int)atomicAdd(&cnt[ex2], 1u);
                *(int4*)(tokinfo + 4 * tok) = make_int4(ex1, p1, ex2, p2);
                tokw[tok] = (f32x2){w1, w2};
            }
            __syncthreads();
        }
    }
    GRID_SYNC();
    LAS int* tab = (LAS int*)(ldsp + TAB_LDS_OFF);
    {
        if (tid == 0) {
            int ro = 0, tp = 0;
            for (int e = 0; e < NE; ++e) { const int c = (int)cnt[e]; tab[e] = c; tab[64 + e] = ro; tab[128 + e] = tp; ro += c; tp += (c + 255) / 256; }
            tab[128 + NE] = tp;
        }
        __syncthreads();
        for (int tok = gw; tok < T; tok += nw) {
            const int4 info = *(const int4*)(tokinfo + 4 * tok); const f32x2 w = tokw[tok];
            const int s1 = tab[64 + info.x] + info.y, s2 = tab[64 + info.z] + info.w;
            const u32x4 a = *(const u32x4*)(hn2 + (size_t)tok * D + lane * 16), b = *(const u32x4*)(hn2 + (size_t)tok * D + lane * 16 + 8);
            *(u32x4*)(Xg + (size_t)s1 * D + lane * 16) = a; *(u32x4*)(Xg + (size_t)s1 * D + lane * 16 + 8) = b;
            *(u32x4*)(Xg + (size_t)s2 * D + lane * 16) = a; *(u32x4*)(Xg + (size_t)s2 * D + lane * 16 + 8) = b;
            if (lane == 0) { slot_asg[s1] = tok * 2; slot_asg[s2] = tok * 2 + 1; slot_w[s1] = w[0]; slot_w[s2] = w[1]; }
        }
    }
    GRID_SYNC();
    {
        auto E = [=](const g8::Unit& u, int rl, int cl, f32x4 v) {
            if (rl < u.nrows) {
                const float s0 = v[0] * sigmoidf_(v[0]) * v[1], s1 = v[2] * sigmoidf_(v[2]) * v[3];
                *(unsigned*)(act + (size_t)(u.r0 + rl) * DE + ((u.c0 + cl) >> 1)) = pack2(s0, s1);
            }
        };
        g8::RaggedSched S; S.A = (const char*)Xg; S.B = (const char*)WguT; S.tab = tab; S.gsB = (size_t)1024 * 1024 * 2; S.lda = D; S.ldb = D; S.nN = 4; S.G = gridDim.x; S.c = blockIdx.x;
        g8::gemm_phase(ldsp, D, D, D, S, E);
    }
    GRID_SYNC();
    {
        auto E = [=](const g8::Unit& u, int rl, int cl, f32x4 v) {
            if (rl < u.nrows) {
                const int as = slot_asg[u.r0 + rl]; const float w = slot_w[u.r0 + rl];
                u32x2 o; o[0] = pack2(w * v[0], w * v[1]); o[1] = pack2(w * v[2], w * v[3]);
                *(u32x2*)(ybuf + (size_t)as * D + u.c0 + cl) = o;
            }
        };
        g8::RaggedSched S; S.A = (const char*)act; S.B = (const char*)WdT; S.tab = tab; S.gsB = (size_t)1024 * 512 * 2; S.lda = DE; S.ldb = DE; S.nN = 4; S.G = gridDim.x; S.c = blockIdx.x;
        g8::gemm_phase(ldsp, DE, DE, DE, S, E);
    }
    GRID_SYNC();
    {
        for (int r = gw; r < T; r += nw) {
            f32x4 v[4]; load_row(x2 + (size_t)r * D, lane, v);
#pragma unroll
            for (int i = 0; i < 4; ++i) {
                const u32x2 y0 = *(const u32x2*)(ybuf + (size_t)(2 * r) * D + 4 * lane + 256 * i);
                const u32x2 y1 = *(const u32x2*)(ybuf + (size_t)(2 * r + 1) * D + 4 * lane + 256 * i);
                v[i][0] += __uint_as_float(y0[0] << 16) + __uint_as_float(y1[0] << 16);
                v[i][1] += __uint_as_float(y0[0] & 0xffff0000u) + __uint_as_float(y1[0] & 0xffff0000u);
                v[i][2] += __uint_as_float(y0[1] << 16) + __uint_as_float(y1[1] << 16);
                v[i][3] += __uint_as_float(y0[1] & 0xffff0000u) + __uint_as_float(y1[1] & 0xffff0000u);
            }
            const float inv = row_inv_rms(v);
#pragma unroll
            for (int i = 0; i < 4; ++i) {
                const f32x4 gg = *(const f32x4*)(p.fin_g + 4 * lane + 256 * i);
                *(f32x4*)(p.out + (size_t)r * D + 4 * lane + 256 * i) = (f32x4){v[i][0] * inv * gg[0], v[i][1] * inv * gg[1], v[i][2] * inv * gg[2], v[i][3] * inv * gg[3]};
            }
        }
    }
}

extern "C" void kernel_launch(void* const* d_in, const int* in_sizes, int n_in, void* d_out, int out_size, void* d_ws, size_t ws_size, hipStream_t stream) {
    (void)in_sizes; (void)n_in; (void)out_size;
    static int grid_blocks = 0;
    if (!grid_blocks) {
        int dev = 0, cus = 0, per_cu = 0;
        (void)hipGetDevice(&dev);
        (void)hipDeviceGetAttribute(&cus, hipDeviceAttributeMultiprocessorCount, dev);
        (void)hipOccupancyMaxActiveBlocksPerMultiprocessor(&per_cu, fwd_megakernel, NTHREADS, 0);
        if (per_cu > 1) per_cu = 1;
        if (per_cu < 1) per_cu = 1;
        grid_blocks = cus * per_cu;
    }
    if (ws_size < WS_NEED) { fprintf(stderr, "workspace too small: %zu < %zu\n", ws_size, (size_t)WS_NEED); return; }
    Params p{};
    p.x = (const float*)d_in[0]; p.mix_g = (const float*)d_in[1]; p.w_in = (const float*)d_in[2]; p.w_fo = (const float*)d_in[3];
    p.A_re = (const float*)d_in[4]; p.A_im = (const float*)d_in[5]; p.log_dt = (const float*)d_in[6];
    p.B_re = (const float*)d_in[7]; p.B_im = (const float*)d_in[8]; p.C_re = (const float*)d_in[9]; p.C_im = (const float*)d_in[10];
    p.ssm_D = (const float*)d_in[11]; p.w_glu = (const float*)d_in[12]; p.w_sso = (const float*)d_in[13]; p.w_out = (const float*)d_in[14];
    p.ffn_g = (const float*)d_in[15]; p.rg_w = (const float*)d_in[16]; p.rg_b = (const float*)d_in[17]; p.re_w = (const float*)d_in[18]; p.re_b = (const float*)d_in[19];
    p.e_gate = (const float*)d_in[20]; p.e_up = (const float*)d_in[21]; p.e_down = (const float*)d_in[22]; p.fin_g = (const float*)d_in[23];
    p.out = (float*)d_out; p.ws = (unsigned char*)d_ws;
    (void)hipMemsetAsync((unsigned char*)d_ws + OFF_J, 0, J_ZERO_BYTES, stream);
    void* args[] = {&p};
    hipError_t e = hipLaunchCooperativeKernel((const void*)fwd_megakernel, dim3(grid_blocks), dim3(NTHREADS), args, 0, stream);
    if (e != hipSuccess) fprintf(stderr, "cooperative launch failed: %s (grid %d)\n", hipGetErrorString(e), grid_blocks);
}
```

```cpp
#include <hip/hip_runtime.h>
#include <cstdio>

typedef unsigned short bf16_t;
typedef short bf16x8 __attribute__((ext_vector_type(8)));
typedef float f32x4 __attribute__((ext_vector_type(4)));
typedef float f32x2 __attribute__((ext_vector_type(2)));
typedef unsigned u32x2 __attribute__((ext_vector_type(2)));
typedef unsigned u32x4 __attribute__((ext_vector_type(4)));

#ifndef REP0
#define REP0 1
#endif
#ifndef REP1
#define REP1 1
#endif
#ifndef REP2
#define REP2 1
#endif
#ifndef REP3
#define REP3 1
#endif
#ifndef REP4
#define REP4 1
#endif
#ifndef REP5
#define REP5 1
#endif
#ifndef REP7
#define REP7 1
#endif
#ifndef REP9
#define REP9 1
#endif
#ifndef REP10
#define REP10 1
#endif
#ifndef REP11
#define REP11 1
#endif
constexpr int D = 1024, BATCH = 4, SEQ = 4096, T = BATCH * SEQ;
constexpr int FW = 512, SW = 512, INW = 3072;
constexpr int SG = 32, SC = 16, SN = 64;
constexpr int LC = 32, NCH = SEQ / LC, ROWS = T / LC;
constexpr int UK = 768;
constexpr int NE = 64, DE = 512, LISTCAP = 16384;
constexpr int NTHREADS = 512, NWAVES = 8;
constexpr int SMEM_BYTES = 136 * 1024;

constexpr size_t MiB = 1024 * 1024;
constexpr size_t OFF_WGUT = 0;
constexpr size_t OFF_WDT  = OFF_WGUT + 128 * MiB;
constexpr size_t OFF_WINT = OFF_WDT + 64 * MiB;
constexpr size_t OFF_WPT  = OFF_WINT + 6 * MiB;
constexpr size_t OFF_WGLT = OFF_WPT + 2 * MiB;
constexpr size_t OFF_WSOT = OFF_WGLT + MiB / 2;
constexpr size_t OFF_WOT  = OFF_WSOT + 1 * MiB;
constexpr size_t OFF_BTS  = OFF_WOT + 2 * MiB;
constexpr size_t OFF_BTY  = OFF_BTS + 8 * MiB;
constexpr size_t OFF_C    = OFF_BTY + 24 * MiB;
constexpr size_t OFF_D    = OFF_C + 64 * MiB;
constexpr size_t OFF_E    = OFF_D + 32 * MiB;
constexpr size_t OFF_FG   = OFF_E + 64 * MiB;
constexpr size_t OFF_H    = OFF_FG + 32 * MiB;
constexpr size_t OFF_I    = OFF_H + 24 * MiB;
constexpr size_t OFF_J    = OFF_I + 32 * MiB;
constexpr size_t J_CNT   = 0;
constexpr size_t J_BAR   = 4096;
constexpr size_t J_ZERO_BYTES = 20480;
constexpr size_t J_AL    = 32768;
constexpr size_t J_TOKW    = 65536;
constexpr size_t J_TOKINFO = 196608;
constexpr size_t J_SLOTASG = 458752;
constexpr size_t J_SLOTW   = 655360;
constexpr size_t J_WRT     = 1048576;
constexpr size_t WS_NEED = OFF_J + 2 * MiB;
constexpr int TAB_LDS_OFF = 131072;
constexpr int BAR_LDS_OFF = SMEM_BYTES - 16;

struct Params {
    const float* x; const float* mix_g; const float* w_in; const float* w_fo;
    const float* A_re; const float* A_im; const float* log_dt; const float* B_re; const float* B_im; const float* C_re; const float* C_im;
    const float* ssm_D; const float* w_glu; const float* w_sso; const float* w_out; const float* ffn_g;
    const float* rg_w; const float* rg_b; const float* re_w; const float* re_b;
    const float* e_gate; const float* e_up; const float* e_down; const float* fin_g;
    float* out; unsigned char* ws;
};

__device__ __forceinline__ bf16_t f2bf(float f) { unsigned u = __float_as_uint(f); u += 0x7FFFu + ((u >> 16) & 1u); return (bf16_t)(u >> 16); }
__device__ __forceinline__ float bf2f(bf16_t b) { return __uint_as_float(((unsigned)b) << 16); }
__device__ __forceinline__ unsigned pack2(float lo, float hi) { return (unsigned)f2bf(lo) | ((unsigned)f2bf(hi) << 16); }
__device__ __forceinline__ float sigmoidf_(float v) { return 1.0f / (1.0f + __expf(-v)); }
__device__ __forceinline__ float gelu_tanh(float v) { const float u = 1.5957691216057308f * (v + 0.044715f * v * v * v); return v / (1.0f + __expf(-u)); }
__device__ __forceinline__ float wave_sum(float v) {
#pragma unroll
    for (int o = 32; o > 0; o >>= 1) v += __shfl_xor(v, o);
    return v;
}


#define LAS __attribute__((address_space(3)))
#define XB_TMO      128
#define XB_XCNT(j)  (256  + 64 * (j))
#define XB_XSUB(j)  (1280 + 64 * (j))
#define XB_XGEN(j)  (2304 + 64 * (j))
#define XB_TOP      3328
#define XB_TOPGEN   3392
#define XCD_BAR_WORDS 3456
#define XB_SPIN_CAP (1u << 18)
__device__ __forceinline__ unsigned xb_ld(unsigned* p)              { return __hip_atomic_load(p, __ATOMIC_RELAXED, __HIP_MEMORY_SCOPE_AGENT); }
__device__ __forceinline__ unsigned xb_add(unsigned* p, unsigned v) { return __hip_atomic_fetch_add(p, v, __ATOMIC_RELAXED, __HIP_MEMORY_SCOPE_AGENT); }
__device__ __forceinline__ unsigned xb_xcc_id() { return (unsigned)__builtin_amdgcn_s_getreg((3 << 11) | 20) & 0xFu; }
#define XB_SPIN(cond, bar) do { unsigned _sp = 0; while (cond) { __builtin_amdgcn_s_sleep(1); \
    if ((++_sp & 255u) == 0u) { if (xb_ld(&(bar)[XB_TMO])) break; if (_sp > XB_SPIN_CAP) { atomicAdd(&(bar)[XB_TMO], 1u); break; } } } } while (0)
struct XcdBarrier { unsigned* bar; unsigned x; volatile LAS unsigned* st; };
__device__ __forceinline__ XcdBarrier xcd_barrier_post(unsigned* bar, volatile LAS unsigned* st) {
    XcdBarrier b; b.bar = bar; b.x = xb_xcc_id(); b.st = st;
    if (threadIdx.x == 0) (void)xb_add(&bar[XB_XCNT(b.x)], 1u);
    return b;
}
__device__ __forceinline__ void xcd_barrier_complete(unsigned* bar, unsigned x, unsigned& nloc, unsigned& nx) {
    const unsigned G = gridDim.x * gridDim.y * gridDim.z;
    unsigned sum, cnt, mine, sp = 0u;
    for (;;) {
        sum = 0u; cnt = 0u; mine = 0u;
#pragma unroll
        for (unsigned j = 0; j < 16; ++j) { const unsigned c = xb_ld(&bar[XB_XCNT(j)]); sum += c; cnt += (c > 0u) ? 1u : 0u; mine = (j == x) ? c : mine; }
        if (sum == G) break;
        __builtin_amdgcn_s_sleep(1);
        if ((++sp & 255u) == 0u) { if (xb_ld(&bar[XB_TMO])) break; if (sp > XB_SPIN_CAP) { atomicAdd(&bar[XB_TMO], 1u); break; } }
    }
    nloc = mine > 0u ? mine : 1u; nx = cnt > 0u ? cnt : 1u;
}
__device__ __forceinline__ void xcd_barrier(const XcdBarrier& b) {
    asm volatile("s_waitcnt vmcnt(0)" ::: "memory");
    __syncthreads();
    if (threadIdx.x == 0) {
        unsigned* bar = b.bar;
        __builtin_amdgcn_s_waitcnt(0);
        unsigned nloc = b.st[0], nx = b.st[1];
        if (nloc == 0u) { xcd_barrier_complete(bar, b.x, nloc, nx); b.st[0] = nloc; b.st[1] = nx; }
        const unsigned old = xb_add(&bar[XB_XSUB(b.x)], 1u);
        const unsigned gen = old / nloc;
        if (old + 1u == (gen + 1u) * nloc) {
            __builtin_amdgcn_fence(__ATOMIC_RELEASE, "agent");
            asm volatile("s_waitcnt vmcnt(0)" ::: "memory");
            const unsigned og = xb_add(&bar[XB_TOP], 1u);
            const unsigned tg = og / nx;
            if (og + 1u == (tg + 1u) * nx) xb_add(&bar[XB_TOPGEN], 1u);
            else XB_SPIN(xb_ld(&bar[XB_TOPGEN]) == tg, bar);
            __builtin_amdgcn_fence(__ATOMIC_ACQUIRE, "agent");
            xb_add(&bar[XB_XGEN(b.x)], 1u);
            asm volatile("s_waitcnt vmcnt(0)" ::: "memory");
        } else {
            XB_SPIN(xb_ld(&bar[XB_XGEN(b.x)]) == gen, bar);
            __builtin_amdgcn_fence(__ATOMIC_ACQUIRE, "agent");
            asm volatile("s_waitcnt vmcnt(0)" ::: "memory");
        }
    }
    __syncthreads();
}

template <class AF, class BF, class EF>
__device__ __forceinline__ void wave_gemm_64x64(const int K, const AF& arow, const BF& brow, const EF& epi, const int m0, const int n0, const int lane) {
    const int fr = lane & 15, fq = lane >> 4;
    const bf16_t* ap0 = arow(m0 + fr) + fq * 8;
    const bf16_t* ap1 = arow(m0 + 16 + fr) + fq * 8;
    const bf16_t* ap2 = arow(m0 + 32 + fr) + fq * 8;
    const bf16_t* ap3 = arow(m0 + 48 + fr) + fq * 8;
    const bf16_t* bp0 = brow(n0 + fr) + fq * 8;
    const bf16_t* bp1 = brow(n0 + 16 + fr) + fq * 8;
    const bf16_t* bp2 = brow(n0 + 32 + fr) + fq * 8;
    const bf16_t* bp3 = brow(n0 + 48 + fr) + fq * 8;
    f32x4 acc[4][4];
#pragma unroll
    for (int i = 0; i < 4; ++i)
#pragma unroll
        for (int j = 0; j < 4; ++j) acc[i][j] = (f32x4){0.f, 0.f, 0.f, 0.f};
    bf16x8 a[4], b[4];
    a[0] = *(const bf16x8*)ap0; a[1] = *(const bf16x8*)ap1; a[2] = *(const bf16x8*)ap2; a[3] = *(const bf16x8*)ap3;
    b[0] = *(const bf16x8*)bp0; b[1] = *(const bf16x8*)bp1; b[2] = *(const bf16x8*)bp2; b[3] = *(const bf16x8*)bp3;
    for (int k = 0; k < K; k += 32) {
        bf16x8 an[4], bn[4];
        const int kn = (k + 32 < K) ? k + 32 : k;
        an[0] = *(const bf16x8*)(ap0 + kn); an[1] = *(const bf16x8*)(ap1 + kn); an[2] = *(const bf16x8*)(ap2 + kn); an[3] = *(const bf16x8*)(ap3 + kn);
        bn[0] = *(const bf16x8*)(bp0 + kn); bn[1] = *(const bf16x8*)(bp1 + kn); bn[2] = *(const bf16x8*)(bp2 + kn); bn[3] = *(const bf16x8*)(bp3 + kn);
#pragma unroll
        for (int i = 0; i < 4; ++i)
#pragma unroll
            for (int j = 0; j < 4; ++j) acc[i][j] = __builtin_amdgcn_mfma_f32_16x16x32_bf16(b[j], a[i], acc[i][j], 0, 0, 0);
#pragma unroll
        for (int i = 0; i < 4; ++i) { a[i] = an[i]; b[i] = bn[i]; }
    }
#pragma unroll
    for (int i = 0; i < 4; ++i)
#pragma unroll
        for (int j = 0; j < 4; ++j) epi(m0 + 16 * i + fr, n0 + 16 * j + 4 * fq, acc[i][j]);
}

template <class AF, class BF, class EF>
__device__ __forceinline__ void gemm_phase_simple(const int M, const int N, const int K, const AF& arow, const BF& brow, const EF& epi) {
    const int lane = threadIdx.x & 63, wid = threadIdx.x >> 6;
    const int gw = blockIdx.x * NWAVES + wid, nw = gridDim.x * NWAVES;
    const int tn = N / 64, tiles = (M / 64) * tn;
    for (int t = gw; t < tiles; t += nw) wave_gemm_64x64(K, arow, brow, epi, (t / tn) * 64, (t % tn) * 64, lane);
}


namespace g8 {
constexpr int BM = 256, BK = 64, HALF = 128, HTB = HALF * BK * 2, STAGE_BYTES = 8 * HTB;
__device__ __forceinline__ int lds_byte(int r, int c) { const int st = (r >> 4) * 2 + (c >> 5), rr = r & 15, cc = c & 31, ob = rr * 64 + cc * 2; return st * 1024 + (ob ^ (((ob >> 9) & 1) << 5)); }
__device__ __forceinline__ void stage_rc(int b, int& R, int& C) { const int st = b / 1024, sb = b % 1024, swz = sb ^ (((sb >> 9) & 1) << 5); R = (st >> 1) * 16 + swz / 64; C = (st & 1) * 32 + (swz % 64) / 2; }
struct Unit { const char* A; const char* B; int r0, c0, aux, nrows; };

struct DenseSched {
    const char* A; const char* B; size_t gsA, gsB; int lda, ldb, nM, nN, nG, G, c;
    __device__ __forceinline__ bool next(int i, Unit& u) const {
        const int nMt = nM * nG, nwg = nMt * nN;
        const long L = (long)i * G + c; if (L >= nwg) return false;
        int wgid = (int)L; { const int q = nwg / 8, r = nwg % 8, xcd = wgid % 8, off = wgid / 8; wgid = (xcd < r ? xcd * (q + 1) : r * (q + 1) + (xcd - r) * q) + off; }
        const int nig = 8 * nN, gid = wgid / nig, fm = gid * 8, gsz = (nMt - fm) < 8 ? (nMt - fm) : 8;
        const int pmt = fm + ((wgid % nig) % gsz), pn = (wgid % nig) / gsz;
        const int g = pmt / nM, pm = pmt % nM;
        u.A = A + (size_t)g * gsA + (size_t)pm * BM * lda * 2; u.B = B + (size_t)g * gsB + (size_t)pn * BM * ldb * 2;
        u.r0 = pm * BM; u.c0 = pn * BM; u.aux = g; u.nrows = BM; return true;
    }
};

struct RaggedSched {
    const char* A; const char* B; const LAS int* tab; size_t gsB; int lda, ldb, nN, G, c;
    __device__ __forceinline__ bool next(int i, Unit& u) const {
        const int nwg = tab[128 + 64] * nN;
        const long L = (long)i * G + c; if (L >= nwg) return false;
        int wgid = (int)L; { const int q = nwg / 8, r = nwg % 8, xcd = wgid % 8, off = wgid / 8; wgid = (xcd < r ? xcd * (q + 1) : r * (q + 1) + (xcd - r) * q) + off; }
        const int rt = wgid / nN, pn = wgid % nN;
        int e = 0;
        while (tab[128 + e + 1] <= rt) ++e;
        const int mt = rt - tab[128 + e], cnt = tab[e], ro = tab[64 + e] + mt * BM;
        u.A = A + (size_t)ro * lda * 2; u.B = B + (size_t)e * gsB + (size_t)pn * BM * ldb * 2;
        u.r0 = ro; u.c0 = pn * BM; u.aux = e; u.nrows = (cnt - mt * BM) < BM ? (cnt - mt * BM) : BM; return true;
    }
};

template <class Sched, class Epi>
__device__ __forceinline__ void gemm_phase(LAS unsigned char* lds, const int K, const int lda, const int ldb, const Sched& S, const Epi& E) {
    int tid = threadIdx.x; asm volatile("" : "+v"(tid));
    const int wid = __builtin_amdgcn_readfirstlane(tid >> 6), lane = tid & 63, wr = wid >> 2, wc = wid & 3, fr = lane & 15, fq = lane >> 4;
    const int nt = K / BK;
    unsigned voffA[2], voffB[2];
#pragma unroll
    for (int i = 0; i < 2; ++i) { int R, C; stage_rc(tid * 16 + i * 8192, R, C); voffA[i] = (unsigned)(R * lda + C) * 2u; voffB[i] = (unsigned)(R * ldb + C) * 2u; }
    const size_t kstep = (size_t)(BK * 2);
    const size_t hstepA = (size_t)HALF * lda * 2, hstepB = (size_t)HALF * ldb * 2;
    const unsigned ldsw = (unsigned)wid * 1024u;
    const int aoff = lds_byte(wr * 64 + fr, fq * 8), boff = lds_byte(wc * 32 + fr, fq * 8);
#define G8_SA(b, h) (((b) * 2 + (h)) * HTB)
#define G8_SB(b, h) ((4 + (b) * 2 + (h)) * HTB)
#define G8_STAGE(bufoff, gbase, voff) do { _Pragma("unroll") for (int _i = 0; _i < 2; ++_i) \
        __builtin_amdgcn_global_load_lds((const unsigned*)((const char*)(gbase) + (voff)[_i]), (LAS unsigned*)(lds + (bufoff) + ldsw + _i * 8192), 16, 0, 0); } while (0)
#define G8_LDA(dst, b, h) do { _Pragma("unroll") for (int m = 0; m < 4; ++m) _Pragma("unroll") for (int k = 0; k < 2; ++k) dst[m][k] = *(const LAS bf16x8*)(lds + G8_SA(b, h) + aoff + m * 2048 + k * 1024); } while (0)
#define G8_LDB(dst, b, h) do { _Pragma("unroll") for (int n = 0; n < 2; ++n) _Pragma("unroll") for (int k = 0; k < 2; ++k) dst[n][k] = *(const LAS bf16x8*)(lds + G8_SB(b, h) + boff + n * 2048 + k * 1024); } while (0)
#define G8_MMA(ai, bj, At, Bt) do { __builtin_amdgcn_s_setprio(1); _Pragma("unroll") for (int m = 0; m < 4; ++m) _Pragma("unroll") for (int n = 0; n < 2; ++n) _Pragma("unroll") for (int k = 0; k < 2; ++k) \
        acc[ai][bj][m][n] = __builtin_amdgcn_mfma_f32_16x16x32_bf16(Bt[n][k], At[m][k], acc[ai][bj][m][n], 0, 0, 0); __builtin_amdgcn_s_setprio(0); } while (0)
#define G8_WAIT_V(n) asm volatile("s_waitcnt vmcnt(" #n ")" ::: "memory")
#define G8_WAIT_L(n) asm volatile("s_waitcnt lgkmcnt(" #n ")" ::: "memory")
#define G8_BAR __builtin_amdgcn_s_barrier()
#define G8_SCHED __builtin_amdgcn_sched_barrier(0)
    Unit cur, nxt; int ui = 0;
    if (!S.next(0, cur)) return;
    f32x4 acc[2][2][4][2];
#pragma unroll
    for (int a = 0; a < 2; ++a)
#pragma unroll
        for (int b = 0; b < 2; ++b)
#pragma unroll
            for (int m = 0; m < 4; ++m)
#pragma unroll
                for (int n = 0; n < 2; ++n) acc[a][b][m][n] = (f32x4){0.f, 0.f, 0.f, 0.f};
    bf16x8 At[4][2], B0[2][2], B1[2][2];
    const char* cA = cur.A; const char* cB = cur.B;
    G8_STAGE(G8_SB(0, 0), cB, voffB); G8_STAGE(G8_SA(0, 0), cA, voffA); G8_STAGE(G8_SB(0, 1), cB + hstepB, voffB); G8_STAGE(G8_SA(0, 1), cA + hstepA, voffA);
    if (wr == 1) G8_BAR;
    G8_WAIT_V(4); G8_BAR;
    G8_STAGE(G8_SB(1, 0), cB + kstep, voffB); G8_STAGE(G8_SA(1, 0), cA + kstep, voffA); G8_STAGE(G8_SB(1, 1), cB + hstepB + kstep, voffB);
    G8_WAIT_V(6); G8_BAR;
    for (;;) {
        const bool has_next = S.next(ui + 1, nxt);
        const char* nA = has_next ? nxt.A : cA; const char* nB = has_next ? nxt.B : cB;
        for (int t = 0; t < nt; t += 2) {
            const bool last = (t == nt - 2);
            const char* a1 = cA + (size_t)(t + 1) * kstep;
            const char* a2 = last ? nA : cA + (size_t)(t + 2) * kstep; const char* b2 = last ? nB : cB + (size_t)(t + 2) * kstep;
            const char* a3 = a2 + kstep; const char* b3 = b2 + kstep;
            G8_LDB(B0, 0, 0); G8_SCHED; G8_LDA(At, 0, 0); G8_STAGE(G8_SA(1, 1), a1 + hstepA, voffA);
            G8_WAIT_L(8); G8_BAR; G8_WAIT_L(0); G8_MMA(0, 0, At, B0); G8_BAR; G8_SCHED;
            G8_LDB(B1, 0, 1); G8_STAGE(G8_SB(0, 0), b2, voffB);
            G8_BAR; G8_WAIT_L(0); G8_MMA(0, 1, At, B1); G8_BAR;
            G8_LDA(At, 0, 1); G8_STAGE(G8_SA(0, 0), a2, voffA);
            G8_BAR; G8_WAIT_L(0); G8_MMA(1, 0, At, B0); G8_BAR; G8_SCHED;
            G8_STAGE(G8_SB(0, 1), b2 + hstepB, voffB);
            G8_WAIT_V(6); G8_BAR; G8_MMA(1, 1, At, B1); G8_BAR;
            G8_LDB(B0, 1, 0); G8_SCHED; G8_LDA(At, 1, 0); G8_STAGE(G8_SA(0, 1), a2 + hstepA, voffA);
            G8_WAIT_L(8); G8_BAR; G8_WAIT_L(0); G8_MMA(0, 0, At, B0); G8_BAR; G8_SCHED;
            G8_LDB(B1, 1, 1); G8_STAGE(G8_SB(1, 0), b3, voffB);
            G8_BAR; G8_WAIT_L(0); G8_MMA(0, 1, At, B1); G8_BAR;
            G8_LDA(At, 1, 1); G8_STAGE(G8_SA(1, 0), a3, voffA);
            G8_BAR; G8_WAIT_L(0); G8_MMA(1, 0, At, B0); G8_BAR; G8_SCHED;
            G8_STAGE(G8_SB(1, 1), b3 + hstepB, voffB);
            G8_WAIT_V(6); G8_BAR; G8_MMA(1, 1, At, B1); G8_BAR;
        }
#pragma unroll
        for (int ai = 0; ai < 2; ++ai)
#pragma unroll
            for (int m = 0; m < 4; ++m)
#pragma unroll
                for (int bj = 0; bj < 2; ++bj)
#pragma unroll
                    for (int n = 0; n < 2; ++n) { E(cur, ai * HALF + wr * 64 + m * 16 + fr, bj * HALF + wc * 32 + n * 16 + 4 * fq, acc[ai][bj][m][n]); asm volatile("" ::: "memory"); }
        if (!has_next) break;
#pragma unroll
        for (int a = 0; a < 2; ++a)
#pragma unroll
            for (int b = 0; b < 2; ++b)
#pragma unroll
                for (int m = 0; m < 4; ++m)
#pragma unroll
                    for (int n = 0; n < 2; ++n) acc[a][b][m][n] = (f32x4){0.f, 0.f, 0.f, 0.f};
        cur = nxt; cA = nA; cB = nB; ++ui;
    }
    G8_WAIT_V(0);
    if (wr == 0) G8_BAR;
    G8_BAR;
#undef G8_SA
#undef G8_SB
#undef G8_STAGE
#undef G8_LDA
#undef G8_LDB
#undef G8_MMA
#undef G8_WAIT_V
#undef G8_WAIT_L
#undef G8_BAR
#undef G8_SCHED
}
}

template <class Epi>
__device__ __forceinline__ void dense_gemm(LAS unsigned char* lds, const bf16_t* A, const bf16_t* B, int M, int N, int K, int lda, int ldb, int nG, size_t gsA, size_t gsB, const Epi& E) {
    g8::DenseSched S; S.A = (const char*)A; S.B = (const char*)B; S.gsA = gsA * 2; S.gsB = gsB * 2; S.lda = lda; S.ldb = ldb; S.nM = M / 256; S.nN = N / 256; S.nG = nG; S.G = gridDim.x; S.c = blockIdx.x;
    g8::gemm_phase(lds, K, lda, ldb, S, E);
}

__device__ __forceinline__ void transpose_cvt_tile_wave(const float* __restrict__ src, bf16_t* __restrict__ dst, const int K, const int N, const int nmul, const int nadd, const int tile, float* lds, const int lane) {
    const int tn = N / 64, k0 = (tile / tn) * 64, n0 = (tile % tn) * 64;
    f32x4 v[16];
#pragma unroll
    for (int i = 0; i < 16; ++i) v[i] = *(const f32x4*)(src + (size_t)(k0 + i * 4 + (lane >> 4)) * N + n0 + (lane & 15) * 4);
#pragma unroll
    for (int i = 0; i < 16; ++i) {
        const int kk = i * 4 + (lane >> 4), c4 = (lane & 15) * 4;
        lds[kk * 65 + c4 + 0] = v[i][0]; lds[kk * 65 + c4 + 1] = v[i][1]; lds[kk * 65 + c4 + 2] = v[i][2]; lds[kk * 65 + c4 + 3] = v[i][3];
    }
    asm volatile("s_waitcnt lgkmcnt(0)" ::: "memory");
    const int kc = (lane & 7) * 8;
#pragma unroll
    for (int it = 0; it < 8; ++it) {
        const int n = it * 8 + (lane >> 3);
        u32x4 w;
        w[0] = pack2(lds[(kc + 0) * 65 + n], lds[(kc + 1) * 65 + n]);
        w[1] = pack2(lds[(kc + 2) * 65 + n], lds[(kc + 3) * 65 + n]);
        w[2] = pack2(lds[(kc + 4) * 65 + n], lds[(kc + 5) * 65 + n]);
        w[3] = pack2(lds[(kc + 6) * 65 + n], lds[(kc + 7) * 65 + n]);
        *(u32x4*)(dst + (size_t)((n0 + n) * nmul + nadd) * K + k0 + kc) = w;
    }
    asm volatile("s_waitcnt lgkmcnt(0)" ::: "memory");
}

__device__ void ssm_prep_job(const Params& p, const int g, const int part, float* lds) {
    f32x2* pw = (f32x2*)lds;
    f32x2* bb = pw + 4224;
    f32x2* cm = bb + 2048;
    float* kt = (float*)(cm + 2048);
    const int t = threadIdx.x;
    bf16_t* BtS = (bf16_t*)(p.ws + OFF_BTS) + (size_t)g * 256 * 512;
    bf16_t* BtY = (bf16_t*)(p.ws + OFF_BTY) + (size_t)g * 512 * UK;
    f32x2* aL = (f32x2*)(p.ws + OFF_J + J_AL);
    __syncthreads();
    for (int i = t; i < 2 * 64 * 33; i += NTHREADS) {
        const int dir = i / (64 * 33), n = (i / 33) % 64, tau = i % 33;
        const double are = (double)p.A_re[(dir * SG + g) * SN + n], aim = (double)p.A_im[(dir * SG + g) * SN + n];
        const double dt = exp((double)p.log_dt[dir * SG + g]);
        const double mag = exp(are * dt * tau), ang = aim * dt * tau;
        pw[i] = (f32x2){(float)(mag * cos(ang)), (float)(mag * sin(ang))};
        if (tau == 32 && part == 0) aL[(dir * SG + g) * SN + n] = pw[i];
    }
    for (int i = t; i < 2 * 64 * 16; i += NTHREADS) {
        const int dir = i / 1024, n = (i / 16) % 64, ci = i % 16;
        const double are = (double)p.A_re[(dir * SG + g) * SN + n], aim = (double)p.A_im[(dir * SG + g) * SN + n];
        const double dt = exp((double)p.log_dt[dir * SG + g]);
        const double mag = exp(are * dt), ang = aim * dt;
        const double nr = mag * cos(ang) - 1.0, ni = mag * sin(ang);
        const double den = are * are + aim * aim;
        const double qr = (nr * are + ni * aim) / den, qi = (ni * are - nr * aim) / den;
        const size_t bi = ((size_t)(dir * SG + g) * SN + n) * SC + ci;
        const double br = (double)p.B_re[bi], bim = (double)p.B_im[bi];
        bb[i] = (f32x2){(float)(qr * br - qi * bim), (float)(qr * bim + qi * br)};
    }
    for (int i = t; i < 2 * 16 * 64; i += NTHREADS) {
        const int dir = i / 1024, co = (i / 64) % 16, n = i % 64;
        const size_t ci_ = ((size_t)(dir * SG + g) * SC + co) * SN + n;
        cm[i] = (f32x2){p.C_re[ci_], p.C_im[ci_]};
    }
    __syncthreads();
    for (int i = t; i < 2 * 32 * 2 * 16; i += NTHREADS) {
        const int dir = i >> 10, tau = (i >> 5) & 31, col = (i >> 4) & 1, ci = i & 15, co = 2 * part + col;
        float s = 0.f;
        for (int n = 0; n < 64; ++n) {
            const f32x2 c = cm[(dir * 16 + co) * 64 + n], a = pw[(dir * 64 + n) * 33 + tau], b = bb[(dir * 64 + n) * 16 + ci];
            const float zr = c[0] * a[0] - c[1] * a[1], zi = c[0] * a[1] + c[1] * a[0];
            s += zr * b[0] - zi * b[1];
        }
        kt[i] = s;
    }
    __syncthreads();
    for (int i = t; i < 32 * 512; i += NTHREADS) {
        const int rr = i >> 9, col = i & 511;
        const int dir = rr >> 4, n = 8 * part + ((rr >> 1) & 7), ri = rr & 1, s = col >> 4, ci = col & 15;
        const int tau = dir == 0 ? (LC - 1 - s) : s;
        const f32x2 a = pw[(dir * 64 + n) * 33 + tau], b = bb[(dir * 64 + n) * 16 + ci];
        const float v = ri == 0 ? (a[0] * b[0] - a[1] * b[1]) : (a[0] * b[1] + a[1] * b[0]);
        BtS[(size_t)((dir * 64 + n) * 2 + ri) * 512 + col] = f2bf(v);
    }
    for (int rr = 0; rr < 64; ++rr) {
        const int tt = rr >> 1, col = rr & 1, co = 2 * part + col;
        for (int kk = t; kk < UK; kk += NTHREADS) {
            float v;
            if (kk < 512) {
                const int s = kk >> 4, ci = kk & 15;
                if (s < tt) v = kt[((0 * 32 + (tt - s)) * 2 + col) * 16 + ci];
                else if (s > tt) v = kt[((1 * 32 + (s - tt)) * 2 + col) * 16 + ci];
                else v = kt[((0 * 32 + 0) * 2 + col) * 16 + ci] + kt[((1 * 32 + 0) * 2 + col) * 16 + ci];
            } else {
                const int q = kk - 512, dir = q >> 7, n = (q >> 1) & 63, ri = q & 1;
                const int tau = dir == 0 ? (tt + 1) : (LC - tt);
                const f32x2 c = cm[(dir * 16 + co) * 64 + n], a = pw[(dir * 64 + n) * 33 + tau];
                const float zr = c[0] * a[0] - c[1] * a[1], zi = c[0] * a[1] + c[1] * a[0];
                v = ri == 0 ? zr : -zi;
            }
            BtY[(size_t)(tt * 16 + co) * UK + kk] = f2bf(v);
        }
    }
}

__device__ __forceinline__ void load_row(const float* row, const int lane, f32x4 (&v)[4]) {
#pragma unroll
    for (int i = 0; i < 4; ++i) v[i] = *(const f32x4*)(row + 4 * lane + 256 * i);
}
__device__ __forceinline__ float row_inv_rms(const f32x4 (&v)[4]) {
    float s = 0.f;
#pragma unroll
    for (int i = 0; i < 4; ++i) s += v[i][0] * v[i][0] + v[i][1] * v[i][1] + v[i][2] * v[i][2] + v[i][3] * v[i][3];
    s = wave_sum(s);
    return 1.0f / sqrtf(s * (1.0f / 1024.0f) + 1e-6f);
}

__global__ void __launch_bounds__(NTHREADS) fwd_megakernel(const Params p) {
    __shared__ __attribute__((aligned(16))) unsigned char smem[SMEM_BYTES];
    const int tid = threadIdx.x, lane = tid & 63, wid = tid >> 6;
    const int gw = blockIdx.x * NWAVES + wid, nw = gridDim.x * NWAVES;
    const int gt = blockIdx.x * NTHREADS + tid, nt = gridDim.x * NTHREADS;
    unsigned char* ws = p.ws;
    bf16_t* WguT = (bf16_t*)(ws + OFF_WGUT); bf16_t* WdT = (bf16_t*)(ws + OFF_WDT);
    bf16_t* WinT = (bf16_t*)(ws + OFF_WINT); bf16_t* WpT = (bf16_t*)(ws + OFF_WPT); bf16_t* WglT = (bf16_t*)(ws + OFF_WGLT);
    bf16_t* WsoT = (bf16_t*)(ws + OFF_WSOT); bf16_t* WoT = (bf16_t*)(ws + OFF_WOT);
    bf16_t* BtS = (bf16_t*)(ws + OFF_BTS); bf16_t* BtY = (bf16_t*)(ws + OFF_BTY);
    bf16_t* DT = (bf16_t*)(ws + OFF_C); bf16_t* ybuf = (bf16_t*)(ws + OFF_C);
    bf16_t* hn = (bf16_t*)(ws + OFF_D); bf16_t* Fb = (bf16_t*)(ws + OFF_D); bf16_t* hn2 = (bf16_t*)(ws + OFF_D);
    bf16_t* gates = (bf16_t*)(ws + OFF_E); bf16_t* act = (bf16_t*)(ws + OFF_E + 65 * MiB);
    bf16_t* uT = (bf16_t*)(ws + OFF_FG); float* Sst = (float*)(ws + OFF_FG + 16 * MiB); bf16_t* m1 = (bf16_t*)(ws + OFF_FG);
    bf16_t* Ucomb = (bf16_t*)(ws + OFF_H);
    bf16_t* yg = (bf16_t*)(ws + OFF_I); bf16_t* ys2 = (bf16_t*)(ws + OFF_I + 16 * MiB);
    unsigned* cnt = (unsigned*)(ws + OFF_J + J_CNT);
    const f32x2* aL = (const f32x2*)(ws + OFF_J + J_AL);
    f32x2* tokw = (f32x2*)(ws + OFF_J + J_TOKW);
    int* tokinfo = (int*)(ws + OFF_J + J_TOKINFO);
    int* slot_asg = (int*)(ws + OFF_J + J_SLOTASG);
    float* slot_w = (float*)(ws + OFF_J + J_SLOTW);
    bf16_t* WrT = (bf16_t*)(ws + OFF_J + J_WRT);
    bf16_t* Xg = (bf16_t*)(ws + OFF_E);
    float* x2 = p.out;
    LAS unsigned char* ldsp = (LAS unsigned char*)smem;
    if (tid == 0) { ((volatile LAS unsigned*)(ldsp + BAR_LDS_OFF))[0] = 0u; ((volatile LAS unsigned*)(ldsp + BAR_LDS_OFF))[1] = 0u; }
    __syncthreads();
    const XcdBarrier bar = xcd_barrier_post((unsigned*)(ws + OFF_J + J_BAR), (volatile LAS unsigned*)(ldsp + BAR_LDS_OFF));
#define GRID_SYNC() xcd_barrier(bar)

    for (int _rep = 0; _rep < REP0; ++_rep) {
    {
        {
            float* ldsw = (float*)smem + (size_t)wid * (64 * 65);
            const int T_WIN = 16 * 48, T_GLU = 8 * 8, T_SSO = 8 * 16, T_WO = 16 * 16, T_EG = 64 * 16 * 8, T_ED = 64 * 8 * 16;
            const int total = T_WIN + T_GLU + T_SSO + T_WO + 2 * T_EG + T_ED;
            for (int j = gw; j < total; j += nw) {
                int q = j;
                if (q < T_WIN) { transpose_cvt_tile_wave(p.w_in, WinT, 1024, 3072, 1, 0, q, ldsw, lane); continue; } q -= T_WIN;
                if (q < T_GLU) { transpose_cvt_tile_wave(p.w_glu, WglT, 512, 512, 1, 0, q, ldsw, lane); continue; } q -= T_GLU;
                if (q < T_SSO) { transpose_cvt_tile_wave(p.w_sso, WsoT, 512, 1024, 1, 0, q, ldsw, lane); continue; } q -= T_SSO;
                if (q < T_WO) { transpose_cvt_tile_wave(p.w_out, WoT, 1024, 1024, 1, 0, q, ldsw, lane); continue; } q -= T_WO;
                if (q < T_EG) { const int e = q / 128; transpose_cvt_tile_wave(p.e_gate + (size_t)e * 1024 * 512, WguT + (size_t)e * 1024 * 1024, 1024, 512, 2, 0, q % 128, ldsw, lane); continue; } q -= T_EG;
                if (q < T_EG) { const int e = q / 128; transpose_cvt_tile_wave(p.e_up + (size_t)e * 1024 * 512, WguT + (size_t)e * 1024 * 1024, 1024, 512, 2, 1, q % 128, ldsw, lane); continue; } q -= T_EG;
                { const int e = q / 128; transpose_cvt_tile_wave(p.e_down + (size_t)e * 512 * 1024, WdT + (size_t)e * 1024 * 512, 512, 1024, 1, 0, q % 128, ldsw, lane); }
            }
        }
        __syncthreads();
        {
            f32x2* cst = (f32x2*)smem;
            if (tid < 128) { float sv, cv; sincospif((float)tid * (1.0f / 64.0f), &sv, &cv); cst[tid] = (f32x2){cv, sv}; }
            __syncthreads();
            for (int i = gt; i < 1024 * 1024; i += nt) {
                const int d = i & 1023, kk = i >> 10;
                const int g = kk >> 8, c = (kk >> 1) & 127, ri = kk & 1;
                const float* wp = p.w_fo + (size_t)(g * 128) * 1024 + d;
                float s = 0.f;
#pragma unroll 8
                for (int m = 0; m < 128; ++m) s += cst[(c * m) & 127][ri] * wp[(size_t)m * 1024];
                WpT[(size_t)d * 1024 + kk] = f2bf(s * 0.08838834764831845f);
            }
            __syncthreads();
        }
        for (int i = gt; i < 80 * 2048; i += nt) {
            const int n = i >> 11, k = i & 2047, kk = k & 1023;
            const float w = n < 64 ? p.re_w[kk * 64 + n] : (n < 72 ? p.rg_w[kk * 8 + (n - 64)] : 0.f);
            const bf16_t hi = f2bf(w);
            WrT[i] = k < 1024 ? hi : f2bf(w - bf2f(hi));
        }
        for (int i = gt; i < 8192 * 512; i += nt) {
            const int row = i >> 9, l0 = (i & 511) * 8;
            const int k = row >> 1, ri = row & 1;
            unsigned w[4];
#pragma unroll
            for (int j = 0; j < 4; ++j) {
                float v[2];
#pragma unroll
                for (int h = 0; h < 2; ++h) {
                    const int l = l0 + 2 * j + h;
                    const float ang = (float)((k * l) & 4095) * (1.0f / 2048.0f);
                    v[h] = (ri ? -sinpif(ang) : cospif(ang)) * (1.0f / 64.0f);
                }
                w[j] = pack2(v[0], v[1]);
            }
            *(u32x4*)(DT + (size_t)row * 4096 + l0) = (u32x4){w[0], w[1], w[2], w[3]};
        }
        for (int j = blockIdx.x; j < SG * 8; j += gridDim.x) ssm_prep_job(p, j >> 3, j & 7, (float*)smem);
        for (int r = gw; r < T; r += nw) {
            f32x4 v[4]; load_row(p.x + (size_t)r * D, lane, v);
            const float inv = row_inv_rms(v);
#pragma unroll
            for (int i = 0; i < 4; ++i) {
                const f32x4 gg = *(const f32x4*)(p.mix_g + 4 * lane + 256 * i);
                u32x2 w; w[0] = pack2(v[i][0] * inv * gg[0], v[i][1] * inv * gg[1]); w[1] = pack2(v[i][2] * inv * gg[2], v[i][3] * inv * gg[3]);
                *(u32x2*)(hn + (size_t)r * D + 4 * lane + 256 * i) = w;
            }
        }
    }
    GRID_SYNC();
    }
    for (int _rep = 0; _rep < REP1; ++_rep) {
    {
        auto arow = [=](int m) { return hn + (size_t)m * D; };
        auto brow = [=](int n) { return WinT + (size_t)n * D; };
        auto epi = [=](int m, int n4, f32x4 v) {
            if (n4 < FW) {
                const int b = m >> 12, l = m & 4095;
#pragma unroll
                for (int j = 0; j < 4; ++j) uT[((size_t)(b * FW + n4 + j) << 12) + l] = f2bf(v[j]);
            } else if (n4 < FW + SW) {
                const int ch = n4 - FW, g = ch >> 4, ci = ch & 15;
                u32x2 w; w[0] = pack2(v[0], v[1]); w[1] = pack2(v[2], v[3]);
                *(u32x2*)(Ucomb + ((size_t)(g * ROWS + (m >> 5))) * UK + (m & 31) * 16 + ci) = w;
            } else {
                u32x2 w; w[0] = pack2(sigmoidf_(v[0]), sigmoidf_(v[1])); w[1] = pack2(sigmoidf_(v[2]), sigmoidf_(v[3]));
                *(u32x2*)(gates + (size_t)m * 2048 + (n4 - 1024)) = w;
            }
        };
        auto E = [=](const g8::Unit& u, int rl, int cl, f32x4 v) { epi(u.r0 + rl, u.c0 + cl, v); };
        dense_gemm(ldsp, hn, WinT, T, INW, D, D, D, 1, 0, 0, E);
    }
    GRID_SYNC();
    }
    for (int _rep = 0; _rep < REP2; ++_rep) {
    {
        {
            auto E = [=](const g8::Unit& u, int rl, int cl, f32x4 v) {
                const int b = u.aux, m = u.r0 + rl, k0 = (u.c0 + cl) >> 1;
                *(unsigned*)(Fb + ((size_t)(b * SEQ + k0)) * 1024 + 2 * m) = pack2(v[0], v[1]);
                *(unsigned*)(Fb + ((size_t)(b * SEQ + k0 + 1)) * 1024 + 2 * m) = pack2(v[2], v[3]);
            };
            dense_gemm(ldsp, uT, DT, FW, 2 * SEQ, SEQ, SEQ, SEQ, BATCH, (size_t)FW * SEQ, 0, E);
        }
        {
            auto E = [=](const g8::Unit& u, int rl, int cl, f32x4 v) { *(f32x4*)(Sst + (size_t)(u.aux * ROWS + u.r0 + rl) * 256 + u.c0 + cl) = v; };
            dense_gemm(ldsp, Ucomb, BtS, ROWS, 256, 512, UK, 512, SG, (size_t)ROWS * UK, (size_t)256 * 512, E);
        }
    }
    GRID_SYNC();
    }
    for (int _rep = 0; _rep < REP3; ++_rep) {
    {
        for (int i = gt; i < BATCH * SG * 2 * SN; i += nt) {
            const int n = i & 63, dir = (i >> 6) & 1, g = (i >> 7) & 31, b = i >> 12;
            const f32x2 a = aL[(dir * SG + g) * SN + n];
            float hr = 0.f, hi = 0.f;
            for (int j0 = 0; j0 < NCH; j0 += 16) {
                f32x2 s[16];
#pragma unroll
                for (int q = 0; q < 16; ++q) {
                    const int jj = j0 + q, j = dir == 0 ? jj : (NCH - 1 - jj);
                    s[q] = *(const f32x2*)(Sst + ((size_t)g * ROWS + b * NCH + j) * 256 + (dir * 64 + n) * 2);
                }
#pragma unroll
                for (int q = 0; q < 16; ++q) {
                    const int jj = j0 + q, j = dir == 0 ? jj : (NCH - 1 - jj);
                    const size_t row = (size_t)g * ROWS + b * NCH + j;
                    *(unsigned*)(Ucomb + row * UK + 512 + (dir * 64 + n) * 2) = pack2(hr, hi);
                    const float nr = a[0] * hr - a[1] * hi + s[q][0], ni = a[0] * hi + a[1] * hr + s[q][1];
                    hr = nr; hi = ni;
                }
            }
        }
    }
    GRID_SYNC();
    }
    for (int _rep = 0; _rep < REP4; ++_rep) {
    {
        {
            auto E = [=](const g8::Unit& u, int rl, int cl, f32x4 v) {
                const int g = u.aux, m = u.r0 + rl, n4 = u.c0 + cl;
                const int tt = n4 >> 4, co = n4 & 15, tok = m * LC + tt, ch = g * 16 + co;
                const u32x2 uu = *(const u32x2*)(Ucomb + (size_t)(g * ROWS + m) * UK + n4);
                const f32x4 dd = *(const f32x4*)(p.ssm_D + ch);
                const float u0 = __uint_as_float(uu[0] << 16), u1 = __uint_as_float(uu[0] & 0xffff0000u), u2 = __uint_as_float(uu[1] << 16), u3 = __uint_as_float(uu[1] & 0xffff0000u);
                u32x2 w; w[0] = pack2(gelu_tanh(v[0] + dd[0] * u0), gelu_tanh(v[1] + dd[1] * u1)); w[1] = pack2(gelu_tanh(v[2] + dd[2] * u2), gelu_tanh(v[3] + dd[3] * u3));
                *(u32x2*)(yg + (size_t)tok * SW + ch) = w;
            };
            dense_gemm(ldsp, Ucomb, BtY, ROWS, 512, UK, UK, UK, SG, (size_t)ROWS * UK, (size_t)512 * UK, E);
        }
        {
            auto arow = [=](int m) { return Fb + (size_t)m * 1024; };
            auto brow = [=](int n) { return WpT + (size_t)n * 1024; };
            auto epi = [=](int m, int n4, f32x4 v) {
                const u32x2 gg = *(const u32x2*)(gates + (size_t)m * 2048 + n4);
                const float g0 = __uint_as_float(gg[0] << 16), g1 = __uint_as_float(gg[0] & 0xffff0000u), g2 = __uint_as_float(gg[1] << 16), g3 = __uint_as_float(gg[1] & 0xffff0000u);
                u32x2 w; w[0] = pack2(g0 * v[0], g1 * v[1]); w[1] = pack2(g2 * v[2], g3 * v[3]);
                *(u32x2*)(m1 + (size_t)m * D + n4) = w;
            };
            auto E = [=](const g8::Unit& u, int rl, int cl, f32x4 v) { epi(u.r0 + rl, u.c0 + cl, v); };
            dense_gemm(ldsp, Fb, WpT, T, D, 1024, 1024, 1024, 1, 0, 0, E);
        }
    }
    GRID_SYNC();
    }
    for (int _rep = 0; _rep < REP5; ++_rep) {
    {
        auto arow = [=](int m) { return yg + (size_t)m * SW; };
        auto brow = [=](int n) { return WglT + (size_t)n * SW; };
        auto epi = [=](int m, int n4, f32x4 v) {
            const u32x2 yy = *(const u32x2*)(yg + (size_t)m * SW + n4);
            const float y0 = __uint_as_float(yy[0] << 16), y1 = __uint_as_float(yy[0] & 0xffff0000u), y2 = __uint_as_float(yy[1] << 16), y3 = __uint_as_float(yy[1] & 0xffff0000u);
            u32x2 w; w[0] = pack2(y0 * sigmoidf_(v[0]), y1 * sigmoidf_(v[1])); w[1] = pack2(y2 * sigmoidf_(v[2]), y3 * sigmoidf_(v[3]));
            *(u32x2*)(ys2 + (size_t)m * SW + n4) = w;
        };
        auto E = [=](const g8::Unit& u, int rl, int cl, f32x4 v) { epi(u.r0 + rl, u.c0 + cl, v); };
        dense_gemm(ldsp, yg, WglT, T, SW, SW, SW, SW, 1, 0, 0, E);
    }
    GRID_SYNC();
    }
    {
        auto arow = [=](int m) { return ys2 + (size_t)m * SW; };
        auto brow = [=](int n) { return WsoT + (size_t)n * SW; };
        auto epi = [=](int m, int n4, f32x4 v) {
            const u32x2 gg = *(const u32x2*)(gates + (size_t)m * 2048 + 1024 + n4);
            const u32x2 mm = *(const u32x2*)(m1 + (size_t)m * D + n4);
            const float g0 = __uint_as_float(gg[0] << 16), g1 = __uint_as_float(gg[0] & 0xffff0000u), g2 = __uint_as_float(gg[1] << 16), g3 = __uint_as_float(gg[1] & 0xffff0000u);
            const float a0 = __uint_as_float(mm[0] << 16), a1 = __uint_as_float(mm[0] & 0xffff0000u), a2 = __uint_as_float(mm[1] << 16), a3 = __uint_as_float(mm[1] & 0xffff0000u);
            u32x2 w; w[0] = pack2(a0 + g0 * v[0], a1 + g1 * v[1]); w[1] = pack2(a2 + g2 * v[2], a3 + g3 * v[3]);
            *(u32x2*)(m1 + (size_t)m * D + n4) = w;
        };
        auto E = [=](const g8::Unit& u, int rl, int cl, f32x4 v) { epi(u.r0 + rl, u.c0 + cl, v); };
        dense_gemm(ldsp, ys2, WsoT, T, D, SW, SW, SW, 1, 0, 0, E);
    }
    GRID_SYNC();
    for (int _rep = 0; _rep < REP7; ++_rep) {
    {
        auto arow = [=](int m) { return m1 + (size_t)m * D; };
        auto brow = [=](int n) { return WoT + (size_t)n * D; };
        auto epi = [=](int m, int n4, f32x4 v) {
            const f32x4 xx = *(const f32x4*)(p.x + (size_t)m * D + n4);
            *(f32x4*)(x2 + (size_t)m * D + n4) = xx + v;
        };
        auto E = [=](const g8::Unit& u, int rl, int cl, f32x4 v) { epi(u.r0 + rl, u.c0 + cl, v); };
        dense_gemm(ldsp, m1, WoT, T, D, D, D, D, 1, 0, 0, E);
    }
    GRID_SYNC();
    }
    {
        LAS unsigned char* hrow = ldsp;
        LAS float* part = (LAS float*)(ldsp + 66048);
        const int fr = lane & 15, fq = lane >> 4;
        for (int tb = blockIdx.x; tb < T / 32; tb += gridDim.x) {
            const int tok0 = tb * 32;
            f32x4 xv[4][4];
#pragma unroll
            for (int q = 0; q < 4; ++q) load_row(x2 + (size_t)(tok0 + wid * 4 + q) * D, lane, xv[q]);
#pragma unroll
            for (int q = 0; q < 4; ++q) {
                const int rl = wid * 4 + q, r = tok0 + rl;
                const float inv = row_inv_rms(xv[q]);
#pragma unroll
                for (int i = 0; i < 4; ++i) {
                    const f32x4 gg = *(const f32x4*)(p.ffn_g + 4 * lane + 256 * i);
                    u32x2 w; w[0] = pack2(xv[q][i][0] * inv * gg[0], xv[q][i][1] * inv * gg[1]); w[1] = pack2(xv[q][i][2] * inv * gg[2], xv[q][i][3] * inv * gg[3]);
                    *(u32x2*)(hn2 + (size_t)r * D + 4 * lane + 256 * i) = w;
                    *(LAS u32x2*)(hrow + rl * 2064 + (4 * lane + 256 * i) * 2) = w;
                }
            }
            __syncthreads();
            {
                const int mtl = wid & 1, kq = wid >> 1;
                const LAS unsigned char* ap = hrow + (mtl * 16 + fr) * 2064 + ((kq & 1) * 512 + fq * 8) * 2;
                const bf16_t* bp = WrT + (size_t)fr * 2048 + kq * 512 + fq * 8;
                f32x4 acc[5];
#pragma unroll
                for (int n = 0; n < 5; ++n) acc[n] = (f32x4){0.f, 0.f, 0.f, 0.f};
#pragma unroll
                for (int h = 0; h < 4; ++h) {
                    bf16x8 bfr[4][5];
#pragma unroll
                    for (int ks = 0; ks < 4; ++ks)
#pragma unroll
                        for (int n = 0; n < 5; ++n) bfr[ks][n] = *(const bf16x8*)(bp + (size_t)n * 16 * 2048 + (h * 4 + ks) * 32);
#pragma unroll
                    for (int ks = 0; ks < 4; ++ks) {
                        const bf16x8 a = *(const LAS bf16x8*)(ap + (h * 4 + ks) * 64);
#pragma unroll
                        for (int n = 0; n < 5; ++n) acc[n] = __builtin_amdgcn_mfma_f32_16x16x32_bf16(bfr[ks][n], a, acc[n], 0, 0, 0);
                    }
                }
#pragma unroll
                for (int n = 0; n < 5; ++n) *(LAS f32x4*)(part + (kq * 32 + mtl * 16 + fr) * 80 + n * 16 + 4 * fq) = acc[n];
            }
            __syncthreads();
            if (tid < 32) {
                const LAS float* L = part + tid * 80;
                float gv[8];
#pragma unroll
                for (int i = 0; i < 8; ++i) gv[i] = ((L[64 + i] + L[2560 + 64 + i]) + (L[5120 + 64 + i] + L[7680 + 64 + i])) + p.rg_b[i];
                int gi = 0; float gm = gv[0];
#pragma unroll
                for (int i = 1; i < 8; ++i) if (gv[i] > gm) { gm = gv[i]; gi = i; }
                float den = 0.f;
#pragma unroll
                for (int i = 0; i < 8; ++i) den += __expf(gv[i] - gm);
                const float pg = 1.0f / den;
                float ev[8];
#pragma unroll
                for (int i = 0; i < 8; ++i) { const int c = gi * 8 + i; ev[i] = ((L[c] + L[2560 + c]) + (L[5120 + c] + L[7680 + c])) + p.re_b[c]; }
                int i1 = 0; float v1 = ev[0];
#pragma unroll
                for (int i = 1; i < 8; ++i) if (ev[i] > v1) { v1 = ev[i]; i1 = i; }
                int i2 = -1; float v2 = -3.0e38f;
#pragma unroll
                for (int i = 0; i < 8; ++i) if (i != i1 && ev[i] > v2) { v2 = ev[i]; i2 = i; }
                const float e2 = __expf(v2 - v1), w1 = pg / (1.0f + e2), w2 = pg * e2 / (1.0f + e2);
                const int tok = tok0 + tid, ex1 = gi * 8 + i1, ex2 = gi * 8 + i2;
                const int p1 = (int)atomicAdd(&cnt[ex1], 1u), p2 = (int)atomicAdd(&cnt[ex2], 1u);
                *(int4*)(tokinfo + 4 * tok) = make_int4(ex1, p1, ex2, p2);
                tokw[tok] = (f32x2){w1, w2};
            }
            __syncthreads();
        }
    }
    GRID_SYNC();
    LAS int* tab = (LAS int*)(ldsp + TAB_LDS_OFF);
    for (int _rep = 0; _rep < REP9; ++_rep) {
    {
        if (tid == 0) {
            int ro = 0, tp = 0;
            for (int e = 0; e < NE; ++e) { const int c = (int)cnt[e]; tab[e] = c; tab[64 + e] = ro; tab[128 + e] = tp; ro += c; tp += (c + 255) / 256; }
            tab[128 + NE] = tp;
        }
        __syncthreads();
        for (int tok = gw; tok < T; tok += nw) {
            const int4 info = *(const int4*)(tokinfo + 4 * tok); const f32x2 w = tokw[tok];
            const int s1 = tab[64 + info.x] + info.y, s2 = tab[64 + info.z] + info.w;
            const u32x4 a = *(const u32x4*)(hn2 + (size_t)tok * D + lane * 16), b = *(const u32x4*)(hn2 + (size_t)tok * D + lane * 16 + 8);
            *(u32x4*)(Xg + (size_t)s1 * D + lane * 16) = a; *(u32x4*)(Xg + (size_t)s1 * D + lane * 16 + 8) = b;
            *(u32x4*)(Xg + (size_t)s2 * D + lane * 16) = a; *(u32x4*)(Xg + (size_t)s2 * D + lane * 16 + 8) = b;
            if (lane == 0) { slot_asg[s1] = tok * 2; slot_asg[s2] = tok * 2 + 1; slot_w[s1] = w[0]; slot_w[s2] = w[1]; }
        }
    }
    GRID_SYNC();
    }
    for (int _rep = 0; _rep < REP10; ++_rep) {
    {
        auto E = [=](const g8::Unit& u, int rl, int cl, f32x4 v) {
            if (rl < u.nrows) {
                const float s0 = v[0] * sigmoidf_(v[0]) * v[1], s1 = v[2] * sigmoidf_(v[2]) * v[3];
                *(unsigned*)(act + (size_t)(u.r0 + rl) * DE + ((u.c0 + cl) >> 1)) = pack2(s0, s1);
            }
        };
        g8::RaggedSched S; S.A = (const char*)Xg; S.B = (const char*)WguT; S.tab = tab; S.gsB = (size_t)1024 * 1024 * 2; S.lda = D; S.ldb = D; S.nN = 4; S.G = gridDim.x; S.c = blockIdx.x;
        g8::gemm_phase(ldsp, D, D, D, S, E);
    }
    GRID_SYNC();
    }
    for (int _rep = 0; _rep < REP11; ++_rep) {
    {
        auto E = [=](const g8::Unit& u, int rl, int cl, f32x4 v) {
            if (rl < u.nrows) {
                const int as = slot_asg[u.r0 + rl]; const float w = slot_w[u.r0 + rl];
                u32x2 o; o[0] = pack2(w * v[0], w * v[1]); o[1] = pack2(w * v[2], w * v[3]);
                *(u32x2*)(ybuf + (size_t)as * D + u.c0 + cl) = o;
            }
        };
        g8::RaggedSched S; S.A = (const char*)act; S.B = (const char*)WdT; S.tab = tab; S.gsB = (size_t)1024 * 512 * 2; S.lda = DE; S.ldb = DE; S.nN = 4; S.G = gridDim.x; S.c = blockIdx.x;
        g8::gemm_phase(ldsp, DE, DE, DE, S, E);
    }
    GRID_SYNC();
    }
    {
        for (int r = gw; r < T; r += nw) {
            f32x4 v[4]; load_row(x2 + (size_t)r * D, lane, v);
#pragma unroll
            for (int i = 0; i < 4; ++i) {
                const u32x2 y0 = *(const u32x2*)(ybuf + (size_t)(2 * r) * D + 4 * lane + 256 * i);
                const u32x2 y1 = *(const u32x2*)(ybuf + (size_t)(2 * r + 1) * D + 4 * lane + 256 * i);
                v[i][0] += __uint_as_float(y0[0] << 16) + __uint_as_float(y1[0] << 16);
                v[i][1] += __uint_as_float(y0[0] & 0xffff0000u) + __uint_as_float(y1[0] & 0xffff0000u);
                v[i][2] += __uint_as_float(y0[1] << 16) + __uint_as_float(y1[1] << 16);
                v[i][3] += __uint_as_float(y0[1] & 0xffff0000u) + __uint_as_float(y1[1] & 0xffff0000u);
            }
            const float inv = row_inv_rms(v);
#pragma unroll
            for (int i = 0; i < 4; ++i) {
                const f32x4 gg = *(const f32x4*)(p.fin_g + 4 * lane + 256 * i);
                *(f32x4*)(p.out + (size_t)r * D + 4 * lane + 256 * i) = (f32x4){v[i][0] * inv * gg[0], v[i][1] * inv * gg[1], v[i][2] * inv * gg[2], v[i][3] * inv * gg[3]};
            }
        }
    }
}

extern "C" void kernel_launch(void* const* d_in, const int* in_sizes, int n_in, void* d_out, int out_size, void* d_ws, size_t ws_size, hipStream_t stream) {
    (void)in_sizes; (void)n_in; (void)out_size;
    static int grid_blocks = 0;
    if (!grid_blocks) {
        int dev = 0, cus = 0, per_cu = 0;
        (void)hipGetDevice(&dev);
        (void)hipDeviceGetAttribute(&cus, hipDeviceAttributeMultiprocessorCount, dev);
        (void)hipOccupancyMaxActiveBlocksPerMultiprocessor(&per_cu, fwd_megakernel, NTHREADS, 0);
        if (per_cu > 1) per_cu = 1;
        if (per_cu < 1) per_cu = 1;
        grid_blocks = cus * per_cu;
    }
    if (ws_size < WS_NEED) { fprintf(stderr, "workspace too small: %zu < %zu\n", ws_size, (size_t)WS_NEED); return; }
    Params p{};
    p.x = (const float*)d_in[0]; p.mix_g = (const float*)d_in[1]; p.w_in = (const float*)d_in[2]; p.w_fo = (const float*)d_in[3];
    p.A_re = (const float*)d_in[4]; p.A_im = (const float*)d_in[5]; p.log_dt = (const float*)d_in[6];
    p.B_re = (const float*)d_in[7]; p.B_im = (const float*)d_in[8]; p.C_re = (const float*)d_in[9]; p.C_im = (const float*)d_in[10];
    p.ssm_D = (const float*)d_in[11]; p.w_glu = (const float*)d_in[12]; p.w_sso = (const float*)d_in[13]; p.w_out = (const float*)d_in[14];
    p.ffn_g = (const float*)d_in[15]; p.rg_w = (const float*)d_in[16]; p.rg_b = (const float*)d_in[17]; p.re_w = (const float*)d_in[18]; p.re_b = (const float*)d_in[19];
    p.e_gate = (const float*)d_in[20]; p.e_up = (const float*)d_in[21]; p.e_down = (const float*)d_in[22]; p.fin_g = (const float*)d_in[23];
    p.out = (float*)d_out; p.ws = (unsigned char*)d_ws;
    (void)hipMemsetAsync((unsigned char*)d_ws + OFF_J, 0, J_ZERO_BYTES, stream);
    void* args[] = {&p};
    hipError_t e = hipLaunchCooperativeKernel((const void*)fwd_megakernel, dim3(grid_blocks), dim3(NTHREADS), args, 0, stream);
    if (e != hipSuccess) fprintf(stderr, "cooperative launch failed: %s (grid %d)\n", hipGetErrorString(e), grid_blocks);
}
```

```cpp
#include <hip/hip_runtime.h>
#include <cstdio>

typedef unsigned short bf16_t;
typedef short bf16x8 __attribute__((ext_vector_type(8)));
typedef float f32x4 __attribute__((ext_vector_type(4)));
typedef float f32x2 __attribute__((ext_vector_type(2)));
typedef unsigned u32x2 __attribute__((ext_vector_type(2)));
typedef unsigned u32x4 __attribute__((ext_vector_type(4)));

#ifndef REP0
#define REP0 1
#endif
#ifndef REP1
#define REP1 1
#endif
#ifndef REP2
#define REP2 1
#endif
#ifndef REP3
#define REP3 1
#endif
#ifndef REP4
#define REP4 1
#endif
#ifndef REP5
#define REP5 1
#endif
#ifndef REP7
#define REP7 1
#endif
#ifndef REP9
#define REP9 1
#endif
#ifndef REP10
#define REP10 1
#endif
#ifndef REP11
#define REP11 1
#endif
constexpr int D = 1024, BATCH = 4, SEQ = 4096, T = BATCH * SEQ;
constexpr int FW = 512, SW = 512, INW = 3072;
constexpr int SG = 32, SC = 16, SN = 64;
constexpr int LC = 32, NCH = SEQ / LC, ROWS = T / LC;
constexpr int UK = 768;
constexpr int NE = 64, DE = 512, LISTCAP = 16384;
constexpr int NTHREADS = 512, NWAVES = 8;
constexpr int SMEM_BYTES = 136 * 1024;

constexpr size_t MiB = 1024 * 1024;
constexpr size_t OFF_WGUT = 0;
constexpr size_t OFF_WDT  = OFF_WGUT + 128 * MiB;
constexpr size_t OFF_WINT = OFF_WDT + 64 * MiB;
constexpr size_t OFF_WPT  = OFF_WINT + 6 * MiB;
constexpr size_t OFF_WGLT = OFF_WPT + 2 * MiB;
constexpr size_t OFF_WSOT = OFF_WGLT + MiB / 2;
constexpr size_t OFF_WOT  = OFF_WSOT + 1 * MiB;
constexpr size_t OFF_BTS  = OFF_WOT + 2 * MiB;
constexpr size_t OFF_BTY  = OFF_BTS + 8 * MiB;
constexpr size_t OFF_C    = OFF_BTY + 24 * MiB;
constexpr size_t OFF_D    = OFF_C + 64 * MiB;
constexpr size_t OFF_E    = OFF_D + 32 * MiB;
constexpr size_t OFF_FG   = OFF_E + 64 * MiB;
constexpr size_t OFF_H    = OFF_FG + 32 * MiB;
constexpr size_t OFF_I    = OFF_H + 24 * MiB;
constexpr size_t OFF_J    = OFF_I + 32 * MiB;
constexpr size_t J_CNT   = 0;
constexpr size_t J_BAR   = 4096;
constexpr size_t J_ZERO_BYTES = 20480;
constexpr size_t J_AL    = 32768;
constexpr size_t J_TOKW    = 65536;
constexpr size_t J_TOKINFO = 196608;
constexpr size_t J_SLOTASG = 458752;
constexpr size_t J_SLOTW   = 655360;
constexpr size_t J_WRT     = 1048576;
constexpr size_t J_BTA     = 1441792;
constexpr size_t J_BTC     = 1507328;
constexpr size_t J_TW      = 1638400;
constexpr size_t WS_NEED = OFF_J + 2 * MiB;
constexpr int TAB_LDS_OFF = 131072;
constexpr int BAR_LDS_OFF = SMEM_BYTES - 16;

struct Params {
    const float* x; const float* mix_g; const float* w_in; const float* w_fo;
    const float* A_re; const float* A_im; const float* log_dt; const float* B_re; const float* B_im; const float* C_re; const float* C_im;
    const float* ssm_D; const float* w_glu; const float* w_sso; const float* w_out; const float* ffn_g;
    const float* rg_w; const float* rg_b; const float* re_w; const float* re_b;
    const float* e_gate; const float* e_up; const float* e_down; const float* fin_g;
    float* out; unsigned char* ws;
};

__device__ __forceinline__ bf16_t f2bf(float f) { unsigned u = __float_as_uint(f); u += 0x7FFFu + ((u >> 16) & 1u); return (bf16_t)(u >> 16); }
__device__ __forceinline__ float bf2f(bf16_t b) { return __uint_as_float(((unsigned)b) << 16); }
__device__ __forceinline__ unsigned pack2(float lo, float hi) { return (unsigned)f2bf(lo) | ((unsigned)f2bf(hi) << 16); }
__device__ __forceinline__ float sigmoidf_(float v) { return 1.0f / (1.0f + __expf(-v)); }
__device__ __forceinline__ float gelu_tanh(float v) { const float u = 1.5957691216057308f * (v + 0.044715f * v * v * v); return v / (1.0f + __expf(-u)); }
__device__ __forceinline__ float wave_sum(float v) {
#pragma unroll
    for (int o = 32; o > 0; o >>= 1) v += __shfl_xor(v, o);
    return v;
}


#define LAS __attribute__((address_space(3)))
#define XB_TMO      128
#define XB_XCNT(j)  (256  + 64 * (j))
#define XB_XSUB(j)  (1280 + 64 * (j))
#define XB_XGEN(j)  (2304 + 64 * (j))
#define XB_TOP      3328
#define XB_TOPGEN   3392
#define XCD_BAR_WORDS 3456
#define XB_SPIN_CAP (1u << 18)
__device__ __forceinline__ unsigned xb_ld(unsigned* p)              { return __hip_atomic_load(p, __ATOMIC_RELAXED, __HIP_MEMORY_SCOPE_AGENT); }
__device__ __forceinline__ unsigned xb_add(unsigned* p, unsigned v) { return __hip_atomic_fetch_add(p, v, __ATOMIC_RELAXED, __HIP_MEMORY_SCOPE_AGENT); }
__device__ __forceinline__ unsigned xb_xcc_id() { return (unsigned)__builtin_amdgcn_s_getreg((3 << 11) | 20) & 0xFu; }
#define XB_SPIN(cond, bar) do { unsigned _sp = 0; while (cond) { __builtin_amdgcn_s_sleep(1); \
    if ((++_sp & 255u) == 0u) { if (xb_ld(&(bar)[XB_TMO])) break; if (_sp > XB_SPIN_CAP) { atomicAdd(&(bar)[XB_TMO], 1u); break; } } } } while (0)
struct XcdBarrier { unsigned* bar; unsigned x; volatile LAS unsigned* st; };
__device__ __forceinline__ XcdBarrier xcd_barrier_post(unsigned* bar, volatile LAS unsigned* st) {
    XcdBarrier b; b.bar = bar; b.x = xb_xcc_id(); b.st = st;
    if (threadIdx.x == 0) (void)xb_add(&bar[XB_XCNT(b.x)], 1u);
    return b;
}
__device__ __forceinline__ void xcd_barrier_complete(unsigned* bar, unsigned x, unsigned& nloc, unsigned& nx) {
    const unsigned G = gridDim.x * gridDim.y * gridDim.z;
    unsigned sum, cnt, mine, sp = 0u;
    for (;;) {
        sum = 0u; cnt = 0u; mine = 0u;
#pragma unroll
        for (unsigned j = 0; j < 16; ++j) { const unsigned c = xb_ld(&bar[XB_XCNT(j)]); sum += c; cnt += (c > 0u) ? 1u : 0u; mine = (j == x) ? c : mine; }
        if (sum == G) break;
        __builtin_amdgcn_s_sleep(1);
        if ((++sp & 255u) == 0u) { if (xb_ld(&bar[XB_TMO])) break; if (sp > XB_SPIN_CAP) { atomicAdd(&bar[XB_TMO], 1u); break; } }
    }
    nloc = mine > 0u ? mine : 1u; nx = cnt > 0u ? cnt : 1u;
}
__device__ __forceinline__ void xcd_barrier(const XcdBarrier& b) {
    asm volatile("s_waitcnt vmcnt(0)" ::: "memory");
    __syncthreads();
    if (threadIdx.x == 0) {
        unsigned* bar = b.bar;
        __builtin_amdgcn_s_waitcnt(0);
        unsigned nloc = b.st[0], nx = b.st[1];
        if (nloc == 0u) { xcd_barrier_complete(bar, b.x, nloc, nx); b.st[0] = nloc; b.st[1] = nx; }
        const unsigned old = xb_add(&bar[XB_XSUB(b.x)], 1u);
        const unsigned gen = old / nloc;
        if (old + 1u == (gen + 1u) * nloc) {
            __builtin_amdgcn_fence(__ATOMIC_RELEASE, "agent");
            asm volatile("s_waitcnt vmcnt(0)" ::: "memory");
            const unsigned og = xb_add(&bar[XB_TOP], 1u);
            const unsigned tg = og / nx;
            if (og + 1u == (tg + 1u) * nx) xb_add(&bar[XB_TOPGEN], 1u);
            else XB_SPIN(xb_ld(&bar[XB_TOPGEN]) == tg, bar);
            __builtin_amdgcn_fence(__ATOMIC_ACQUIRE, "agent");
            xb_add(&bar[XB_XGEN(b.x)], 1u);
            asm volatile("s_waitcnt vmcnt(0)" ::: "memory");
        } else {
            XB_SPIN(xb_ld(&bar[XB_XGEN(b.x)]) == gen, bar);
            __builtin_amdgcn_fence(__ATOMIC_ACQUIRE, "agent");
            asm volatile("s_waitcnt vmcnt(0)" ::: "memory");
        }
    }
    __syncthreads();
}

template <class AF, class BF, class EF>
__device__ __forceinline__ void wave_gemm_64x64(const int K, const AF& arow, const BF& brow, const EF& epi, const int m0, const int n0, const int lane) {
    const int fr = lane & 15, fq = lane >> 4;
    const bf16_t* ap0 = arow(m0 + fr) + fq * 8;
    const bf16_t* ap1 = arow(m0 + 16 + fr) + fq * 8;
    const bf16_t* ap2 = arow(m0 + 32 + fr) + fq * 8;
    const bf16_t* ap3 = arow(m0 + 48 + fr) + fq * 8;
    const bf16_t* bp0 = brow(n0 + fr) + fq * 8;
    const bf16_t* bp1 = brow(n0 + 16 + fr) + fq * 8;
    const bf16_t* bp2 = brow(n0 + 32 + fr) + fq * 8;
    const bf16_t* bp3 = brow(n0 + 48 + fr) + fq * 8;
    f32x4 acc[4][4];
#pragma unroll
    for (int i = 0; i < 4; ++i)
#pragma unroll
        for (int j = 0; j < 4; ++j) acc[i][j] = (f32x4){0.f, 0.f, 0.f, 0.f};
    bf16x8 a[4], b[4];
    a[0] = *(const bf16x8*)ap0; a[1] = *(const bf16x8*)ap1; a[2] = *(const bf16x8*)ap2; a[3] = *(const bf16x8*)ap3;
    b[0] = *(const bf16x8*)bp0; b[1] = *(const bf16x8*)bp1; b[2] = *(const bf16x8*)bp2; b[3] = *(const bf16x8*)bp3;
    for (int k = 0; k < K; k += 32) {
        bf16x8 an[4], bn[4];
        const int kn = (k + 32 < K) ? k + 32 : k;
        an[0] = *(const bf16x8*)(ap0 + kn); an[1] = *(const bf16x8*)(ap1 + kn); an[2] = *(const bf16x8*)(ap2 + kn); an[3] = *(const bf16x8*)(ap3 + kn);
        bn[0] = *(const bf16x8*)(bp0 + kn); bn[1] = *(const bf16x8*)(bp1 + kn); bn[2] = *(const bf16x8*)(bp2 + kn); bn[3] = *(const bf16x8*)(bp3 + kn);
#pragma unroll
        for (int i = 0; i < 4; ++i)
#pragma unroll
            for (int j = 0; j < 4; ++j) acc[i][j] = __builtin_amdgcn_mfma_f32_16x16x32_bf16(b[j], a[i], acc[i][j], 0, 0, 0);
#pragma unroll
        for (int i = 0; i < 4; ++i) { a[i] = an[i]; b[i] = bn[i]; }
    }
#pragma unroll
    for (int i = 0; i < 4; ++i)
#pragma unroll
        for (int j = 0; j < 4; ++j) epi(m0 + 16 * i + fr, n0 + 16 * j + 4 * fq, acc[i][j]);
}

template <class AF, class BF, class EF>
__device__ __forceinline__ void gemm_phase_simple(const int M, const int N, const int K, const AF& arow, const BF& brow, const EF& epi) {
    const int lane = threadIdx.x & 63, wid = threadIdx.x >> 6;
    const int gw = blockIdx.x * NWAVES + wid, nw = gridDim.x * NWAVES;
    const int tn = N / 64, tiles = (M / 64) * tn;
    for (int t = gw; t < tiles; t += nw) wave_gemm_64x64(K, arow, brow, epi, (t / tn) * 64, (t % tn) * 64, lane);
}


namespace g8 {
constexpr int BM = 256, BK = 64, HALF = 128, HTB = HALF * BK * 2, STAGE_BYTES = 8 * HTB;
__device__ __forceinline__ int lds_byte(int r, int c) { const int st = (r >> 4) * 2 + (c >> 5), rr = r & 15, cc = c & 31, ob = rr * 64 + cc * 2; return st * 1024 + (ob ^ (((ob >> 9) & 1) << 5)); }
__device__ __forceinline__ void stage_rc(int b, int& R, int& C) { const int st = b / 1024, sb = b % 1024, swz = sb ^ (((sb >> 9) & 1) << 5); R = (st >> 1) * 16 + swz / 64; C = (st & 1) * 32 + (swz % 64) / 2; }
struct Unit { const char* A; const char* B; int r0, c0, aux, nrows; };

struct DenseSched {
    const char* A; const char* B; size_t gsA, gsB; int lda, ldb, nM, nN, nG, G, c;
    __device__ __forceinline__ bool next(int i, Unit& u) const {
        const int nMt = nM * nG, nwg = nMt * nN;
        const long L = (long)i * G + c; if (L >= nwg) return false;
        int wgid = (int)L; { const int q = nwg / 8, r = nwg % 8, xcd = wgid % 8, off = wgid / 8; wgid = (xcd < r ? xcd * (q + 1) : r * (q + 1) + (xcd - r) * q) + off; }
        const int nig = 8 * nN, gid = wgid / nig, fm = gid * 8, gsz = (nMt - fm) < 8 ? (nMt - fm) : 8;
        const int pmt = fm + ((wgid % nig) % gsz), pn = (wgid % nig) / gsz;
        const int g = pmt / nM, pm = pmt % nM;
        u.A = A + (size_t)g * gsA + (size_t)pm * BM * lda * 2; u.B = B + (size_t)g * gsB + (size_t)pn * BM * ldb * 2;
        u.r0 = pm * BM; u.c0 = pn * BM; u.aux = g; u.nrows = BM; return true;
    }
};

struct RaggedSched {
    const char* A; const char* B; const LAS int* tab; size_t gsB; int lda, ldb, nN, G, c;
    __device__ __forceinline__ bool next(int i, Unit& u) const {
        const int nwg = tab[128 + 64] * nN;
        const long L = (long)i * G + c; if (L >= nwg) return false;
        int wgid = (int)L; { const int q = nwg / 8, r = nwg % 8, xcd = wgid % 8, off = wgid / 8; wgid = (xcd < r ? xcd * (q + 1) : r * (q + 1) + (xcd - r) * q) + off; }
        const int rt = wgid / nN, pn = wgid % nN;
        int e = 0;
        while (tab[128 + e + 1] <= rt) ++e;
        const int mt = rt - tab[128 + e], cnt = tab[e], ro = tab[64 + e] + mt * BM;
        u.A = A + (size_t)ro * lda * 2; u.B = B + (size_t)e * gsB + (size_t)pn * BM * ldb * 2;
        u.r0 = ro; u.c0 = pn * BM; u.aux = e; u.nrows = (cnt - mt * BM) < BM ? (cnt - mt * BM) : BM; return true;
    }
};

template <class Sched, class Epi>
__device__ __forceinline__ void gemm_phase(LAS unsigned char* lds, const int K, const int lda, const int ldb, const Sched& S, const Epi& E) {
    int tid = threadIdx.x; asm volatile("" : "+v"(tid));
    const int wid = __builtin_amdgcn_readfirstlane(tid >> 6), lane = tid & 63, wr = wid >> 2, wc = wid & 3, fr = lane & 15, fq = lane >> 4;
    int nt = K / BK; asm volatile("" : "+s"(nt));
    unsigned voffA[2], voffB[2];
#pragma unroll
    for (int i = 0; i < 2; ++i) { int R, C; stage_rc(tid * 16 + i * 8192, R, C); voffA[i] = (unsigned)(R * lda + C) * 2u; voffB[i] = (unsigned)(R * ldb + C) * 2u; }
    const size_t kstep = (size_t)(BK * 2);
    const size_t hstepA = (size_t)HALF * lda * 2, hstepB = (size_t)HALF * ldb * 2;
    const unsigned ldsw = (unsigned)wid * 1024u;
    const int aoff = lds_byte(wr * 64 + fr, fq * 8), boff = lds_byte(wc * 32 + fr, fq * 8);
#define G8_SA(b, h) (((b) * 2 + (h)) * HTB)
#define G8_SB(b, h) ((4 + (b) * 2 + (h)) * HTB)
#define G8_STAGE(bufoff, gbase, voff) do { _Pragma("unroll") for (int _i = 0; _i < 2; ++_i) \
        __builtin_amdgcn_global_load_lds((const unsigned*)((const char*)(gbase) + (voff)[_i]), (LAS unsigned*)(lds + (bufoff) + ldsw + _i * 8192), 16, 0, 0); } while (0)
#define G8_LDA(dst, b, h) do { _Pragma("unroll") for (int m = 0; m < 4; ++m) _Pragma("unroll") for (int k = 0; k < 2; ++k) dst[m][k] = *(const LAS bf16x8*)(lds + G8_SA(b, h) + aoff + m * 2048 + k * 1024); } while (0)
#define G8_LDB(dst, b, h) do { _Pragma("unroll") for (int n = 0; n < 2; ++n) _Pragma("unroll") for (int k = 0; k < 2; ++k) dst[n][k] = *(const LAS bf16x8*)(lds + G8_SB(b, h) + boff + n * 2048 + k * 1024); } while (0)
#define G8_MMA(ai, bj, At, Bt) do { __builtin_amdgcn_s_setprio(1); _Pragma("unroll") for (int m = 0; m < 4; ++m) _Pragma("unroll") for (int n = 0; n < 2; ++n) _Pragma("unroll") for (int k = 0; k < 2; ++k) \
        acc[ai][bj][m][n] = __builtin_amdgcn_mfma_f32_16x16x32_bf16(Bt[n][k], At[m][k], acc[ai][bj][m][n], 0, 0, 0); __builtin_amdgcn_s_setprio(0); } while (0)
#define G8_WAIT_V(n) asm volatile("s_waitcnt vmcnt(" #n ")" ::: "memory")
#define G8_WAIT_L(n) asm volatile("s_waitcnt lgkmcnt(" #n ")" ::: "memory")
#define G8_BAR __builtin_amdgcn_s_barrier()
#define G8_SCHED __builtin_amdgcn_sched_barrier(0)
    Unit cur, nxt; int ui = 0;
    if (!S.next(0, cur)) return;
    f32x4 acc[2][2][4][2];
#pragma unroll
    for (int a = 0; a < 2; ++a)
#pragma unroll
        for (int b = 0; b < 2; ++b)
#pragma unroll
            for (int m = 0; m < 4; ++m)
#pragma unroll
                for (int n = 0; n < 2; ++n) acc[a][b][m][n] = (f32x4){0.f, 0.f, 0.f, 0.f};
    bf16x8 At[4][2], B0[2][2], B1[2][2];
    const char* cA = cur.A; const char* cB = cur.B;
    G8_STAGE(G8_SB(0, 0), cB, voffB); G8_STAGE(G8_SA(0, 0), cA, voffA); G8_STAGE(G8_SB(0, 1), cB + hstepB, voffB); G8_STAGE(G8_SA(0, 1), cA + hstepA, voffA);
    if (wr == 1) G8_BAR;
    G8_WAIT_V(4); G8_BAR;
    G8_STAGE(G8_SB(1, 0), cB + kstep, voffB); G8_STAGE(G8_SA(1, 0), cA + kstep, voffA); G8_STAGE(G8_SB(1, 1), cB + hstepB + kstep, voffB);
    G8_WAIT_V(6); G8_BAR;
    for (;;) {
        const bool has_next = S.next(ui + 1, nxt);
        const char* nA = has_next ? nxt.A : cA; const char* nB = has_next ? nxt.B : cB;
        for (int t = 0; t < nt; t += 2) {
            const bool last = (t == nt - 2);
            const char* a1 = cA + (size_t)(t + 1) * kstep;
            const char* a2 = last ? nA : cA + (size_t)(t + 2) * kstep; const char* b2 = last ? nB : cB + (size_t)(t + 2) * kstep;
            const char* a3 = a2 + kstep; const char* b3 = b2 + kstep;
            G8_LDB(B0, 0, 0); G8_SCHED; G8_LDA(At, 0, 0); G8_STAGE(G8_SA(1, 1), a1 + hstepA, voffA);
            G8_WAIT_L(8); G8_BAR; G8_WAIT_L(0); G8_MMA(0, 0, At, B0); G8_BAR; G8_SCHED;
            G8_LDB(B1, 0, 1); G8_STAGE(G8_SB(0, 0), b2, voffB);
            G8_BAR; G8_WAIT_L(0); G8_MMA(0, 1, At, B1); G8_BAR;
            G8_LDA(At, 0, 1); G8_STAGE(G8_SA(0, 0), a2, voffA);
            G8_BAR; G8_WAIT_L(0); G8_MMA(1, 0, At, B0); G8_BAR; G8_SCHED;
            G8_STAGE(G8_SB(0, 1), b2 + hstepB, voffB);
            G8_WAIT_V(6); G8_BAR; G8_MMA(1, 1, At, B1); G8_BAR;
            G8_LDB(B0, 1, 0); G8_SCHED; G8_LDA(At, 1, 0); G8_STAGE(G8_SA(0, 1), a2 + hstepA, voffA);
            G8_WAIT_L(8); G8_BAR; G8_WAIT_L(0); G8_MMA(0, 0, At, B0); G8_BAR; G8_SCHED;
            G8_LDB(B1, 1, 1); G8_STAGE(G8_SB(1, 0), b3, voffB);
            G8_BAR; G8_WAIT_L(0); G8_MMA(0, 1, At, B1); G8_BAR;
            G8_LDA(At, 1, 1); G8_STAGE(G8_SA(1, 0), a3, voffA);
            G8_BAR; G8_WAIT_L(0); G8_MMA(1, 0, At, B0); G8_BAR; G8_SCHED;
            G8_STAGE(G8_SB(1, 1), b3 + hstepB, voffB);
            G8_WAIT_V(6); G8_BAR; G8_MMA(1, 1, At, B1); G8_BAR;
        }
#pragma unroll
        for (int ai = 0; ai < 2; ++ai)
#pragma unroll
            for (int m = 0; m < 4; ++m)
#pragma unroll
                for (int bj = 0; bj < 2; ++bj)
#pragma unroll
                    for (int n = 0; n < 2; ++n) { E(cur, ai * HALF + wr * 64 + m * 16 + fr, bj * HALF + wc * 32 + n * 16 + 4 * fq, acc[ai][bj][m][n]); asm volatile("" ::: "memory"); }
        if (!has_next) break;
#pragma unroll
        for (int a = 0; a < 2; ++a)
#pragma unroll
            for (int b = 0; b < 2; ++b)
#pragma unroll
                for (int m = 0; m < 4; ++m)
#pragma unroll
                    for (int n = 0; n < 2; ++n) acc[a][b][m][n] = (f32x4){0.f, 0.f, 0.f, 0.f};
        cur = nxt; cA = nA; cB = nB; ++ui;
    }
    G8_WAIT_V(0);
    if (wr == 0) G8_BAR;
    G8_BAR;
#undef G8_SA
#undef G8_SB
#undef G8_STAGE
#undef G8_LDA
#undef G8_LDB
#undef G8_MMA
#undef G8_WAIT_V
#undef G8_WAIT_L
#undef G8_BAR
#undef G8_SCHED
}
}

template <class Epi>
__device__ __forceinline__ void dense_gemm(LAS unsigned char* lds, const bf16_t* A, const bf16_t* B, int M, int N, int K, int lda, int ldb, int nG, size_t gsA, size_t gsB, const Epi& E) {
    g8::DenseSched S; S.A = (const char*)A; S.B = (const char*)B; S.gsA = gsA * 2; S.gsB = gsB * 2; S.lda = lda; S.ldb = ldb; S.nM = M / 256; S.nN = N / 256; S.nG = nG; S.G = gridDim.x; S.c = blockIdx.x;
    g8::gemm_phase(lds, K, lda, ldb, S, E);
}

__device__ __forceinline__ void transpose_cvt_tile_wave(const float* __restrict__ src, bf16_t* __restrict__ dst, const int K, const int N, const int nmul, const int nadd, const int tile, float* lds, const int lane) {
    const int tn = N / 64, k0 = (tile / tn) * 64, n0 = (tile % tn) * 64;
    f32x4 v[16];
#pragma unroll
    for (int i = 0; i < 16; ++i) v[i] = *(const f32x4*)(src + (size_t)(k0 + i * 4 + (lane >> 4)) * N + n0 + (lane & 15) * 4);
#pragma unroll
    for (int i = 0; i < 16; ++i) {
        const int kk = i * 4 + (lane >> 4), c4 = (lane & 15) * 4;
        lds[kk * 65 + c4 + 0] = v[i][0]; lds[kk * 65 + c4 + 1] = v[i][1]; lds[kk * 65 + c4 + 2] = v[i][2]; lds[kk * 65 + c4 + 3] = v[i][3];
    }
    asm volatile("s_waitcnt lgkmcnt(0)" ::: "memory");
    const int kc = (lane & 7) * 8;
#pragma unroll
    for (int it = 0; it < 8; ++it) {
        const int n = it * 8 + (lane >> 3);
        u32x4 w;
        w[0] = pack2(lds[(kc + 0) * 65 + n], lds[(kc + 1) * 65 + n]);
        w[1] = pack2(lds[(kc + 2) * 65 + n], lds[(kc + 3) * 65 + n]);
        w[2] = pack2(lds[(kc + 4) * 65 + n], lds[(kc + 5) * 65 + n]);
        w[3] = pack2(lds[(kc + 6) * 65 + n], lds[(kc + 7) * 65 + n]);
        *(u32x4*)(dst + (size_t)((n0 + n) * nmul + nadd) * K + k0 + kc) = w;
    }
    asm volatile("s_waitcnt lgkmcnt(0)" ::: "memory");
}

__device__ void ssm_prep_job(const Params& p, const int g, const int part, float* lds) {
    f32x2* pw = (f32x2*)lds;
    f32x2* bb = pw + 4224;
    f32x2* cm = bb + 2048;
    float* kt = (float*)(cm + 2048);
    const int t = threadIdx.x;
    bf16_t* BtS = (bf16_t*)(p.ws + OFF_BTS) + (size_t)g * 256 * 512;
    bf16_t* BtY = (bf16_t*)(p.ws + OFF_BTY) + (size_t)g * 512 * UK;
    f32x2* aL = (f32x2*)(p.ws + OFF_J + J_AL);
    __syncthreads();
    for (int i = t; i < 2 * 64 * 33; i += NTHREADS) {
        const int dir = i / (64 * 33), n = (i / 33) % 64, tau = i % 33;
        const double are = (double)p.A_re[(dir * SG + g) * SN + n], aim = (double)p.A_im[(dir * SG + g) * SN + n];
        const double dt = exp((double)p.log_dt[dir * SG + g]);
        const double mag = exp(are * dt * tau), ang = aim * dt * tau;
        pw[i] = (f32x2){(float)(mag * cos(ang)), (float)(mag * sin(ang))};
        if (tau == 32 && part == 0) aL[(dir * SG + g) * SN + n] = pw[i];
    }
    for (int i = t; i < 2 * 64 * 16; i += NTHREADS) {
        const int dir = i / 1024, n = (i / 16) % 64, ci = i % 16;
        const double are = (double)p.A_re[(dir * SG + g) * SN + n], aim = (double)p.A_im[(dir * SG + g) * SN + n];
        const double dt = exp((double)p.log_dt[dir * SG + g]);
        const double mag = exp(are * dt), ang = aim * dt;
        const double nr = mag * cos(ang) - 1.0, ni = mag * sin(ang);
        const double den = are * are + aim * aim;
        const double qr = (nr * are + ni * aim) / den, qi = (ni * are - nr * aim) / den;
        const size_t bi = ((size_t)(dir * SG + g) * SN + n) * SC + ci;
        const double br = (double)p.B_re[bi], bim = (double)p.B_im[bi];
        bb[i] = (f32x2){(float)(qr * br - qi * bim), (float)(qr * bim + qi * br)};
    }
    for (int i = t; i < 2 * 16 * 64; i += NTHREADS) {
        const int dir = i / 1024, co = (i / 64) % 16, n = i % 64;
        const size_t ci_ = ((size_t)(dir * SG + g) * SC + co) * SN + n;
        cm[i] = (f32x2){p.C_re[ci_], p.C_im[ci_]};
    }
    __syncthreads();
    for (int i = t; i < 2 * 32 * 2 * 16; i += NTHREADS) {
        const int dir = i >> 10, tau = (i >> 5) & 31, col = (i >> 4) & 1, ci = i & 15, co = 2 * part + col;
        float s = 0.f;
        for (int n = 0; n < 64; ++n) {
            const f32x2 c = cm[(dir * 16 + co) * 64 + n], a = pw[(dir * 64 + n) * 33 + tau], b = bb[(dir * 64 + n) * 16 + ci];
            const float zr = c[0] * a[0] - c[1] * a[1], zi = c[0] * a[1] + c[1] * a[0];
            s += zr * b[0] - zi * b[1];
        }
        kt[i] = s;
    }
    __syncthreads();
    for (int i = t; i < 32 * 512; i += NTHREADS) {
        const int rr = i >> 9, col = i & 511;
        const int dir = rr >> 4, n = 8 * part + ((rr >> 1) & 7), ri = rr & 1, s = col >> 4, ci = col & 15;
        const int tau = dir == 0 ? (LC - 1 - s) : s;
        const f32x2 a = pw[(dir * 64 + n) * 33 + tau], b = bb[(dir * 64 + n) * 16 + ci];
        const float v = ri == 0 ? (a[0] * b[0] - a[1] * b[1]) : (a[0] * b[1] + a[1] * b[0]);
        BtS[(size_t)((dir * 64 + n) * 2 + ri) * 512 + col] = f2bf(v);
    }
    for (int rr = 0; rr < 64; ++rr) {
        const int tt = rr >> 1, col = rr & 1, co = 2 * part + col;
        for (int kk = t; kk < UK; kk += NTHREADS) {
            float v;
            if (kk < 512) {
                const int s = kk >> 4, ci = kk & 15;
                if (s < tt) v = kt[((0 * 32 + (tt - s)) * 2 + col) * 16 + ci];
                else if (s > tt) v = kt[((1 * 32 + (s - tt)) * 2 + col) * 16 + ci];
                else v = kt[((0 * 32 + 0) * 2 + col) * 16 + ci] + kt[((1 * 32 + 0) * 2 + col) * 16 + ci];
            } else {
                const int q = kk - 512, dir = q >> 7, n = (q >> 1) & 63, ri = q & 1;
                const int tau = dir == 0 ? (tt + 1) : (LC - tt);
                const f32x2 c = cm[(dir * 16 + co) * 64 + n], a = pw[(dir * 64 + n) * 33 + tau];
                const float zr = c[0] * a[0] - c[1] * a[1], zi = c[0] * a[1] + c[1] * a[0];
                v = ri == 0 ? zr : -zi;
            }
            BtY[(size_t)(tt * 16 + co) * UK + kk] = f2bf(v);
        }
    }
}

__device__ __forceinline__ void load_row(const float* row, const int lane, f32x4 (&v)[4]) {
#pragma unroll
    for (int i = 0; i < 4; ++i) v[i] = *(const f32x4*)(row + 4 * lane + 256 * i);
}
__device__ __forceinline__ float row_inv_rms(const f32x4 (&v)[4]) {
    float s = 0.f;
#pragma unroll
    for (int i = 0; i < 4; ++i) s += v[i][0] * v[i][0] + v[i][1] * v[i][1] + v[i][2] * v[i][2] + v[i][3] * v[i][3];
    s = wave_sum(s);
    return 1.0f / sqrtf(s * (1.0f / 1024.0f) + 1e-6f);
}

__global__ void __launch_bounds__(NTHREADS) fwd_megakernel(const Params p) {
    __shared__ __attribute__((aligned(16))) unsigned char smem[SMEM_BYTES];
    const int tid = threadIdx.x, lane = tid & 63, wid = tid >> 6;
    const int gw = blockIdx.x * NWAVES + wid, nw = gridDim.x * NWAVES;
    const int gt = blockIdx.x * NTHREADS + tid, nt = gridDim.x * NTHREADS;
    unsigned char* ws = p.ws;
    bf16_t* WguT = (bf16_t*)(ws + OFF_WGUT); bf16_t* WdT = (bf16_t*)(ws + OFF_WDT);
    bf16_t* WinT = (bf16_t*)(ws + OFF_WINT); bf16_t* WpT = (bf16_t*)(ws + OFF_WPT); bf16_t* WglT = (bf16_t*)(ws + OFF_WGLT);
    bf16_t* WsoT = (bf16_t*)(ws + OFF_WSOT); bf16_t* WoT = (bf16_t*)(ws + OFF_WOT);
    bf16_t* BtS = (bf16_t*)(ws + OFF_BTS); bf16_t* BtY = (bf16_t*)(ws + OFF_BTY);
    bf16_t* T2 = (bf16_t*)(ws + OFF_C); bf16_t* ybuf = (bf16_t*)(ws + OFF_C);
    bf16_t* hn = (bf16_t*)(ws + OFF_D); bf16_t* Fb = (bf16_t*)(ws + OFF_D); bf16_t* hn2 = (bf16_t*)(ws + OFF_D);
    bf16_t* gates = (bf16_t*)(ws + OFF_E); bf16_t* act = (bf16_t*)(ws + OFF_E + 65 * MiB);
    bf16_t* XA = (bf16_t*)(ws + OFF_FG); float* Sst = (float*)(ws + OFF_FG + 16 * MiB); bf16_t* m1 = (bf16_t*)(ws + OFF_FG);
    bf16_t* Ucomb = (bf16_t*)(ws + OFF_H);
    bf16_t* yg = (bf16_t*)(ws + OFF_I); bf16_t* ys2 = (bf16_t*)(ws + OFF_I + 16 * MiB);
    unsigned* cnt = (unsigned*)(ws + OFF_J + J_CNT);
    const f32x2* aL = (const f32x2*)(ws + OFF_J + J_AL);
    f32x2* tokw = (f32x2*)(ws + OFF_J + J_TOKW);
    int* tokinfo = (int*)(ws + OFF_J + J_TOKINFO);
    int* slot_asg = (int*)(ws + OFF_J + J_SLOTASG);
    float* slot_w = (float*)(ws + OFF_J + J_SLOTW);
    bf16_t* WrT = (bf16_t*)(ws + OFF_J + J_WRT);
    bf16_t* BtA = (bf16_t*)(ws + OFF_J + J_BTA); bf16_t* BtC = (bf16_t*)(ws + OFF_J + J_BTC); f32x2* TW = (f32x2*)(ws + OFF_J + J_TW);
    bf16_t* Xg = (bf16_t*)(ws + OFF_E);
    float* x2 = p.out;
    LAS unsigned char* ldsp = (LAS unsigned char*)smem;
    if (tid == 0) { ((volatile LAS unsigned*)(ldsp + BAR_LDS_OFF))[0] = 0u; ((volatile LAS unsigned*)(ldsp + BAR_LDS_OFF))[1] = 0u; }
    __syncthreads();
    const XcdBarrier bar = xcd_barrier_post((unsigned*)(ws + OFF_J + J_BAR), (volatile LAS unsigned*)(ldsp + BAR_LDS_OFF));
#define GRID_SYNC() xcd_barrier(bar)

    for (int _rep = 0; _rep < REP0; ++_rep) {
    {
        {
            float* ldsw = (float*)smem + (size_t)wid * (64 * 65);
            const int T_WIN = 16 * 48, T_GLU = 8 * 8, T_SSO = 8 * 16, T_WO = 16 * 16, T_EG = 64 * 16 * 8, T_ED = 64 * 8 * 16;
            const int total = T_WIN + T_GLU + T_SSO + T_WO + 2 * T_EG + T_ED;
            for (int j = gw; j < total; j += nw) {
                int q = j;
                if (q < T_WIN) { transpose_cvt_tile_wave(p.w_in, WinT, 1024, 3072, 1, 0, q, ldsw, lane); continue; } q -= T_WIN;
                if (q < T_GLU) { transpose_cvt_tile_wave(p.w_glu, WglT, 512, 512, 1, 0, q, ldsw, lane); continue; } q -= T_GLU;
                if (q < T_SSO) { transpose_cvt_tile_wave(p.w_sso, WsoT, 512, 1024, 1, 0, q, ldsw, lane); continue; } q -= T_SSO;
                if (q < T_WO) { transpose_cvt_tile_wave(p.w_out, WoT, 1024, 1024, 1, 0, q, ldsw, lane); continue; } q -= T_WO;
                if (q < T_EG) { const int e = q / 128; transpose_cvt_tile_wave(p.e_gate + (size_t)e * 1024 * 512, WguT + (size_t)e * 1024 * 1024, 1024, 512, 2, 0, q % 128, ldsw, lane); continue; } q -= T_EG;
                if (q < T_EG) { const int e = q / 128; transpose_cvt_tile_wave(p.e_up + (size_t)e * 1024 * 512, WguT + (size_t)e * 1024 * 1024, 1024, 512, 2, 1, q % 128, ldsw, lane); continue; } q -= T_EG;
                { const int e = q / 128; transpose_cvt_tile_wave(p.e_down + (size_t)e * 512 * 1024, WdT + (size_t)e * 1024 * 512, 512, 1024, 1, 0, q % 128, ldsw, lane); }
            }
        }
        __syncthreads();
        {
            f32x2* cst = (f32x2*)smem;
            if (tid < 128) { float sv, cv; sincospif((float)tid * (1.0f / 64.0f), &sv, &cv); cst[tid] = (f32x2){cv, sv}; }
            __syncthreads();
            for (int i = gt; i < 1024 * 1024; i += nt) {
                const int d = i & 1023, kk = i >> 10;
                const int g = kk >> 8, c = (kk >> 1) & 127, ri = kk & 1;
                const float* wp = p.w_fo + (size_t)(g * 128) * 1024 + d;
                float s = 0.f;
#pragma unroll 8
                for (int m = 0; m < 128; ++m) s += cst[(c * m) & 127][ri] * wp[(size_t)m * 1024];
                WpT[(size_t)d * 1024 + kk] = f2bf(s * 0.08838834764831845f);
            }
            __syncthreads();
        }
        for (int i = gt; i < 80 * 2048; i += nt) {
            const int n = i >> 11, k = i & 2047, kk = k & 1023;
            const float w = n < 64 ? p.re_w[kk * 64 + n] : (n < 72 ? p.rg_w[kk * 8 + (n - 64)] : 0.f);
            const bf16_t hi = f2bf(w);
            WrT[i] = k < 1024 ? hi : f2bf(w - bf2f(hi));
        }
        for (int i = gt; i < 256 * 128; i += nt) {
            const int n = i >> 7, k = i & 127;
            const int w = n >> 7, k1 = (n >> 1) & 63, ri = n & 1, w2 = k >> 6, l1 = k & 63;
            float sv, cv; sincospif((float)((k1 * l1) & 63) * (1.0f / 32.0f), &sv, &cv);
            BtA[i] = f2bf(w == w2 ? (ri ? -sv : cv) * 0.125f : 0.f);
        }
        for (int i = gt; i < 256 * 256; i += nt) {
            const int n = i >> 8, k = i & 255;
            const int w = n >> 7, k2 = (n >> 1) & 63, ri = n & 1, w2 = k >> 7, l2 = (k >> 1) & 63, ri2 = k & 1;
            float sv, cv; sincospif((float)((k2 * l2) & 63) * (1.0f / 32.0f), &sv, &cv);
            const float v = ri == 0 ? (ri2 == 0 ? cv : sv) : (ri2 == 0 ? -sv : cv);
            BtC[i] = f2bf(w == w2 ? v * 0.125f : 0.f);
        }
        for (int i = gt; i < 64 * 64; i += nt) {
            const int k1 = i >> 6, l2 = i & 63;
            float sv, cv; sincospif((float)(k1 * l2) * (1.0f / 2048.0f), &sv, &cv);
            TW[i] = (f32x2){cv, -sv};
        }
        for (int j = blockIdx.x; j < SG * 8; j += gridDim.x) ssm_prep_job(p, j >> 3, j & 7, (float*)smem);
        for (int r = gw; r < T; r += nw) {
            f32x4 v[4]; load_row(p.x + (size_t)r * D, lane, v);
            const float inv = row_inv_rms(v);
            const int rp = (r & ~4095) | ((r & 63) << 6) | ((r >> 6) & 63);
#pragma unroll
            for (int i = 0; i < 4; ++i) {
                const f32x4 gg = *(const f32x4*)(p.mix_g + 4 * lane + 256 * i);
                u32x2 w; w[0] = pack2(v[i][0] * inv * gg[0], v[i][1] * inv * gg[1]); w[1] = pack2(v[i][2] * inv * gg[2], v[i][3] * inv * gg[3]);
                *(u32x2*)(hn + (size_t)rp * D + 4 * lane + 256 * i) = w;
            }
        }
    }
    GRID_SYNC();
    }
    for (int _rep = 0; _rep < REP1; ++_rep) {
    {
        auto arow = [=](int m) { return hn + (size_t)m * D; };
        auto brow = [=](int n) { return WinT + (size_t)n * D; };
        auto epi = [=](int m, int n4, f32x4 v) {
            const int b = m >> 12, l2 = (m >> 6) & 63, l1 = m & 63, tok = (b << 12) + (l1 << 6) + l2;
            if (n4 < FW) {
                const int g = n4 >> 7, c = n4 & 127;
#pragma unroll
                for (int j = 0; j < 4; ++j) XA[((((size_t)(b * 4 + g) * 128 + c + j) * 64 + l2) << 6) + l1] = f2bf(v[j]);
            } else if (n4 < FW + SW) {
                const int ch = n4 - FW, g = ch >> 4, ci = ch & 15;
                u32x2 w; w[0] = pack2(v[0], v[1]); w[1] = pack2(v[2], v[3]);
                *(u32x2*)(Ucomb + ((size_t)(g * ROWS + (tok >> 5))) * UK + (tok & 31) * 16 + ci) = w;
            } else {
                u32x2 w; w[0] = pack2(sigmoidf_(v[0]), sigmoidf_(v[1])); w[1] = pack2(sigmoidf_(v[2]), sigmoidf_(v[3]));
                *(u32x2*)(gates + (size_t)tok * 2048 + (n4 - 1024)) = w;
            }
        };
        auto E = [=](const g8::Unit& u, int rl, int cl, f32x4 v) { epi(u.r0 + rl, u.c0 + cl, v); };
        dense_gemm(ldsp, hn, WinT, T, INW, D, D, D, 1, 0, 0, E);
    }
    GRID_SYNC();
    }
    for (int _rep = 0; _rep < REP2; ++_rep) {
    {
        {
            auto E = [=](const g8::Unit& u, int rl, int cl, f32x4 v) {
                const int r = u.r0 + rl, n4 = u.c0 + cl;
                const int l2 = 2 * (r & 31) + (n4 >> 7), c = (r >> 5) & 127, bg = r >> 12, k1 = (n4 & 127) >> 1;
                const f32x2 t0 = TW[k1 * 64 + l2], t1 = TW[(k1 + 1) * 64 + l2];
                bf16_t* dst = T2 + ((((size_t)(bg * 64 + k1) * 128 + c) * 64 + l2) << 1);
                *(unsigned*)dst = pack2(v[0] * t0[0] - v[1] * t0[1], v[0] * t0[1] + v[1] * t0[0]);
                *(unsigned*)(dst + 128 * 64 * 2) = pack2(v[2] * t1[0] - v[3] * t1[1], v[2] * t1[1] + v[3] * t1[0]);
            };
            dense_gemm(ldsp, XA, BtA, 65536, 256, 128, 128, 128, 1, 0, 0, E);
        }
        {
            auto E = [=](const g8::Unit& u, int rl, int cl, f32x4 v) { *(f32x4*)(Sst + (size_t)(u.aux * ROWS + u.r0 + rl) * 256 + u.c0 + cl) = v; };
            dense_gemm(ldsp, Ucomb, BtS, ROWS, 256, 512, UK, 512, SG, (size_t)ROWS * UK, (size_t)256 * 512, E);
        }
    }
    GRID_SYNC();
    }
    for (int _rep = 0; _rep < REP3; ++_rep) {
    {
        {
            auto E = [=](const g8::Unit& u, int rl, int cl, f32x4 v) {
                const int r = u.r0 + rl, n4 = u.c0 + cl;
                const int c = 2 * (r & 63) + (n4 >> 7), k1 = (r >> 6) & 63, bg = r >> 12, k2 = (n4 & 127) >> 1;
                bf16_t* dst = Fb + ((size_t)((bg >> 2) * SEQ + k1 + 64 * k2)) * 1024 + ((bg & 3) * 128 + c) * 2;
                *(unsigned*)dst = pack2(v[0], v[1]);
                *(unsigned*)(dst + 64 * 1024) = pack2(v[2], v[3]);
            };
            dense_gemm(ldsp, T2, BtC, 65536, 256, 256, 256, 256, 1, 0, 0, E);
        }
        for (int i = gt; i < BATCH * SG * 2 * SN; i += nt) {
            const int n = i & 63, dir = (i >> 6) & 1, g = (i >> 7) & 31, b = i >> 12;
            const f32x2 a = aL[(dir * SG + g) * SN + n];
            float hr = 0.f, hi = 0.f;
            for (int j0 = 0; j0 < NCH; j0 += 16) {
                f32x2 s[16];
#pragma unroll
                for (int q = 0; q < 16; ++q) {
                    const int jj = j0 + q, j = dir == 0 ? jj : (NCH - 1 - jj);
                    s[q] = *(const f32x2*)(Sst + ((size_t)g * ROWS + b * NCH + j) * 256 + (dir * 64 + n) * 2);
                }
#pragma unroll
                for (int q = 0; q < 16; ++q) {
                    const int jj = j0 + q, j = dir == 0 ? jj : (NCH - 1 - jj);
                    const size_t row = (size_t)g * ROWS + b * NCH + j;
                    *(unsigned*)(Ucomb + row * UK + 512 + (dir * 64 + n) * 2) = pack2(hr, hi);
                    const float nr = a[0] * hr - a[1] * hi + s[q][0], ni = a[0] * hi + a[1] * hr + s[q][1];
                    hr = nr; hi = ni;
                }
            }
        }
    }
    GRID_SYNC();
    }
    for (int _rep = 0; _rep < REP4; ++_rep) {
    {
        {
            auto E = [=](const g8::Unit& u, int rl, int cl, f32x4 v) {
                const int g = u.aux, m = u.r0 + rl, n4 = u.c0 + cl;
                const int tt = n4 >> 4, co = n4 & 15, tok = m * LC + tt, ch = g * 16 + co;
                const u32x2 uu = *(const u32x2*)(Ucomb + (size_t)(g * ROWS + m) * UK + n4);
                const f32x4 dd = *(const f32x4*)(p.ssm_D + ch);
                const float u0 = __uint_as_float(uu[0] << 16), u1 = __uint_as_float(uu[0] & 0xffff0000u), u2 = __uint_as_float(uu[1] << 16), u3 = __uint_as_float(uu[1] & 0xffff0000u);
                u32x2 w; w[0] = pack2(gelu_tanh(v[0] + dd[0] * u0), gelu_tanh(v[1] + dd[1] * u1)); w[1] = pack2(gelu_tanh(v[2] + dd[2] * u2), gelu_tanh(v[3] + dd[3] * u3));
                *(u32x2*)(yg + (size_t)tok * SW + ch) = w;
            };
            dense_gemm(ldsp, Ucomb, BtY, ROWS, 512, UK, UK, UK, SG, (size_t)ROWS * UK, (size_t)512 * UK, E);
        }
        {
            auto arow = [=](int m) { return Fb + (size_t)m * 1024; };
            auto brow = [=](int n) { return WpT + (size_t)n * 1024; };
            auto epi = [=](int m, int n4, f32x4 v) {
                const u32x2 gg = *(const u32x2*)(gates + (size_t)m * 2048 + n4);
                const float g0 = __uint_as_float(gg[0] << 16), g1 = __uint_as_float(gg[0] & 0xffff0000u), g2 = __uint_as_float(gg[1] << 16), g3 = __uint_as_float(gg[1] & 0xffff0000u);
                u32x2 w; w[0] = pack2(g0 * v[0], g1 * v[1]); w[1] = pack2(g2 * v[2], g3 * v[3]);
                *(u32x2*)(m1 + (size_t)m * D + n4) = w;
            };
            auto E = [=](const g8::Unit& u, int rl, int cl, f32x4 v) { epi(u.r0 + rl, u.c0 + cl, v); };
            dense_gemm(ldsp, Fb, WpT, T, D, 1024, 1024, 1024, 1, 0, 0, E);
        }
    }
    GRID_SYNC();
    }
    for (int _rep = 0; _rep < REP5; ++_rep) {
    {
        auto arow = [=](int m) { return yg + (size_t)m * SW; };
        auto brow = [=](int n) { return WglT + (size_t)n * SW; };
        auto epi = [=](int m, int n4, f32x4 v) {
            const u32x2 yy = *(const u32x2*)(yg + (size_t)m * SW + n4);
            const float y0 = __uint_as_float(yy[0] << 16), y1 = __uint_as_float(yy[0] & 0xffff0000u), y2 = __uint_as_float(yy[1] << 16), y3 = __uint_as_float(yy[1] & 0xffff0000u);
            u32x2 w; w[0] = pack2(y0 * sigmoidf_(v[0]), y1 * sigmoidf_(v[1])); w[1] = pack2(y2 * sigmoidf_(v[2]), y3 * sigmoidf_(v[3]));
            *(u32x2*)(ys2 + (size_t)m * SW + n4) = w;
        };
        auto E = [=](const g8::Unit& u, int rl, int cl, f32x4 v) { epi(u.r0 + rl, u.c0 + cl, v); };
        dense_gemm(ldsp, yg, WglT, T, SW, SW, SW, SW, 1, 0, 0, E);
    }
    GRID_SYNC();
    }
    {
        auto arow = [=](int m) { return ys2 + (size_t)m * SW; };
        auto brow = [=](int n) { return WsoT + (size_t)n * SW; };
        auto epi = [=](int m, int n4, f32x4 v) {
            const u32x2 gg = *(const u32x2*)(gates + (size_t)m * 2048 + 1024 + n4);
            const u32x2 mm = *(const u32x2*)(m1 + (size_t)m * D + n4);
            const float g0 = __uint_as_float(gg[0] << 16), g1 = __uint_as_float(gg[0] & 0xffff0000u), g2 = __uint_as_float(gg[1] << 16), g3 = __uint_as_float(gg[1] & 0xffff0000u);
            const float a0 = __uint_as_float(mm[0] << 16), a1 = __uint_as_float(mm[0] & 0xffff0000u), a2 = __uint_as_float(mm[1] << 16), a3 = __uint_as_float(mm[1] & 0xffff0000u);
            u32x2 w; w[0] = pack2(a0 + g0 * v[0], a1 + g1 * v[1]); w[1] = pack2(a2 + g2 * v[2], a3 + g3 * v[3]);
            *(u32x2*)(m1 + (size_t)m * D + n4) = w;
        };
        auto E = [=](const g8::Unit& u, int rl, int cl, f32x4 v) { epi(u.r0 + rl, u.c0 + cl, v); };
        dense_gemm(ldsp, ys2, WsoT, T, D, SW, SW, SW, 1, 0, 0, E);
    }
    GRID_SYNC();
    for (int _rep = 0; _rep < REP7; ++_rep) {
    {
        auto arow = [=](int m) { return m1 + (size_t)m * D; };
        auto brow = [=](int n) { return WoT + (size_t)n * D; };
        auto epi = [=](int m, int n4, f32x4 v) {
            const f32x4 xx = *(const f32x4*)(p.x + (size_t)m * D + n4);
            *(f32x4*)(x2 + (size_t)m * D + n4) = xx + v;
        };
        auto E = [=](const g8::Unit& u, int rl, int cl, f32x4 v) { epi(u.r0 + rl, u.c0 + cl, v); };
        dense_gemm(ldsp, m1, WoT, T, D, D, D, D, 1, 0, 0, E);
    }
    GRID_SYNC();
    }
    {
        LAS unsigned char* hrow = ldsp;
        LAS float* part = (LAS float*)(ldsp + 66048);
        const int fr = lane & 15, fq = lane >> 4;
        for (int tb = blockIdx.x; tb < T / 32; tb += gridDim.x) {
            const int tok0 = tb * 32;
            f32x4 xv[4][4];
#pragma unroll
            for (int q = 0; q < 4; ++q) load_row(x2 + (size_t)(tok0 + wid * 4 + q) * D, lane, xv[q]);
#pragma unroll
            for (int q = 0; q < 4; ++q) {
                const int rl = wid * 4 + q, r = tok0 + rl;
                const float inv = row_inv_rms(xv[q]);
#pragma unroll
                for (int i = 0; i < 4; ++i) {
                    const f32x4 gg = *(const f32x4*)(p.ffn_g + 4 * lane + 256 * i);
                    u32x2 w; w[0] = pack2(xv[q][i][0] * inv * gg[0], xv[q][i][1] * inv * gg[1]); w[1] = pack2(xv[q][i][2] * inv * gg[2], xv[q][i][3] * inv * gg[3]);
                    *(u32x2*)(hn2 + (size_t)r * D + 4 * lane + 256 * i) = w;
                    *(LAS u32x2*)(hrow + rl * 2064 + (4 * lane + 256 * i) * 2) = w;
                }
            }
            __syncthreads();
            {
                const int mtl = wid & 1, kq = wid >> 1;
                const LAS unsigned char* ap = hrow + (mtl * 16 + fr) * 2064 + ((kq & 1) * 512 + fq * 8) * 2;
                const bf16_t* bp = WrT + (size_t)fr * 2048 + kq * 512 + fq * 8;
                f32x4 acc[5];
#pragma unroll
                for (int n = 0; n < 5; ++n) acc[n] = (f32x4){0.f, 0.f, 0.f, 0.f};
#pragma unroll
                for (int h = 0; h < 4; ++h) {
                    bf16x8 bfr[4][5];
#pragma unroll
                    for (int ks = 0; ks < 4; ++ks)
#pragma unroll
                        for (int n = 0; n < 5; ++n) bfr[ks][n] = *(const bf16x8*)(bp + (size_t)n * 16 * 2048 + (h * 4 + ks) * 32);
#pragma unroll
                    for (int ks = 0; ks < 4; ++ks) {
                        const bf16x8 a = *(const LAS bf16x8*)(ap + (h * 4 + ks) * 64);
#pragma unroll
                        for (int n = 0; n < 5; ++n) acc[n] = __builtin_amdgcn_mfma_f32_16x16x32_bf16(bfr[ks][n], a, acc[n], 0, 0, 0);
                    }
                }
#pragma unroll
                for (int n = 0; n < 5; ++n) *(LAS f32x4*)(part + (kq * 32 + mtl * 16 + fr) * 80 + n * 16 + 4 * fq) = acc[n];
            }
            __syncthreads();
            if (tid < 32) {
                const LAS float* L = part + tid * 80;
                float gv[8];
#pragma unroll
                for (int i = 0; i < 8; ++i) gv[i] = ((L[64 + i] + L[2560 + 64 + i]) + (L[5120 + 64 + i] + L[7680 + 64 + i])) + p.rg_b[i];
                int gi = 0; float gm = gv[0];
#pragma unroll
                for (int i = 1; i < 8; ++i) if (gv[i] > gm) { gm = gv[i]; gi = i; }
                float den = 0.f;
#pragma unroll
                for (int i = 0; i < 8; ++i) den += __expf(gv[i] - gm);
                const float pg = 1.0f / den;
                float ev[8];
#pragma unroll
                for (int i = 0; i < 8; ++i) { const int c = gi * 8 + i; ev[i] = ((L[c] + L[2560 + c]) + (L[5120 + c] + L[7680 + c])) + p.re_b[c]; }
                int i1 = 0; float v1 = ev[0];
#pragma unroll
                for (int i = 1; i < 8; ++i) if (ev[i] > v1) { v1 = ev[i]; i1 = i; }
                int i2 = -1; float v2 = -3.0e38f;
#pragma unroll
                for (int i = 0; i < 8; ++i) if (i != i1 && ev[i] > v2) { v2 = ev[i]; i2 = i; }
                const float e2 = __expf(v2 - v1), w1 = pg / (1.0f + e2), w2 = pg * e2 / (1.0f + e2);
                const int tok = tok0 + tid, ex1 = gi * 8 + i1, ex2 = gi * 8 + i2;
                const int p1 = (int)atomicAdd(&cnt[ex1], 1u), p2 = (int)atomicAdd(&cnt[ex2], 1u);
                *(int4*)(tokinfo + 4 * tok) = make_int4(ex1, p1, ex2, p2);
                tokw[tok] = (f32x2){w1, w2};
            }
            __syncthreads();
        }
    }
    GRID_SYNC();
    LAS int* tab = (LAS int*)(ldsp + TAB_LDS_OFF);
    for (int _rep = 0; _rep < REP9; ++_rep) {
    {
        if (tid == 0) {
            int ro = 0, tp = 0;
            for (int e = 0; e < NE; ++e) { const int c = (int)cnt[e]; tab[e] = c; tab[64 + e] = ro; tab[128 + e] = tp; ro += c; tp += (c + 255) / 256; }
            tab[128 + NE] = tp;
        }
        __syncthreads();
        for (int tok = gw; tok < T; tok += nw) {
            const int4 info = *(const int4*)(tokinfo + 4 * tok); const f32x2 w = tokw[tok];
            const int s1 = tab[64 + info.x] + info.y, s2 = tab[64 + info.z] + info.w;
            const u32x4 a = *(const u32x4*)(hn2 + (size_t)tok * D + lane * 16), b = *(const u32x4*)(hn2 + (size_t)tok * D + lane * 16 + 8);
            *(u32x4*)(Xg + (size_t)s1 * D + lane * 16) = a; *(u32x4*)(Xg + (size_t)s1 * D + lane * 16 + 8) = b;
            *(u32x4*)(Xg + (size_t)s2 * D + lane * 16) = a; *(u32x4*)(Xg + (size_t)s2 * D + lane * 16 + 8) = b;
            if (lane == 0) { slot_asg[s1] = tok * 2; slot_asg[s2] = tok * 2 + 1; slot_w[s1] = w[0]; slot_w[s2] = w[1]; }
        }
    }
    GRID_SYNC();
    }
    for (int _rep = 0; _rep < REP10; ++_rep) {
    {
        auto E = [=](const g8::Unit& u, int rl, int cl, f32x4 v) {
            if (rl < u.nrows) {
                const float s0 = v[0] * sigmoidf_(v[0]) * v[1], s1 = v[2] * sigmoidf_(v[2]) * v[3];
                *(unsigned*)(act + (size_t)(u.r0 + rl) * DE + ((u.c0 + cl) >> 1)) = pack2(s0, s1);
            }
        };
        g8::RaggedSched S; S.A = (const char*)Xg; S.B = (const char*)WguT; S.tab = tab; S.gsB = (size_t)1024 * 1024 * 2; S.lda = D; S.ldb = D; S.nN = 4; S.G = gridDim.x; S.c = blockIdx.x;
        g8::gemm_phase(ldsp, D, D, D, S, E);
    }
    GRID_SYNC();
    }
    for (int _rep = 0; _rep < REP11; ++_rep) {
    {
        auto E = [=](const g8::Unit& u, int rl, int cl, f32x4 v) {
            if (rl < u.nrows) {
                const int as = slot_asg[u.r0 + rl]; const float w = slot_w[u.r0 + rl];
                u32x2 o; o[0] = pack2(w * v[0], w * v[1]); o[1] = pack2(w * v[2], w * v[3]);
                *(u32x2*)(ybuf + (size_t)as * D + u.c0 + cl) = o;
            }
        };
        g8::RaggedSched S; S.A = (const char*)act; S.B = (const char*)WdT; S.tab = tab; S.gsB = (size_t)1024 * 512 * 2; S.lda = DE; S.ldb = DE; S.nN = 4; S.G = gridDim.x; S.c = blockIdx.x;
        g8::gemm_phase(ldsp, DE, DE, DE, S, E);
    }
    GRID_SYNC();
    }
    {
        for (int r = gw; r < T; r += nw) {
            f32x4 v[4]; load_row(x2 + (size_t)r * D, lane, v);
#pragma unroll
            for (int i = 0; i < 4; ++i) {
                const u32x2 y0 = *(const u32x2*)(ybuf + (size_t)(2 * r) * D + 4 * lane + 256 * i);
                const u32x2 y1 = *(const u32x2*)(ybuf + (size_t)(2 * r + 1) * D + 4 * lane + 256 * i);
                v[i][0] += __uint_as_float(y0[0] << 16) + __uint_as_float(y1[0] << 16);
                v[i][1] += __uint_as_float(y0[0] & 0xffff0000u) + __uint_as_float(y1[0] & 0xffff0000u);
                v[i][2] += __uint_as_float(y0[1] << 16) + __uint_as_float(y1[1] << 16);
                v[i][3] += __uint_as_float(y0[1] & 0xffff0000u) + __uint_as_float(y1[1] & 0xffff0000u);
            }
            const float inv = row_inv_rms(v);
#pragma unroll
            for (int i = 0; i < 4; ++i) {
                const f32x4 gg = *(const f32x4*)(p.fin_g + 4 * lane + 256 * i);
                *(f32x4*)(p.out + (size_t)r * D + 4 * lane + 256 * i) = (f32x4){v[i][0] * inv * gg[0], v[i][1] * inv * gg[1], v[i][2] * inv * gg[2], v[i][3] * inv * gg[3]};
            }
        }
    }
}

extern "C" void kernel_launch(void* const* d_in, const int* in_sizes, int n_in, void* d_out, int out_size, void* d_ws, size_t ws_size, hipStream_t stream) {
    (void)in_sizes; (void)n_in; (void)out_size;
    static int grid_blocks = 0;
    if (!grid_blocks) {
        int dev = 0, cus = 0, per_cu = 0;
        (void)hipGetDevice(&dev);
        (void)hipDeviceGetAttribute(&cus, hipDeviceAttributeMultiprocessorCount, dev);
        (void)hipOccupancyMaxActiveBlocksPerMultiprocessor(&per_cu, fwd_megakernel, NTHREADS, 0);
        if (per_cu > 1) per_cu = 1;
        if (per_cu < 1) per_cu = 1;
        grid_blocks = cus * per_cu;
    }
    if (ws_size < WS_NEED) { fprintf(stderr, "workspace too small: %zu < %zu\n", ws_size, (size_t)WS_NEED); return; }
    Params p{};
    p.x = (const float*)d_in[0]; p.mix_g = (const float*)d_in[1]; p.w_in = (const float*)d_in[2]; p.w_fo = (const float*)d_in[3];
    p.A_re = (const float*)d_in[4]; p.A_im = (const float*)d_in[5]; p.log_dt = (const float*)d_in[6];
    p.B_re = (const float*)d_in[7]; p.B_im = (const float*)d_in[8]; p.C_re = (const float*)d_in[9]; p.C_im = (const float*)d_in[10];
    p.ssm_D = (const float*)d_in[11]; p.w_glu = (const float*)d_in[12]; p.w_sso = (const float*)d_in[13]; p.w_out = (const float*)d_in[14];
    p.ffn_g = (const float*)d_in[15]; p.rg_w = (const float*)d_in[16]; p.rg_b = (const float*)d_in[17]; p.re_w = (const float*)d_in[18]; p.re_b = (const float*)d_in[19];
    p.e_gate = (const float*)d_in[20]; p.e_up = (const float*)d_in[21]; p.e_down = (const float*)d_in[22]; p.fin_g = (const float*)d_in[23];
    p.out = (float*)d_out; p.ws = (unsigned char*)d_ws;
    (void)hipMemsetAsync((unsigned char*)d_ws + OFF_J, 0, J_ZERO_BYTES, stream);
    void* args[] = {&p};
    hipError_t e = hipLaunchCooperativeKernel((const void*)fwd_megakernel, dim3(grid_blocks), dim3(NTHREADS), args, 0, stream);
    if (e != hipSuccess) fprintf(stderr, "cooperative launch failed: %s (grid %d)\n", hipGetErrorString(e), grid_blocks);
}
```

```cpp
#include <hip/hip_runtime.h>
#include <cstdio>

typedef unsigned short bf16_t;
typedef short bf16x8 __attribute__((ext_vector_type(8)));
typedef float f32x4 __attribute__((ext_vector_type(4)));
typedef float f32x2 __attribute__((ext_vector_type(2)));
typedef unsigned u32x2 __attribute__((ext_vector_type(2)));
typedef unsigned u32x4 __attribute__((ext_vector_type(4)));

#ifndef REP0
#define REP0 1
#endif
#ifndef REP1
#define REP1 1
#endif
#ifndef REP2
#define REP2 1
#endif
#ifndef REP3
#define REP3 1
#endif
#ifndef REP4
#define REP4 1
#endif
#ifndef REP5
#define REP5 1
#endif
#ifndef REP7
#define REP7 1
#endif
#ifndef REP9
#define REP9 1
#endif
#ifndef REP10
#define REP10 1
#endif
#ifndef REP11
#define REP11 1
#endif
#ifndef REP12
#define REP12 1
#endif
#ifndef REP8
#define REP8 1
#endif
#ifndef REP0C
#define REP0C 1
#endif
#ifndef REP0A
#define REP0A 1
#endif
#ifndef REP0B
#define REP0B 1
#endif
#ifndef REP0D
#define REP0D 1
#endif
#ifndef REP0E
#define REP0E 1
#endif
constexpr int D = 1024, BATCH = 4, SEQ = 4096, T = BATCH * SEQ;
constexpr int FW = 512, SW = 512, INW = 3072;
constexpr int SG = 32, SC = 16, SN = 64;
constexpr int LC = 32, NCH = SEQ / LC, ROWS = T / LC;
constexpr int UK = 768;
constexpr int NE = 64, DE = 512, LISTCAP = 16384;
constexpr int NTHREADS = 512, NWAVES = 8;
constexpr int SMEM_BYTES = 156 * 1024;

constexpr size_t MiB = 1024 * 1024;
constexpr size_t OFF_WGUT = 0;
constexpr size_t OFF_WDT  = OFF_WGUT + 128 * MiB;
constexpr size_t OFF_WINT = OFF_WDT + 64 * MiB;
constexpr size_t OFF_WPT  = OFF_WINT + 6 * MiB;
constexpr size_t OFF_WGLT = OFF_WPT + 2 * MiB;
constexpr size_t OFF_WSOT = OFF_WGLT + MiB / 2;
constexpr size_t OFF_WOT  = OFF_WSOT + 1 * MiB;
constexpr size_t OFF_BTS  = OFF_WOT + 2 * MiB;
constexpr size_t OFF_BTY  = OFF_BTS + 8 * MiB;
constexpr size_t OFF_C    = OFF_BTY + 24 * MiB;
constexpr size_t OFF_D    = OFF_C + 64 * MiB;
constexpr size_t OFF_E    = OFF_D + 32 * MiB;
constexpr size_t OFF_FG   = OFF_E + 64 * MiB;
constexpr size_t OFF_H    = OFF_FG + 32 * MiB;
constexpr size_t OFF_I    = OFF_H + 24 * MiB;
constexpr size_t OFF_J    = OFF_I + 32 * MiB;
constexpr size_t J_CNT   = 0;
constexpr size_t J_BAR   = 4096;
constexpr size_t J_ZERO_BYTES = 20480;
constexpr size_t J_TS    = 24576;
constexpr size_t J_AL    = 32768;
constexpr size_t J_TOKW    = 65536;
constexpr size_t J_TOKINFO = 196608;
constexpr size_t J_SLOTASG = 458752;
constexpr size_t J_SLOTW   = 655360;
constexpr size_t J_SLOTTOK = 1703936;
constexpr size_t J_HIST    = 851968;
constexpr size_t J_WRT     = 1048576;
constexpr size_t J_BTA     = 1441792;
constexpr size_t J_BTC     = 1507328;
constexpr size_t J_TW      = 1638400;
constexpr size_t WS_NEED = OFF_J + 2 * MiB;
constexpr int TAB_LDS_OFF = 131072;
constexpr int BAR_LDS_OFF = SMEM_BYTES - 16;

struct Params {
    const float* x; const float* mix_g; const float* w_in; const float* w_fo;
    const float* A_re; const float* A_im; const float* log_dt; const float* B_re; const float* B_im; const float* C_re; const float* C_im;
    const float* ssm_D; const float* w_glu; const float* w_sso; const float* w_out; const float* ffn_g;
    const float* rg_w; const float* rg_b; const float* re_w; const float* re_b;
    const float* e_gate; const float* e_up; const float* e_down; const float* fin_g;
    float* out; unsigned char* ws;
};

__device__ __forceinline__ bf16_t f2bf(float f) { return __builtin_bit_cast(bf16_t, (__bf16)f); }
__device__ __forceinline__ float bf2f(bf16_t b) { return __uint_as_float(((unsigned)b) << 16); }
typedef __bf16 bf16x2_hw __attribute__((ext_vector_type(2)));
__device__ __forceinline__ unsigned pack2(float lo, float hi) { const f32x2 v = {lo, hi}; return __builtin_bit_cast(unsigned, __builtin_convertvector(v, bf16x2_hw)); }
__device__ __forceinline__ float sigmoidf_(float v) { return __builtin_amdgcn_rcpf(1.0f + __expf(-v)); }
__device__ __forceinline__ float gelu_tanh(float v) { const float u = 1.5957691216057308f * (v + 0.044715f * v * v * v); return v * __builtin_amdgcn_rcpf(1.0f + __expf(-u)); }
__device__ __forceinline__ float wave_sum(float v) {
#pragma unroll
    for (int o = 32; o > 0; o >>= 1) v += __shfl_xor(v, o);
    return v;
}


#define LAS __attribute__((address_space(3)))
#define XB_TMO      128
#define XB_XCNT(j)  (256  + 64 * (j))
#define XB_XSUB(j)  (1280 + 64 * (j))
#define XB_XGEN(j)  (2304 + 64 * (j))
#define XB_TOP      3328
#define XB_TOPGEN   3392
#define XCD_BAR_WORDS 3456
#define XB_SPIN_CAP (1u << 18)
__device__ __forceinline__ unsigned xb_ld(unsigned* p)              { return __hip_atomic_load(p, __ATOMIC_RELAXED, __HIP_MEMORY_SCOPE_AGENT); }
__device__ __forceinline__ unsigned xb_add(unsigned* p, unsigned v) { return __hip_atomic_fetch_add(p, v, __ATOMIC_RELAXED, __HIP_MEMORY_SCOPE_AGENT); }
__device__ __forceinline__ unsigned xb_xcc_id() { return (unsigned)__builtin_amdgcn_s_getreg((3 << 11) | 20) & 0xFu; }
#define XB_SPIN(cond, bar) do { unsigned _sp = 0; while (cond) { __builtin_amdgcn_s_sleep(1); \
    if ((++_sp & 255u) == 0u) { if (xb_ld(&(bar)[XB_TMO])) break; if (_sp > XB_SPIN_CAP) { atomicAdd(&(bar)[XB_TMO], 1u); break; } } } } while (0)
struct XcdBarrier { unsigned* bar; unsigned x; volatile LAS unsigned* st; };
__device__ __forceinline__ XcdBarrier xcd_barrier_post(unsigned* bar, volatile LAS unsigned* st) {
    XcdBarrier b; b.bar = bar; b.x = xb_xcc_id(); b.st = st;
    if (threadIdx.x == 0) (void)xb_add(&bar[XB_XCNT(b.x)], 1u);
    return b;
}
__device__ __forceinline__ void xcd_barrier_complete(unsigned* bar, unsigned x, unsigned& nloc, unsigned& nx) {
    const unsigned G = gridDim.x * gridDim.y * gridDim.z;
    unsigned sum, cnt, mine, sp = 0u;
    for (;;) {
        sum = 0u; cnt = 0u; mine = 0u;
#pragma unroll
        for (unsigned j = 0; j < 16; ++j) { const unsigned c = xb_ld(&bar[XB_XCNT(j)]); sum += c; cnt += (c > 0u) ? 1u : 0u; mine = (j == x) ? c : mine; }
        if (sum == G) break;
        __builtin_amdgcn_s_sleep(1);
        if ((++sp & 255u) == 0u) { if (xb_ld(&bar[XB_TMO])) break; if (sp > XB_SPIN_CAP) { atomicAdd(&bar[XB_TMO], 1u); break; } }
    }
    nloc = mine > 0u ? mine : 1u; nx = cnt > 0u ? cnt : 1u;
}
__device__ __forceinline__ void xcd_barrier(const XcdBarrier& b) {
    asm volatile("s_waitcnt vmcnt(0)" ::: "memory");
    __syncthreads();
    if (threadIdx.x == 0) {
        unsigned* bar = b.bar;
        __builtin_amdgcn_s_waitcnt(0);
        unsigned nloc = b.st[0], nx = b.st[1];
        if (nloc == 0u) { xcd_barrier_complete(bar, b.x, nloc, nx); b.st[0] = nloc; b.st[1] = nx; }
        const unsigned old = xb_add(&bar[XB_XSUB(b.x)], 1u);
        const unsigned gen = old / nloc;
        if (old + 1u == (gen + 1u) * nloc) {
            __builtin_amdgcn_fence(__ATOMIC_RELEASE, "agent");
            asm volatile("s_waitcnt vmcnt(0)" ::: "memory");
            const unsigned og = xb_add(&bar[XB_TOP], 1u);
            const unsigned tg = og / nx;
            if (og + 1u == (tg + 1u) * nx) xb_add(&bar[XB_TOPGEN], 1u);
            else XB_SPIN(xb_ld(&bar[XB_TOPGEN]) == tg, bar);
            __builtin_amdgcn_fence(__ATOMIC_ACQUIRE, "agent");
            xb_add(&bar[XB_XGEN(b.x)], 1u);
            asm volatile("s_waitcnt vmcnt(0)" ::: "memory");
        } else {
            XB_SPIN(xb_ld(&bar[XB_XGEN(b.x)]) == gen, bar);
            __builtin_amdgcn_fence(__ATOMIC_ACQUIRE, "agent");
            asm volatile("s_waitcnt vmcnt(0)" ::: "memory");
        }
    }
    __syncthreads();
}

namespace g8 {
constexpr int BM = 256, BK = 64, HALF = 128, HTB = HALF * BK * 2, STAGE_BYTES = 8 * HTB;
__device__ __forceinline__ int lds_byte(int r, int c) { const int st = (r >> 4) * 2 + (c >> 5), rr = r & 15, cc = c & 31, ob = rr * 64 + cc * 2; return st * 1024 + (ob ^ (((ob >> 9) & 1) << 5)); }
__device__ __forceinline__ void stage_rc(int b, int& R, int& C) { const int st = b / 1024, sb = b % 1024, swz = sb ^ (((sb >> 9) & 1) << 5); R = (st >> 1) * 16 + swz / 64; C = (st & 1) * 32 + (swz % 64) / 2; }
struct Unit { const char* A; const char* B; int r0, c0, aux, nrows; const int* ridx; };

struct DenseSched {
    const char* A; const char* B; size_t gsA, gsB; int lda, ldb, nM, nN, nG, G, c;
    __device__ __forceinline__ bool next(int i, Unit& u) const {
        const int nMt = nM * nG, nwg = nMt * nN;
        const long L = (long)i * G + c; if (L >= nwg) return false;
        int wgid = (int)L; { const int q = nwg / 8, r = nwg % 8, xcd = wgid % 8, off = wgid / 8; wgid = (xcd < r ? xcd * (q + 1) : r * (q + 1) + (xcd - r) * q) + off; }
        const int nig = 8 * nN, gid = wgid / nig, fm = gid * 8, gsz = (nMt - fm) < 8 ? (nMt - fm) : 8;
        const int pmt = fm + ((wgid % nig) % gsz), pn = (wgid % nig) / gsz;
        const int g = pmt / nM, pm = pmt % nM;
        u.A = A + (size_t)g * gsA + (size_t)pm * BM * lda * 2; u.B = B + (size_t)g * gsB + (size_t)pn * BM * ldb * 2;
        u.r0 = pm * BM; u.c0 = pn * BM; u.aux = g; u.nrows = BM; u.ridx = nullptr; return true;
    }
};

struct HalfSched {
    const char* A; const char* B; size_t gsA, gsB; int lda, ldb, nM, nN, nG, G, c;
    __device__ __forceinline__ bool next(int i, Unit& u) const {
        const int nH = 2 * nM * nG, nwg = nH * nN;
        const long L = (long)i * G + c; if (L >= nwg) return false;
        int wgid = (int)L; { const int q = nwg / 8, r = nwg % 8, xcd = wgid % 8, off = wgid / 8; wgid = (xcd < r ? xcd * (q + 1) : r * (q + 1) + (xcd - r) * q) + off; }
        const int ht = wgid / nN, pn = wgid % nN, g = ht / (2 * nM), hm = ht % (2 * nM);
        u.A = A + (size_t)g * gsA + (size_t)hm * HALF * lda * 2; u.B = B + (size_t)g * gsB + (size_t)pn * BM * ldb * 2;
        u.r0 = hm * HALF; u.c0 = pn * BM; u.aux = g; u.nrows = HALF; u.ridx = nullptr; return true;
    }
};

struct RaggedSched {
    const char* A; const char* B; const LAS int* tab; size_t gsB; int lda, ldb, nN, G, c; const int* ridx;
    __device__ __forceinline__ static int remap(int wgid, int nwg) { const int q = nwg / 8, r = nwg % 8, xcd = wgid % 8, off = wgid / 8; return (xcd < r ? xcd * (q + 1) : r * (q + 1) + (xcd - r) * q) + off; }
    __device__ __forceinline__ bool next(int i, Unit& u) const {
        const int nF = tab[128 + 64] * nN, nR = tab[200 + 64] * nN;
        const long L = (long)i * G + c; if (L >= nF + nR) return false;
        int e = 0, mt, pn;
        if (L < nF) { const int w = remap((int)L, nF); const int rt = w / nN; pn = w % nN; while (tab[128 + e + 1] <= rt) ++e; mt = rt - tab[128 + e]; }
        else { const int w = remap((int)L - nF, nR); const int rt = w / nN; pn = w % nN; while (tab[200 + e + 1] <= rt) ++e; mt = tab[e] >> 8; }
        const int cnt = tab[e], ro = tab[64 + e] + mt * BM;
        u.A = ridx ? A : A + (size_t)ro * lda * 2; u.B = B + (size_t)e * gsB + (size_t)pn * BM * ldb * 2; u.ridx = ridx ? ridx + ro : nullptr;
        u.r0 = ro; u.c0 = pn * BM; u.aux = e; u.nrows = (cnt - mt * BM) < BM ? (cnt - mt * BM) : BM; return true;
    }
};

__device__ __forceinline__ int perm32(int rho) { const int n = rho >> 4, i = rho & 15; return 8 * (i >> 2) + 4 * n + (i & 3); }
template <bool RAGGED = false, bool GATHER = false, bool PERM = false, class Sched, class Epi>
__device__ __forceinline__ void gemm_phase(LAS unsigned char* lds, const int K, const int lda, const int ldb, const Sched& S, const Epi& E) {
    int tid = threadIdx.x; asm volatile("" : "+v"(tid));
    const int wid = __builtin_amdgcn_readfirstlane(tid >> 6), lane = tid & 63, wr = wid >> 2, wc = wid & 3, fr = lane & 15, fq = lane >> 4;
    int nt = K / BK; asm volatile("" : "+s"(nt));
    unsigned voffA[2], voffB[2]; int stR[2], stC[2];
#pragma unroll
    for (int i = 0; i < 2; ++i) { int R, C; stage_rc(tid * 16 + i * 8192, R, C); stR[i] = R; stC[i] = C; voffA[i] = (unsigned)(R * lda + C) * 2u; const int Rb = PERM ? ((R & ~31) + perm32(R & 31)) : R; voffB[i] = (unsigned)(Rb * ldb + C) * 2u; }
    unsigned gA0[2], gA1[2], gN0[2], gN1[2];
#define G8_GOFF(u, d0, d1) do { _Pragma("unroll") for (int _i = 0; _i < 2; ++_i) { \
        const int _r0 = stR[_i] < (u).nrows ? stR[_i] : 0, _r1 = (HALF + stR[_i]) < (u).nrows ? HALF + stR[_i] : 0; \
        d0[_i] = (unsigned)((u).ridx[_r0] * lda + stC[_i]) * 2u; d1[_i] = (unsigned)((u).ridx[_r1] * lda + stC[_i]) * 2u; } } while (0)
    const size_t kstep = (size_t)(BK * 2);
    const size_t hstepA = (size_t)HALF * lda * 2, hstepB = (size_t)HALF * ldb * 2;
    const unsigned ldsw = (unsigned)wid * 1024u;
    const int aoff = lds_byte(wr * 64 + fr, fq * 8), boff = lds_byte(wc * 32 + fr, fq * 8);
#define G8_SA(b, h) (((b) * 2 + (h)) * HTB)
#define G8_SB(b, h) ((4 + (b) * 2 + (h)) * HTB)
#define G8_STAGE(bufoff, gbase, voff) do { _Pragma("unroll") for (int _i = 0; _i < 2; ++_i) \
        __builtin_amdgcn_global_load_lds((const unsigned*)((const char*)(gbase) + (voff)[_i]), (LAS unsigned*)(lds + (bufoff) + ldsw + _i * 8192), 16, 0, 0); } while (0)
#define G8_LDA(dst, b, h) do { _Pragma("unroll") for (int m = 0; m < 4; ++m) _Pragma("unroll") for (int k = 0; k < 2; ++k) dst[m][k] = *(const LAS bf16x8*)(lds + G8_SA(b, h) + aoff + m * 2048 + k * 1024); } while (0)
#define G8_LDB(dst, b, h) do { _Pragma("unroll") for (int n = 0; n < 2; ++n) _Pragma("unroll") for (int k = 0; k < 2; ++k) dst[n][k] = *(const LAS bf16x8*)(lds + G8_SB(b, h) + boff + n * 2048 + k * 1024); } while (0)
#define G8_MMA(ai, bj, At, Bt) do { __builtin_amdgcn_s_setprio(1); _Pragma("unroll") for (int m = 0; m < 4; ++m) _Pragma("unroll") for (int n = 0; n < 2; ++n) _Pragma("unroll") for (int k = 0; k < 2; ++k) \
        acc[ai][bj][m][n] = __builtin_amdgcn_mfma_f32_16x16x32_bf16(Bt[n][k], At[m][k], acc[ai][bj][m][n], 0, 0, 0); __builtin_amdgcn_s_setprio(0); } while (0)
#define G8_WAIT_V(n) asm volatile("s_waitcnt vmcnt(" #n ")" ::: "memory")
#define G8_WAIT_L(n) asm volatile("s_waitcnt lgkmcnt(" #n ")" ::: "memory")
#define G8_BAR __builtin_amdgcn_s_barrier()
#define G8_SCHED __builtin_amdgcn_sched_barrier(0)
    Unit cur, nxt; int ui = 0;
    if (!S.next(0, cur)) return;
    f32x4 acc[2][2][4][2];
#pragma unroll
    for (int a = 0; a < 2; ++a)
#pragma unroll
        for (int b = 0; b < 2; ++b)
#pragma unroll
            for (int m = 0; m < 4; ++m)
#pragma unroll
                for (int n = 0; n < 2; ++n) acc[a][b][m][n] = (f32x4){0.f, 0.f, 0.f, 0.f};
    bf16x8 At[4][2], B0[2][2], B1[2][2];
    const char* cA = cur.A; const char* cB = cur.B;
    if (GATHER) { G8_GOFF(cur, gA0, gA1); _Pragma("unroll") for (int _i = 0; _i < 2; ++_i) { gN0[_i] = gA0[_i]; gN1[_i] = gA1[_i]; } }
#define G8_STAGE_A(bufoff, gbase, half, nx) do { if (GATHER) { unsigned _v[2]; _Pragma("unroll") for (int _i = 0; _i < 2; ++_i) _v[_i] = (nx) ? ((half) ? gN1[_i] : gN0[_i]) : ((half) ? gA1[_i] : gA0[_i]); G8_STAGE(bufoff, gbase, _v); } \
        else { G8_STAGE(bufoff, (gbase) + ((half) ? hstepA : 0), voffA); } } while (0)
    G8_STAGE(G8_SB(0, 0), cB, voffB); G8_STAGE_A(G8_SA(0, 0), cA, 0, false); G8_STAGE(G8_SB(0, 1), cB + hstepB, voffB); G8_STAGE_A(G8_SA(0, 1), cA, 1, false);
    if (wr == 1) G8_BAR;
    G8_WAIT_V(4); G8_BAR;
    G8_STAGE(G8_SB(1, 0), cB + kstep, voffB); G8_STAGE_A(G8_SA(1, 0), cA + kstep, 0, false); G8_STAGE(G8_SB(1, 1), cB + hstepB + kstep, voffB);
    G8_WAIT_V(6); G8_BAR;
    for (;;) {
        const bool has_next = S.next(ui + 1, nxt);
        const bool do0 = !RAGGED || (wr * 64 < cur.nrows), do1 = !RAGGED || (HALF + wr * 64 < cur.nrows);
        if (GATHER && has_next) G8_GOFF(nxt, gN0, gN1);
        const char* nA = has_next ? nxt.A : cA; const char* nB = has_next ? nxt.B : cB;
        for (int t = 0; t < nt; t += 2) {
            const bool last = (t == nt - 2);
            const char* a1 = cA + (size_t)(t + 1) * kstep;
            const char* a2 = last ? nA : cA + (size_t)(t + 2) * kstep; const char* b2 = last ? nB : cB + (size_t)(t + 2) * kstep;
            const char* a3 = a2 + kstep; const char* b3 = b2 + kstep;
            G8_LDB(B0, 0, 0); G8_SCHED; G8_LDA(At, 0, 0); G8_STAGE_A(G8_SA(1, 1), a1, 1, false);
            G8_WAIT_L(8); G8_BAR; G8_WAIT_L(0); if (do0) G8_MMA(0, 0, At, B0); G8_BAR; G8_SCHED;
            G8_LDB(B1, 0, 1); G8_STAGE(G8_SB(0, 0), b2, voffB);
            G8_BAR; G8_WAIT_L(0); if (do0) G8_MMA(0, 1, At, B1); G8_BAR;
            G8_LDA(At, 0, 1); G8_STAGE_A(G8_SA(0, 0), a2, 0, last);
            G8_BAR; G8_WAIT_L(0); if (do1) G8_MMA(1, 0, At, B0); G8_BAR; G8_SCHED;
            G8_STAGE(G8_SB(0, 1), b2 + hstepB, voffB);
            G8_WAIT_V(6); G8_BAR; if (do1) G8_MMA(1, 1, At, B1); G8_BAR;
            G8_LDB(B0, 1, 0); G8_SCHED; G8_LDA(At, 1, 0); G8_STAGE_A(G8_SA(0, 1), a2, 1, last);
            G8_WAIT_L(8); G8_BAR; G8_WAIT_L(0); if (do0) G8_MMA(0, 0, At, B0); G8_BAR; G8_SCHED;
            G8_LDB(B1, 1, 1); G8_STAGE(G8_SB(1, 0), b3, voffB);
            G8_BAR; G8_WAIT_L(0); if (do0) G8_MMA(0, 1, At, B1); G8_BAR;
            G8_LDA(At, 1, 1); G8_STAGE_A(G8_SA(1, 0), a3, 0, last);
            G8_BAR; G8_WAIT_L(0); if (do1) G8_MMA(1, 0, At, B0); G8_BAR; G8_SCHED;
            G8_STAGE(G8_SB(1, 1), b3 + hstepB, voffB);
            G8_WAIT_V(6); G8_BAR; if (do1) G8_MMA(1, 1, At, B1); G8_BAR;
        }
        if constexpr (PERM) {
            typedef decltype(E.load(cur, 0, 0)) AuxT_;
            constexpr int GS = sizeof(AuxT_) <= 16 ? 8 : (sizeof(AuxT_) <= 32 ? 4 : 2), NG = 16 / GS;
            AuxT_ ax[2][GS];
#define G8_ROW(e) ((((e) >> 3) & 1) * HALF + wr * 64 + (((e) >> 1) & 3) * 16 + fr)
#define G8_COL(e) (((e) & 1) * HALF + wc * 32 + 8 * fq)
#pragma unroll
            for (int j = 0; j < GS; ++j) ax[0][j] = E.load(cur, G8_ROW(j), G8_COL(j));
#pragma unroll
            for (int g = 0; g < NG; ++g) {
                if (g + 1 < NG) {
#pragma unroll
                    for (int j = 0; j < GS; ++j) ax[(g + 1) & 1][j] = E.load(cur, G8_ROW((g + 1) * GS + j), G8_COL((g + 1) * GS + j));
                }
#pragma unroll
                for (int j = 0; j < GS; ++j) { const int e = g * GS + j; E.store(cur, G8_ROW(e), G8_COL(e), acc[(e >> 3) & 1][e & 1][(e >> 1) & 3][0], acc[(e >> 3) & 1][e & 1][(e >> 1) & 3][1], ax[g & 1][j]); }
            }
#undef G8_ROW
#undef G8_COL
        } else
        {
            typedef decltype(E.load(cur, 0, 0)) AuxT_;
            constexpr int GS = sizeof(AuxT_) <= 8 ? 16 : (sizeof(AuxT_) <= 16 ? 8 : 4), NG = 32 / GS;
            AuxT_ ax[2][GS];
#define G8_ROW(e) ((((e) >> 4) & 1) * HALF + wr * 64 + (((e) >> 2) & 3) * 16 + fr)
#define G8_COL(e) ((((e) >> 1) & 1) * HALF + wc * 32 + ((e) & 1) * 16 + 4 * fq)
#pragma unroll
            for (int j = 0; j < GS; ++j) ax[0][j] = E.load(cur, G8_ROW(j), G8_COL(j));
#pragma unroll
            for (int g = 0; g < NG; ++g) {
                if (g + 1 < NG) {
#pragma unroll
                    for (int j = 0; j < GS; ++j) ax[(g + 1) & 1][j] = E.load(cur, G8_ROW((g + 1) * GS + j), G8_COL((g + 1) * GS + j));
                }
#pragma unroll
                for (int j = 0; j < GS; ++j) { const int e = g * GS + j; E.store(cur, G8_ROW(e), G8_COL(e), acc[(e >> 4) & 1][(e >> 1) & 1][(e >> 2) & 3][e & 1], ax[g & 1][j]); }
            }
#undef G8_ROW
#undef G8_COL
        }
        if (!has_next) break;
#pragma unroll
        for (int a = 0; a < 2; ++a)
#pragma unroll
            for (int b = 0; b < 2; ++b)
#pragma unroll
                for (int m = 0; m < 4; ++m)
#pragma unroll
                    for (int n = 0; n < 2; ++n) acc[a][b][m][n] = (f32x4){0.f, 0.f, 0.f, 0.f};
        cur = nxt; cA = nA; cB = nB; ++ui;
        if (GATHER) { _Pragma("unroll") for (int _i = 0; _i < 2; ++_i) { gA0[_i] = gN0[_i]; gA1[_i] = gN1[_i]; } }
    }
    G8_WAIT_V(0);
    if (wr == 0) G8_BAR;
    G8_BAR;
#undef G8_SA
#undef G8_SB
#undef G8_STAGE
#undef G8_STAGE_A
#undef G8_GOFF
#undef G8_LDA
#undef G8_LDB
#undef G8_MMA
#undef G8_WAIT_V
#undef G8_WAIT_L
#undef G8_BAR
#undef G8_SCHED
}
}

struct NoAux {};
template <class F> struct EpiNoLoad {
    F f;
    __device__ __forceinline__ NoAux load(const g8::Unit&, int, int) const { return NoAux{}; }
    __device__ __forceinline__ void store(const g8::Unit& u, int rl, int cl, f32x4 v, const NoAux&) const { f(u, rl, cl, v); }
};
template <class F> __device__ __forceinline__ EpiNoLoad<F> epi_noload(const F& f) { return EpiNoLoad<F>{f}; }
template <class L, class S> struct EpiLS {
    L l; S s;
    __device__ __forceinline__ auto load(const g8::Unit& u, int rl, int cl) const { return l(u, rl, cl); }
    template <class A> __device__ __forceinline__ void store(const g8::Unit& u, int rl, int cl, f32x4 v, const A& a) const { s(u, rl, cl, v, a); }
};
template <class L, class S> __device__ __forceinline__ EpiLS<L, S> epi_ls(const L& l, const S& s) { return EpiLS<L, S>{l, s}; }
template <class F> struct EpiNoLoad8 {
    F f;
    __device__ __forceinline__ NoAux load(const g8::Unit&, int, int) const { return NoAux{}; }
    __device__ __forceinline__ void store(const g8::Unit& u, int rl, int cl, f32x4 v0, f32x4 v1, const NoAux&) const { f(u, rl, cl, v0, v1); }
};
template <class F> __device__ __forceinline__ EpiNoLoad8<F> epi_noload8(const F& f) { return EpiNoLoad8<F>{f}; }
template <class L, class S> struct EpiLS8 {
    L l; S s;
    __device__ __forceinline__ auto load(const g8::Unit& u, int rl, int cl) const { return l(u, rl, cl); }
    template <class A> __device__ __forceinline__ void store(const g8::Unit& u, int rl, int cl, f32x4 v0, f32x4 v1, const A& a) const { s(u, rl, cl, v0, v1, a); }
};
template <class L, class S> __device__ __forceinline__ EpiLS8<L, S> epi_ls8(const L& l, const S& s) { return EpiLS8<L, S>{l, s}; }
__device__ __forceinline__ float bflo(unsigned w) { return __uint_as_float(w << 16); }
__device__ __forceinline__ float bfhi(unsigned w) { return __uint_as_float(w & 0xffff0000u); }
struct Aux2 { u32x2 a, b; };
struct Aux44 { u32x4 a, b; };
struct AuxY8 { u32x4 uu; f32x4 d0, d1; };
struct AuxY { u32x2 uu; f32x4 dd; };
struct AuxT { f32x2 t0, t1; };
struct AuxS { int as; float w; };

template <bool PERM = false, class Epi>
__device__ __forceinline__ void half_gemm(LAS unsigned char* lds, const bf16_t* A, const bf16_t* B, int M, int N, int K, int lda, int ldb, int nG, size_t gsA, size_t gsB, const Epi& E) {
    g8::HalfSched S; S.A = (const char*)A; S.B = (const char*)B; S.gsA = gsA * 2; S.gsB = gsB * 2; S.lda = lda; S.ldb = ldb; S.nM = M / 256; S.nN = N / 256; S.nG = nG; S.G = gridDim.x; S.c = blockIdx.x;
    g8::gemm_phase<true, false, PERM>(lds, K, lda, ldb, S, E);
}
template <bool PERM = false, class Epi>
__device__ __forceinline__ void dense_gemm(LAS unsigned char* lds, const bf16_t* A, const bf16_t* B, int M, int N, int K, int lda, int ldb, int nG, size_t gsA, size_t gsB, const Epi& E) {
    g8::DenseSched S; S.A = (const char*)A; S.B = (const char*)B; S.gsA = gsA * 2; S.gsB = gsB * 2; S.lda = lda; S.ldb = ldb; S.nM = M / 256; S.nN = N / 256; S.nG = nG; S.G = gridDim.x; S.c = blockIdx.x;
    g8::gemm_phase<false, false, PERM>(lds, K, lda, ldb, S, E);
}

struct TJob { const float* src; bf16_t* dst; int K, N, nmul, nadd, tile; };
__device__ __forceinline__ void tjob_load(const TJob& j, const int lane, f32x4 (&v)[16]) {
    const int tk = j.K / 64, k0 = (j.tile % tk) * 64, n0 = (j.tile / tk) * 64;
#pragma unroll
    for (int i = 0; i < 16; ++i) v[i] = *(const f32x4*)(j.src + (size_t)(k0 + i * 4 + (lane >> 4)) * j.N + n0 + (lane & 15) * 4);
}
__device__ __forceinline__ void tjob_process(const TJob& j, const int lane, const f32x4 (&v)[16], float* lds) {
    const int tk = j.K / 64, k0 = (j.tile % tk) * 64, n0 = (j.tile / tk) * 64;
#pragma unroll
    for (int i = 0; i < 16; ++i) {
        const int kk = i * 4 + (lane >> 4), c4 = (lane & 15) * 4;
        lds[kk * 65 + c4 + 0] = v[i][0]; lds[kk * 65 + c4 + 1] = v[i][1]; lds[kk * 65 + c4 + 2] = v[i][2]; lds[kk * 65 + c4 + 3] = v[i][3];
    }
    asm volatile("s_waitcnt lgkmcnt(0)" ::: "memory");
    const int kc = (lane & 7) * 8;
#pragma unroll
    for (int it = 0; it < 8; ++it) {
        const int n = it * 8 + (lane >> 3);
        u32x4 w;
        w[0] = pack2(lds[(kc + 0) * 65 + n], lds[(kc + 1) * 65 + n]);
        w[1] = pack2(lds[(kc + 2) * 65 + n], lds[(kc + 3) * 65 + n]);
        w[2] = pack2(lds[(kc + 4) * 65 + n], lds[(kc + 5) * 65 + n]);
        w[3] = pack2(lds[(kc + 6) * 65 + n], lds[(kc + 7) * 65 + n]);
        *(u32x4*)(j.dst + (size_t)((n0 + n) * j.nmul + j.nadd) * j.K + k0 + kc) = w;
    }
    asm volatile("s_waitcnt lgkmcnt(0)" ::: "memory");
}

__device__ void ssm_prep_job(const Params& p, const int g, const int part, float* lds) {
    f32x2* pw = (f32x2*)lds;
    f32x2* bb = pw + 4224;
    f32x2* cm = bb + 2048;
    float* kt = (float*)(cm + 2048);
    const int t = threadIdx.x;
    bf16_t* BtS = (bf16_t*)(p.ws + OFF_BTS) + (size_t)g * 256 * 512;
    bf16_t* BtY = (bf16_t*)(p.ws + OFF_BTY) + (size_t)g * 512 * UK;
    f32x2* aL = (f32x2*)(p.ws + OFF_J + J_AL);
    __syncthreads();
    for (int i = t; i < 2 * 64 * 33; i += NTHREADS) {
        const int dir = i / (64 * 33), n = (i / 33) % 64, tau = i % 33;
        const float are = p.A_re[(dir * SG + g) * SN + n], aim = p.A_im[(dir * SG + g) * SN + n];
        const float dt = expf(p.log_dt[dir * SG + g]);
        const float mag = expf(are * dt * (float)tau); float sv, cv; sincosf(aim * dt * (float)tau, &sv, &cv);
        pw[i] = (f32x2){mag * cv, mag * sv};
        if (tau == 32 && part == 0) aL[(dir * SG + g) * SN + n] = pw[i];
    }
    for (int i = t; i < 2 * 64 * 16; i += NTHREADS) {
        const int dir = i / 1024, n = (i / 16) % 64, ci = i % 16;
        const float are = p.A_re[(dir * SG + g) * SN + n], aim = p.A_im[(dir * SG + g) * SN + n];
        const float dt = expf(p.log_dt[dir * SG + g]);
        float sv, cv; sincosf(aim * dt, &sv, &cv);
        const float mag = expf(are * dt), nr = mag * cv - 1.0f, ni = mag * sv;
        const float den = are * are + aim * aim;
        const float qr = (nr * are + ni * aim) / den, qi = (ni * are - nr * aim) / den;
        const size_t bi = ((size_t)(dir * SG + g) * SN + n) * SC + ci;
        const float br = p.B_re[bi], bim = p.B_im[bi];
        bb[i] = (f32x2){qr * br - qi * bim, qr * bim + qi * br};
    }
    for (int i = t; i < 2 * 16 * 64; i += NTHREADS) {
        const int dir = i / 1024, co = (i / 64) % 16, n = i % 64;
        const size_t ci_ = ((size_t)(dir * SG + g) * SC + co) * SN + n;
        cm[i] = (f32x2){p.C_re[ci_], p.C_im[ci_]};
    }
    __syncthreads();
    for (int i = t; i < 2 * 32 * 2 * 16; i += NTHREADS) {
        const int dir = i >> 10, tau = (i >> 5) & 31, col = (i >> 4) & 1, ci = i & 15, co = 2 * part + col;
        float s = 0.f;
        for (int n = 0; n < 64; ++n) {
            const f32x2 c = cm[(dir * 16 + co) * 64 + n], a = pw[(dir * 64 + n) * 33 + tau], b = bb[(dir * 64 + n) * 16 + ci];
            const float zr = c[0] * a[0] - c[1] * a[1], zi = c[0] * a[1] + c[1] * a[0];
            s += zr * b[0] - zi * b[1];
        }
        kt[i] = s;
    }
    __syncthreads();
    for (int i = t; i < 32 * 512; i += NTHREADS) {
        const int rr = i >> 9, col = i & 511;
        const int dir = rr >> 4, n = 8 * part + ((rr >> 1) & 7), ri = rr & 1, s = col >> 4, ci = col & 15;
        const int tau = dir == 0 ? (LC - 1 - s) : s;
        const f32x2 a = pw[(dir * 64 + n) * 33 + tau], b = bb[(dir * 64 + n) * 16 + ci];
        const float v = ri == 0 ? (a[0] * b[0] - a[1] * b[1]) : (a[0] * b[1] + a[1] * b[0]);
        BtS[(size_t)((dir * 64 + n) * 2 + ri) * 512 + col] = f2bf(v);
    }
    for (int rr = 0; rr < 64; ++rr) {
        const int tt = rr >> 1, col = rr & 1, co = 2 * part + col;
        for (int kk = t; kk < UK; kk += NTHREADS) {
            float v;
            if (kk < 512) {
                const int s = kk >> 4, ci = kk & 15;
                if (s < tt) v = kt[((0 * 32 + (tt - s)) * 2 + col) * 16 + ci];
                else if (s > tt) v = kt[((1 * 32 + (s - tt)) * 2 + col) * 16 + ci];
                else v = kt[((0 * 32 + 0) * 2 + col) * 16 + ci] + kt[((1 * 32 + 0) * 2 + col) * 16 + ci];
            } else {
                const int q = kk - 512, dir = q >> 7, n = (q >> 1) & 63, ri = q & 1;
                const int tau = dir == 0 ? (tt + 1) : (LC - tt);
                const f32x2 c = cm[(dir * 16 + co) * 64 + n], a = pw[(dir * 64 + n) * 33 + tau];
                const float zr = c[0] * a[0] - c[1] * a[1], zi = c[0] * a[1] + c[1] * a[0];
                v = ri == 0 ? zr : -zi;
            }
            BtY[(size_t)(tt * 16 + co) * UK + kk] = f2bf(v);
        }
    }
}

__device__ __forceinline__ void load_row(const float* row, const int lane, f32x4 (&v)[4]) {
#pragma unroll
    for (int i = 0; i < 4; ++i) v[i] = *(const f32x4*)(row + 4 * lane + 256 * i);
}
__device__ __forceinline__ float row_inv_rms(const f32x4 (&v)[4]) {
    float s = 0.f;
#pragma unroll
    for (int i = 0; i < 4; ++i) s += v[i][0] * v[i][0] + v[i][1] * v[i][1] + v[i][2] * v[i][2] + v[i][3] * v[i][3];
    s = wave_sum(s);
    return 1.0f / sqrtf(s * (1.0f / 1024.0f) + 1e-6f);
}

__global__ void __launch_bounds__(NTHREADS) fwd_megakernel(const Params p) {
    __shared__ __attribute__((aligned(16))) unsigned char smem[SMEM_BYTES];
#define PHASE_IDS int tid = threadIdx.x; asm volatile("" : "+v"(tid)); const int lane = tid & 63, wid = tid >> 6; \
    const int gw = blockIdx.x * NWAVES + wid, nw = gridDim.x * NWAVES, gt = blockIdx.x * NTHREADS + tid, nt = gridDim.x * NTHREADS; \
    (void)lane; (void)wid; (void)gw; (void)nw; (void)gt; (void)nt;
    unsigned char* ws = p.ws;
    bf16_t* WguT = (bf16_t*)(ws + OFF_WGUT); bf16_t* WdT = (bf16_t*)(ws + OFF_WDT);
    bf16_t* WinT = (bf16_t*)(ws + OFF_WINT); bf16_t* WpT = (bf16_t*)(ws + OFF_WPT); bf16_t* WglT = (bf16_t*)(ws + OFF_WGLT);
    bf16_t* WsoT = (bf16_t*)(ws + OFF_WSOT); bf16_t* WoT = (bf16_t*)(ws + OFF_WOT);
    bf16_t* BtS = (bf16_t*)(ws + OFF_BTS); bf16_t* BtY = (bf16_t*)(ws + OFF_BTY);
    bf16_t* T2 = (bf16_t*)(ws + OFF_C); bf16_t* ybuf = (bf16_t*)(ws + OFF_C);
    bf16_t* hn = (bf16_t*)(ws + OFF_D); bf16_t* Fb = (bf16_t*)(ws + OFF_D); bf16_t* hn2 = (bf16_t*)(ws + OFF_D);
    bf16_t* gates = (bf16_t*)(ws + OFF_E); bf16_t* act = (bf16_t*)(ws + OFF_E + 65 * MiB);
    bf16_t* XA = (bf16_t*)(ws + OFF_FG); float* Sst = (float*)(ws + OFF_FG + 16 * MiB); bf16_t* m1 = (bf16_t*)(ws + OFF_FG);
    bf16_t* Ucomb = (bf16_t*)(ws + OFF_H);
    bf16_t* yg = (bf16_t*)(ws + OFF_I); bf16_t* ys2 = (bf16_t*)(ws + OFF_I + 16 * MiB);
    unsigned* cnt = (unsigned*)(ws + OFF_J + J_CNT);
    const f32x2* aL = (const f32x2*)(ws + OFF_J + J_AL);
    f32x2* tokw = (f32x2*)(ws + OFF_J + J_TOKW);
    int* tokinfo = (int*)(ws + OFF_J + J_TOKINFO);
    int* slot_asg = (int*)(ws + OFF_J + J_SLOTASG);
    float* slot_w = (float*)(ws + OFF_J + J_SLOTW);
    int* hist = (int*)(ws + OFF_J + J_HIST);
    int* slot_tok = (int*)(ws + OFF_J + J_SLOTTOK);
    bf16_t* WrT = (bf16_t*)(ws + OFF_J + J_WRT);
    bf16_t* BtA = (bf16_t*)(ws + OFF_J + J_BTA); bf16_t* BtC = (bf16_t*)(ws + OFF_J + J_BTC); f32x2* TW = (f32x2*)(ws + OFF_J + J_TW);
    bf16_t* Xg = (bf16_t*)(ws + OFF_E);
    float* x2 = p.out;
    LAS unsigned char* ldsp = (LAS unsigned char*)smem;
    if (threadIdx.x == 0) { ((volatile LAS unsigned*)(ldsp + BAR_LDS_OFF))[0] = 0u; ((volatile LAS unsigned*)(ldsp + BAR_LDS_OFF))[1] = 0u; }
    __syncthreads();
    const XcdBarrier bar = xcd_barrier_post((unsigned*)(ws + OFF_J + J_BAR), (volatile LAS unsigned*)(ldsp + BAR_LDS_OFF));
#define GRID_SYNC() xcd_barrier(bar)
#if defined(TP_A)
    unsigned long long* tsp = (unsigned long long*)(ws + OFF_J + J_TS);
#define STAMP(k) do { if (blockIdx.x == 0 && threadIdx.x == 0) { __hip_atomic_store(tsp + (k), (unsigned long long)__builtin_amdgcn_s_memrealtime(), __ATOMIC_RELAXED, __HIP_MEMORY_SCOPE_AGENT); } } while (0)
#else
#define STAMP(k) do { } while (0)
#endif
    STAMP(0);

    for (int _rep = 0; _rep < REP0; ++_rep) {
    {
        PHASE_IDS
        auto rest = [&]() {
        for (int _rb = 0; _rb < REP0B; ++_rb) {
            f32x2* cst = (f32x2*)smem;
            if (tid < 128) { float sv, cv; sincospif((float)tid * (1.0f / 64.0f), &sv, &cv); cst[tid] = (f32x2){cv, sv}; }
            __syncthreads();
            for (int i = gt; i < 4 * 16 * 1024; i += nt) {
                const int d = i & 1023, cc = (i >> 10) & 15, g = i >> 14;
                const float* wp = p.w_fo + (size_t)(g * 128) * 1024 + d;
                float sr[8], si[8];
#pragma unroll
                for (int j = 0; j < 8; ++j) { sr[j] = 0.f; si[j] = 0.f; }
                for (int m = 0; m < 128; ++m) {
                    const float w = wp[(size_t)m * 1024];
#pragma unroll
                    for (int j = 0; j < 8; ++j) { const f32x2 t = cst[((cc * 8 + j) * m) & 127]; sr[j] += t[0] * w; si[j] += t[1] * w; }
                }
                u32x4 o0, o1;
                o0[0] = pack2(sr[0] * 0.08838834764831845f, si[0] * 0.08838834764831845f); o0[1] = pack2(sr[1] * 0.08838834764831845f, si[1] * 0.08838834764831845f);
                o0[2] = pack2(sr[2] * 0.08838834764831845f, si[2] * 0.08838834764831845f); o0[3] = pack2(sr[3] * 0.08838834764831845f, si[3] * 0.08838834764831845f);
                o1[0] = pack2(sr[4] * 0.08838834764831845f, si[4] * 0.08838834764831845f); o1[1] = pack2(sr[5] * 0.08838834764831845f, si[5] * 0.08838834764831845f);
                o1[2] = pack2(sr[6] * 0.08838834764831845f, si[6] * 0.08838834764831845f); o1[3] = pack2(sr[7] * 0.08838834764831845f, si[7] * 0.08838834764831845f);
                bf16_t* dst = WpT + (size_t)d * 1024 + g * 256 + cc * 16;
                *(u32x4*)dst = o0; *(u32x4*)(dst + 8) = o1;
            }
            __syncthreads();
        }
        STAMP(2);
        for (int _rc = 0; _rc < REP0C; ++_rc) {
        for (int i = gt; i < 80 * 2048; i += nt) {
            const int n = i >> 11, k = i & 2047, kk = k & 1023;
            const float w = n < 64 ? p.re_w[kk * 64 + n] : (n < 72 ? p.rg_w[kk * 8 + (n - 64)] : 0.f);
            const bf16_t hi = f2bf(w);
            WrT[i] = k < 1024 ? hi : f2bf(w - bf2f(hi));
        }
        for (int i = gt; i < 256 * 128; i += nt) {
            const int n = i >> 7, k = i & 127;
            const int w = n >> 7, k1 = (n >> 1) & 63, ri = n & 1, w2 = k >> 6, l1 = k & 63;
            float sv, cv; sincospif((float)((k1 * l1) & 63) * (1.0f / 32.0f), &sv, &cv);
            BtA[i] = f2bf(w == w2 ? (ri ? -sv : cv) * 0.125f : 0.f);
        }
        for (int i = gt; i < 256 * 256; i += nt) {
            const int n = i >> 8, k = i & 255;
            const int w = n >> 7, k2 = (n >> 1) & 63, ri = n & 1, w2 = k >> 7, l2 = (k >> 1) & 63, ri2 = k & 1;
            float sv, cv; sincospif((float)((k2 * l2) & 63) * (1.0f / 32.0f), &sv, &cv);
            const float v = ri == 0 ? (ri2 == 0 ? cv : sv) : (ri2 == 0 ? -sv : cv);
            BtC[i] = f2bf(w == w2 ? v * 0.125f : 0.f);
        }
        for (int i = gt; i < 64 * 64; i += nt) {
            const int k1 = i >> 6, l2 = i & 63;
            float sv, cv; sincospif((float)(k1 * l2) * (1.0f / 2048.0f), &sv, &cv);
            TW[i] = (f32x2){cv, -sv};
        }
        }
        STAMP(3);
        for (int _rd = 0; _rd < REP0D; ++_rd) for (int j = blockIdx.x; j < SG * 8; j += gridDim.x) ssm_prep_job(p, j >> 3, j & 7, (float*)smem);
        STAMP(4);
        for (int _re = 0; _re < REP0E; ++_re) for (int r = gw; r < T; r += nw) {
            f32x4 v[4]; load_row(p.x + (size_t)r * D, lane, v);
            const float inv = row_inv_rms(v);
            const int rp = (r & ~4095) | ((r & 63) << 6) | ((r >> 6) & 63);
#pragma unroll
            for (int i = 0; i < 4; ++i) {
                const f32x4 gg = *(const f32x4*)(p.mix_g + 4 * lane + 256 * i);
                u32x2 w; w[0] = pack2(v[i][0] * inv * gg[0], v[i][1] * inv * gg[1]); w[1] = pack2(v[i][2] * inv * gg[2], v[i][3] * inv * gg[3]);
                *(u32x2*)(hn + (size_t)rp * D + 4 * lane + 256 * i) = w;
            }
        }
            __syncthreads();
        };
        if (blockIdx.x & 1) rest();
        for (int _ra = 0; _ra < REP0A; ++_ra) {
#if defined(SHADOW_A)
            const size_t shadow = _ra ? OFF_C : 0;
            bf16_t* WinT = (bf16_t*)(ws + OFF_WINT + shadow); bf16_t* WglT = (bf16_t*)(ws + OFF_WGLT + shadow); bf16_t* WsoT = (bf16_t*)(ws + OFF_WSOT + shadow); bf16_t* WoT = (bf16_t*)(ws + OFF_WOT + shadow); bf16_t* WguT = (bf16_t*)(ws + OFF_WGUT + shadow); bf16_t* WdT = (bf16_t*)(ws + OFF_WDT + shadow);
#endif
            float* ldsw = (float*)smem + (size_t)wid * (64 * 65);
            const int T_WIN = 16 * 48, T_GLU = 8 * 8, T_SSO = 8 * 16, T_WO = 16 * 16, T_EG = 64 * 16 * 8, T_ED = 64 * 8 * 16;
            const int total = T_WIN + T_GLU + T_SSO + T_WO + 2 * T_EG + T_ED;
            auto decode = [&](int j) {
                int q = j;
                if (q < T_WIN) return TJob{p.w_in, WinT, 1024, 3072, 1, 0, q}; q -= T_WIN;
                if (q < T_GLU) return TJob{p.w_glu, WglT, 512, 512, 1, 0, q}; q -= T_GLU;
                if (q < T_SSO) return TJob{p.w_sso, WsoT, 512, 1024, 1, 0, q}; q -= T_SSO;
                if (q < T_WO) return TJob{p.w_out, WoT, 1024, 1024, 1, 0, q}; q -= T_WO;
                if (q < T_EG) { const int e = q / 128; return TJob{p.e_gate + (size_t)e * 1024 * 512, WguT + (size_t)e * 1024 * 1024, 1024, 512, 2, 0, q % 128}; } q -= T_EG;
                if (q < T_EG) { const int e = q / 128; return TJob{p.e_up + (size_t)e * 1024 * 512, WguT + (size_t)e * 1024 * 1024, 1024, 512, 2, 1, q % 128}; } q -= T_EG;
                { const int e = q / 128; return TJob{p.e_down + (size_t)e * 512 * 1024, WdT + (size_t)e * 1024 * 512, 512, 1024, 1, 0, q % 128}; }
            };
            if (gw < total) {
                TJob cur = decode(gw); f32x4 v[16]; tjob_load(cur, lane, v);
                for (int j = gw; j < total; j += nw) {
                    TJob nx = cur; f32x4 vn[16];
                    const bool more = j + nw < total;
                    if (more) { nx = decode(j + nw); tjob_load(nx, lane, vn); }
                    tjob_process(cur, lane, v, ldsw);
                    if (more) {
                        cur = nx;
#pragma unroll
                        for (int i = 0; i < 16; ++i) v[i] = vn[i];
                    }
                }
            }
        }
        __syncthreads();
        STAMP(1);
        if (!(blockIdx.x & 1)) rest();
    }
    STAMP(5);
    GRID_SYNC();
    STAMP(6);
    }
    for (int _rep = 0; _rep < REP1; ++_rep) {
    {
        PHASE_IDS
        auto E = [=](const g8::Unit& u, int rl, int cl, f32x4 v0, f32x4 v1) {
            const int m = u.r0 + rl, n8 = u.c0 + cl;
            const int b = m >> 12, l2 = (m >> 6) & 63, l1 = m & 63, tok = (b << 12) + (l1 << 6) + l2;
            if (n8 < FW) {
                const int g = n8 >> 7, c = n8 & 127;
                const bool odd = (l1 & 1) != 0;
                f32x4 recv;
#pragma unroll
                for (int j = 0; j < 4; ++j) recv[j] = __shfl_xor(odd ? v0[j] : v1[j], 1);
                bf16_t* dst = XA + ((((size_t)(b * 4 + g) * 128 + c + (odd ? 4 : 0)) * 64 + l2) << 6) + (l1 & ~1);
#pragma unroll
                for (int j = 0; j < 4; ++j) *(unsigned*)(dst + ((size_t)j << 12)) = odd ? pack2(recv[j], v1[j]) : pack2(v0[j], recv[j]);
            } else if (n8 < FW + SW) {
                const int ch = n8 - FW, g = ch >> 4, ci = ch & 15;
                u32x4 w; w[0] = pack2(v0[0], v0[1]); w[1] = pack2(v0[2], v0[3]); w[2] = pack2(v1[0], v1[1]); w[3] = pack2(v1[2], v1[3]);
                *(u32x4*)(Ucomb + ((size_t)(g * ROWS + (tok >> 5))) * UK + (tok & 31) * 16 + ci) = w;
            } else {
                u32x4 w; w[0] = pack2(sigmoidf_(v0[0]), sigmoidf_(v0[1])); w[1] = pack2(sigmoidf_(v0[2]), sigmoidf_(v0[3])); w[2] = pack2(sigmoidf_(v1[0]), sigmoidf_(v1[1])); w[3] = pack2(sigmoidf_(v1[2]), sigmoidf_(v1[3]));
                *(u32x4*)(gates + (size_t)tok * 2048 + (n8 - 1024)) = w;
            }
        };
        dense_gemm<true>(ldsp, hn, WinT, T, INW, D, D, D, 1, 0, 0, epi_noload8(E));
    }
    GRID_SYNC();
    STAMP(7);
    }
    for (int _rep = 0; _rep < REP2; ++_rep) {
    {
        PHASE_IDS
        {
            auto L = [=](const g8::Unit& u, int rl, int cl) {
                const int r = u.r0 + rl, n4 = u.c0 + cl;
                const int l2 = 2 * (r & 31) + (n4 >> 7), k1 = (n4 & 127) >> 1;
                return AuxT{TW[k1 * 64 + l2], TW[(k1 + 1) * 64 + l2]};
            };
            auto S = [=](const g8::Unit& u, int rl, int cl, f32x4 v, const AuxT& a) {
                const int r = u.r0 + rl, n4 = u.c0 + cl;
                const int l2 = 2 * (r & 31) + (n4 >> 7), c = (r >> 5) & 127, bg = r >> 12, k1 = (n4 & 127) >> 1;
                bf16_t* dst = T2 + ((((size_t)(bg * 64 + k1) * 128 + c) * 64 + l2) << 1);
                *(unsigned*)dst = pack2(v[0] * a.t0[0] - v[1] * a.t0[1], v[0] * a.t0[1] + v[1] * a.t0[0]);
                *(unsigned*)(dst + 128 * 64 * 2) = pack2(v[2] * a.t1[0] - v[3] * a.t1[1], v[2] * a.t1[1] + v[3] * a.t1[0]);
            };
            dense_gemm(ldsp, XA, BtA, 65536, 256, 128, 128, 128, 1, 0, 0, epi_ls(L, S));
        }
        {
            auto E = [=](const g8::Unit& u, int rl, int cl, f32x4 v) { if (rl < u.nrows) *(f32x4*)(Sst + (size_t)(u.aux * ROWS + u.r0 + rl) * 256 + u.c0 + cl) = v; };
            half_gemm(ldsp, Ucomb, BtS, ROWS, 256, 512, UK, 512, SG, (size_t)ROWS * UK, (size_t)256 * 512, epi_noload(E));
        }
    }
    GRID_SYNC();
    STAMP(8);
    }
    for (int _rep = 0; _rep < REP3; ++_rep) {
    {
        PHASE_IDS
        {
            auto E = [=](const g8::Unit& u, int rl, int cl, f32x4 v) {
                const int r = u.r0 + rl, n4 = u.c0 + cl;
                const int c = 2 * (r & 63) + (n4 >> 7), k1 = (r >> 6) & 63, bg = r >> 12, k2 = (n4 & 127) >> 1;
                bf16_t* dst = Fb + ((size_t)((bg >> 2) * SEQ + k1 + 64 * k2)) * 1024 + ((bg & 3) * 128 + c) * 2;
                *(unsigned*)dst = pack2(v[0], v[1]);
                *(unsigned*)(dst + 64 * 1024) = pack2(v[2], v[3]);
            };
            dense_gemm(ldsp, T2, BtC, 65536, 256, 256, 256, 256, 1, 0, 0, epi_noload(E));
        }
        for (int i = gt; i < BATCH * SG * 2 * SN; i += nt) {
            const int n = i & 63, dir = (i >> 6) & 1, g = (i >> 7) & 31, b = i >> 12;
            const f32x2 a = aL[(dir * SG + g) * SN + n];
            float hr = 0.f, hi = 0.f;
            for (int j0 = 0; j0 < NCH; j0 += 16) {
                f32x2 s[16];
#pragma unroll
                for (int q = 0; q < 16; ++q) {
                    const int jj = j0 + q, j = dir == 0 ? jj : (NCH - 1 - jj);
                    s[q] = *(const f32x2*)(Sst + ((size_t)g * ROWS + b * NCH + j) * 256 + (dir * 64 + n) * 2);
                }
#pragma unroll
                for (int q = 0; q < 16; ++q) {
                    const int jj = j0 + q, j = dir == 0 ? jj : (NCH - 1 - jj);
                    const size_t row = (size_t)g * ROWS + b * NCH + j;
                    *(unsigned*)(Ucomb + row * UK + 512 + (dir * 64 + n) * 2) = pack2(hr, hi);
                    const float nr = a[0] * hr - a[1] * hi + s[q][0], ni = a[0] * hi + a[1] * hr + s[q][1];
                    hr = nr; hi = ni;
                }
            }
        }
    }
    GRID_SYNC();
    STAMP(9);
    }
    for (int _rep = 0; _rep < REP4; ++_rep) {
    {
        PHASE_IDS
        {
            auto L = [=](const g8::Unit& u, int rl, int cl) {
                const int g = u.aux, m = u.r0 + rl, n8 = u.c0 + cl;
                const float* dp = p.ssm_D + g * 16 + (n8 & 15);
                return AuxY8{*(const u32x4*)(Ucomb + (size_t)(g * ROWS + m) * UK + n8), *(const f32x4*)dp, *(const f32x4*)(dp + 4)};
            };
            auto S = [=](const g8::Unit& u, int rl, int cl, f32x4 v0, f32x4 v1, const AuxY8& a) {
                const int g = u.aux, m = u.r0 + rl, n8 = u.c0 + cl;
                const int tt = n8 >> 4, co = n8 & 15, tok = m * LC + tt, ch = g * 16 + co;
                if (rl >= u.nrows) return;
                u32x4 w;
                w[0] = pack2(gelu_tanh(v0[0] + a.d0[0] * bflo(a.uu[0])), gelu_tanh(v0[1] + a.d0[1] * bfhi(a.uu[0])));
                w[1] = pack2(gelu_tanh(v0[2] + a.d0[2] * bflo(a.uu[1])), gelu_tanh(v0[3] + a.d0[3] * bfhi(a.uu[1])));
                w[2] = pack2(gelu_tanh(v1[0] + a.d1[0] * bflo(a.uu[2])), gelu_tanh(v1[1] + a.d1[1] * bfhi(a.uu[2])));
                w[3] = pack2(gelu_tanh(v1[2] + a.d1[2] * bflo(a.uu[3])), gelu_tanh(v1[3] + a.d1[3] * bfhi(a.uu[3])));
                *(u32x4*)(yg + (size_t)tok * SW + ch) = w;
            };
            half_gemm<true>(ldsp, Ucomb, BtY, ROWS, 512, UK, UK, UK, SG, (size_t)ROWS * UK, (size_t)512 * UK, epi_ls8(L, S));
        }
        {
            auto L = [=](const g8::Unit& u, int rl, int cl) { return *(const u32x4*)(gates + (size_t)(u.r0 + rl) * 2048 + u.c0 + cl); };
            auto S = [=](const g8::Unit& u, int rl, int cl, f32x4 v0, f32x4 v1, const u32x4& gg) {
                u32x4 w; w[0] = pack2(bflo(gg[0]) * v0[0], bfhi(gg[0]) * v0[1]); w[1] = pack2(bflo(gg[1]) * v0[2], bfhi(gg[1]) * v0[3]);
                w[2] = pack2(bflo(gg[2]) * v1[0], bfhi(gg[2]) * v1[1]); w[3] = pack2(bflo(gg[3]) * v1[2], bfhi(gg[3]) * v1[3]);
                *(u32x4*)(m1 + (size_t)(u.r0 + rl) * D + u.c0 + cl) = w;
            };
            dense_gemm<true>(ldsp, Fb, WpT, T, D, 1024, 1024, 1024, 1, 0, 0, epi_ls8(L, S));
        }
    }
    GRID_SYNC();
    STAMP(10);
    }
    for (int _rep = 0; _rep < REP5; ++_rep) {
    {
        PHASE_IDS
        auto L = [=](const g8::Unit& u, int rl, int cl) { return *(const u32x4*)(yg + (size_t)(u.r0 + rl) * SW + u.c0 + cl); };
        auto S = [=](const g8::Unit& u, int rl, int cl, f32x4 v0, f32x4 v1, const u32x4& yy) {
            if (rl >= u.nrows) return;
            u32x4 w; w[0] = pack2(bflo(yy[0]) * sigmoidf_(v0[0]), bfhi(yy[0]) * sigmoidf_(v0[1])); w[1] = pack2(bflo(yy[1]) * sigmoidf_(v0[2]), bfhi(yy[1]) * sigmoidf_(v0[3]));
            w[2] = pack2(bflo(yy[2]) * sigmoidf_(v1[0]), bfhi(yy[2]) * sigmoidf_(v1[1])); w[3] = pack2(bflo(yy[3]) * sigmoidf_(v1[2]), bfhi(yy[3]) * sigmoidf_(v1[3]));
            *(u32x4*)(ys2 + (size_t)(u.r0 + rl) * SW + u.c0 + cl) = w;
        };
        half_gemm<true>(ldsp, yg, WglT, T, SW, SW, SW, SW, 1, 0, 0, epi_ls8(L, S));
    }
    GRID_SYNC();
    STAMP(11);
    }
    {
        PHASE_IDS
        auto L = [=](const g8::Unit& u, int rl, int cl) {
            return Aux44{*(const u32x4*)(gates + (size_t)(u.r0 + rl) * 2048 + 1024 + u.c0 + cl), *(const u32x4*)(m1 + (size_t)(u.r0 + rl) * D + u.c0 + cl)};
        };
        auto S = [=](const g8::Unit& u, int rl, int cl, f32x4 v0, f32x4 v1, const Aux44& a) {
            u32x4 w;
            w[0] = pack2(bflo(a.b[0]) + bflo(a.a[0]) * v0[0], bfhi(a.b[0]) + bfhi(a.a[0]) * v0[1]); w[1] = pack2(bflo(a.b[1]) + bflo(a.a[1]) * v0[2], bfhi(a.b[1]) + bfhi(a.a[1]) * v0[3]);
            w[2] = pack2(bflo(a.b[2]) + bflo(a.a[2]) * v1[0], bfhi(a.b[2]) + bfhi(a.a[2]) * v1[1]); w[3] = pack2(bflo(a.b[3]) + bflo(a.a[3]) * v1[2], bfhi(a.b[3]) + bfhi(a.a[3]) * v1[3]);
            *(u32x4*)(m1 + (size_t)(u.r0 + rl) * D + u.c0 + cl) = w;
        };
        dense_gemm<true>(ldsp, ys2, WsoT, T, D, SW, SW, SW, 1, 0, 0, epi_ls8(L, S));
    }
    GRID_SYNC();
    STAMP(12);
    for (int _rep = 0; _rep < REP7; ++_rep) {
    {
        PHASE_IDS
        auto L = [=](const g8::Unit& u, int rl, int cl) { return *(const f32x4*)(p.x + (size_t)(u.r0 + rl) * D + u.c0 + cl); };
        auto S = [=](const g8::Unit& u, int rl, int cl, f32x4 v, const f32x4& xx) { *(f32x4*)(x2 + (size_t)(u.r0 + rl) * D + u.c0 + cl) = xx + v; };
        dense_gemm(ldsp, m1, WoT, T, D, D, D, D, 1, 0, 0, epi_ls(L, S));
    }
    GRID_SYNC();
    STAMP(13);
    }
    for (int _rep = 0; _rep < REP8; ++_rep) {
    if (_rep > 0) { if (blockIdx.x == 0 && threadIdx.x < 64) cnt[threadIdx.x] = 0u; GRID_SYNC(); }
    {
        PHASE_IDS
        LAS unsigned char* hrow = ldsp;
        LAS float* lg = (LAS float*)(ldsp + 132096);
        const int fr = lane & 15, fq = lane >> 4;
        for (int tb = blockIdx.x; tb < T / 64; tb += gridDim.x) {
            const int tok0 = tb * 64;
#pragma unroll
            for (int h = 0; h < 2; ++h) {
                f32x4 xv[4][4];
#pragma unroll
                for (int q = 0; q < 4; ++q) load_row(x2 + (size_t)(tok0 + wid * 8 + h * 4 + q) * D, lane, xv[q]);
#pragma unroll
                for (int q = 0; q < 4; ++q) {
                    const int rl = wid * 8 + h * 4 + q, r = tok0 + rl;
                    const float inv = row_inv_rms(xv[q]);
#pragma unroll
                    for (int i = 0; i < 4; ++i) {
                        const f32x4 gg = *(const f32x4*)(p.ffn_g + 4 * lane + 256 * i);
                        u32x2 w; w[0] = pack2(xv[q][i][0] * inv * gg[0], xv[q][i][1] * inv * gg[1]); w[1] = pack2(xv[q][i][2] * inv * gg[2], xv[q][i][3] * inv * gg[3]);
                        *(u32x2*)(hn2 + (size_t)r * D + 4 * lane + 256 * i) = w;
                        *(LAS u32x2*)(hrow + rl * 2064 + (4 * lane + 256 * i) * 2) = w;
                    }
                }
            }
            __syncthreads();
            STAMP(19);
            if (wid < 5) {
                const LAS unsigned char* ap = hrow + fr * 2064 + fq * 16;
                const bf16_t* bp = WrT + (size_t)(wid * 16 + fr) * 2048 + fq * 8;
                asm volatile("" : "+v"(bp));
                f32x4 acc[4];
#pragma unroll
                for (int m = 0; m < 4; ++m) acc[m] = (f32x4){0.f, 0.f, 0.f, 0.f};
                bf16x8 b0[16], b1[16];
#pragma unroll
                for (int s = 0; s < 16; ++s) b0[s] = *(const bf16x8*)(bp + s * 32);
#pragma nounroll
                for (int kb = 0; kb < 4; kb += 2) {
#pragma unroll
                    for (int s = 0; s < 16; ++s) b1[s] = *(const bf16x8*)(bp + ((kb + 1) * 16 + s) * 32);
#pragma unroll
                    for (int s = 0; s < 16; ++s) {
                        const int ks = kb * 16 + s;
#pragma unroll
                        for (int m = 0; m < 4; ++m) acc[m] = __builtin_amdgcn_mfma_f32_16x16x32_bf16(b0[s], *(const LAS bf16x8*)(ap + m * 16 * 2064 + (ks & 31) * 64), acc[m], 0, 0, 0);
                        if ((s & 3) == 3) __builtin_amdgcn_sched_barrier(0);
                    }
                    if (kb + 2 < 4) {
#pragma unroll
                        for (int s = 0; s < 16; ++s) b0[s] = *(const bf16x8*)(bp + ((kb + 2) * 16 + s) * 32);
                    }
#pragma unroll
                    for (int s = 0; s < 16; ++s) {
                        const int ks = (kb + 1) * 16 + s;
#pragma unroll
                        for (int m = 0; m < 4; ++m) acc[m] = __builtin_amdgcn_mfma_f32_16x16x32_bf16(b1[s], *(const LAS bf16x8*)(ap + m * 16 * 2064 + (ks & 31) * 64), acc[m], 0, 0, 0);
                        if ((s & 3) == 3) __builtin_amdgcn_sched_barrier(0);
                    }
                }
#pragma unroll
                for (int m = 0; m < 4; ++m) *(LAS f32x4*)(lg + (m * 16 + fr) * 80 + wid * 16 + 4 * fq) = acc[m];
            }
            __syncthreads();
            STAMP(20);
            if (tid < 64) {
                const LAS float* L = lg + tid * 80;
                float gv[8];
#pragma unroll
                for (int i = 0; i < 8; ++i) gv[i] = L[64 + i] + p.rg_b[i];
                int gi = 0; float gm = gv[0];
#pragma unroll
                for (int i = 1; i < 8; ++i) if (gv[i] > gm) { gm = gv[i]; gi = i; }
                float den = 0.f;
#pragma unroll
                for (int i = 0; i < 8; ++i) den += __expf(gv[i] - gm);
                const float pg = 1.0f / den;
                float ev[8];
#pragma unroll
                for (int i = 0; i < 8; ++i) { const int c = gi * 8 + i; ev[i] = L[c] + p.re_b[c]; }
                int i1 = 0; float v1 = ev[0];
#pragma unroll
                for (int i = 1; i < 8; ++i) if (ev[i] > v1) { v1 = ev[i]; i1 = i; }
                int i2 = -1; float v2 = -3.0e38f;
#pragma unroll
                for (int i = 0; i < 8; ++i) if (i != i1 && ev[i] > v2) { v2 = ev[i]; i2 = i; }
                const float e2 = __expf(v2 - v1), w1 = pg / (1.0f + e2), w2 = pg * e2 / (1.0f + e2);
                const int tok = tok0 + tid, ex1 = gi * 8 + i1, ex2 = gi * 8 + i2;
                int r1 = 0, c1 = 0, r2 = 0, h = 0;
                for (int j = 0; j < 64; ++j) {
                    const int e1j = __shfl(ex1, j), e2j = __shfl(ex2, j);
                    r1 += (j < tid && e1j == ex1) ? 1 : 0;
                    c1 += (e1j == ex2) ? 1 : 0;
                    r2 += (j < tid && e2j == ex2) ? 1 : 0;
                    h += ((e1j == tid) ? 1 : 0) + ((e2j == tid) ? 1 : 0);
                }
                *(int4*)(tokinfo + 4 * tok) = make_int4(ex1, r1, ex2, c1 + r2);
                tokw[tok] = (f32x2){w1, w2};
                hist[tb * 64 + tid] = h;
            }
            __syncthreads();
            STAMP(21);
        }
    }
    GRID_SYNC();
    }
    STAMP(14);
    LAS int* tab = (LAS int*)(ldsp + TAB_LDS_OFF);
    for (int _rep = 0; _rep < REP9; ++_rep) {
    {
        PHASE_IDS
        LAS int* baseL = tab + 280;
        LAS int* part = tab + 352;
        const int tb0 = blockIdx.x < T / 64 ? blockIdx.x : 0;
        for (int tb = tb0; tb < T / 64; tb += gridDim.x) {
            __syncthreads();
            {
                const int e = tid & 63, sl = tid >> 6;
                int tot = 0, base = 0;
#pragma unroll 8
                for (int b = sl * 32; b < sl * 32 + 32; ++b) { const int hh = hist[b * 64 + e]; tot += hh; base += (b < tb) ? hh : 0; }
                part[(sl * 64 + e) * 2] = tot; part[(sl * 64 + e) * 2 + 1] = base;
            }
            __syncthreads();
            if (tid < 64) {
                int tot = 0, base = 0;
#pragma unroll
                for (int sl = 0; sl < 8; ++sl) { tot += part[(sl * 64 + tid) * 2]; base += part[(sl * 64 + tid) * 2 + 1]; }
                tab[tid] = tot; baseL[tid] = base;
            }
            __syncthreads();
            if (tid == 0) {
                int ro = 0, tp = 0, tr = 0;
                for (int e = 0; e < NE; ++e) { const int c = tab[e]; tab[64 + e] = ro; tab[128 + e] = tp; tab[200 + e] = tr; ro += c; tp += c >> 8; tr += (c & 255) ? 1 : 0; }
                tab[128 + NE] = tp; tab[200 + NE] = tr;
            }
            __syncthreads();
            if (blockIdx.x >= T / 64) break;
            if (tid < 64) {
                const int tok = tb * 64 + tid;
                const int4 info = *(const int4*)(tokinfo + 4 * tok); const f32x2 w = tokw[tok];
                const int s1 = tab[64 + info.x] + baseL[info.x] + info.y, s2 = tab[64 + info.z] + baseL[info.z] + info.w;
                slot_asg[s1] = tok * 2; slot_asg[s2] = tok * 2 + 1; slot_w[s1] = w[0]; slot_w[s2] = w[1]; slot_tok[s1] = tok; slot_tok[s2] = tok;
            }
        }
    }
    GRID_SYNC();
    STAMP(15);
    }
    for (int _rep = 0; _rep < REP10; ++_rep) {
    {
        PHASE_IDS
        auto E = [=](const g8::Unit& u, int rl, int cl, f32x4 v0, f32x4 v1) {
            if (rl < u.nrows) {
                u32x2 w; w[0] = pack2(v0[0] * sigmoidf_(v0[0]) * v0[1], v0[2] * sigmoidf_(v0[2]) * v0[3]); w[1] = pack2(v1[0] * sigmoidf_(v1[0]) * v1[1], v1[2] * sigmoidf_(v1[2]) * v1[3]);
                *(u32x2*)(act + (size_t)(u.r0 + rl) * DE + ((u.c0 + cl) >> 1)) = w;
            }
        };
        g8::RaggedSched S; S.A = (const char*)hn2; S.B = (const char*)WguT; S.tab = tab; S.gsB = (size_t)1024 * 1024 * 2; S.lda = D; S.ldb = D; S.nN = 4; S.G = gridDim.x; S.c = blockIdx.x; S.ridx = slot_tok;
        g8::gemm_phase<true, true, true>(ldsp, D, D, D, S, epi_noload8(E));
    }
    GRID_SYNC();
    STAMP(16);
    }
    for (int _rep = 0; _rep < REP11; ++_rep) {
    {
        PHASE_IDS
        auto L = [=](const g8::Unit& u, int rl, int cl) { return AuxS{slot_asg[u.r0 + rl], slot_w[u.r0 + rl]}; };
        auto St = [=](const g8::Unit& u, int rl, int cl, f32x4 v0, f32x4 v1, const AuxS& a) {
            if (rl < u.nrows) {
                const float w = a.w;
                u32x4 o; o[0] = pack2(w * v0[0], w * v0[1]); o[1] = pack2(w * v0[2], w * v0[3]); o[2] = pack2(w * v1[0], w * v1[1]); o[3] = pack2(w * v1[2], w * v1[3]);
                *(u32x4*)(ybuf + (size_t)a.as * D + u.c0 + cl) = o;
            }
        };
        g8::RaggedSched S; S.A = (const char*)act; S.B = (const char*)WdT; S.tab = tab; S.gsB = (size_t)1024 * 512 * 2; S.lda = DE; S.ldb = DE; S.nN = 4; S.G = gridDim.x; S.c = blockIdx.x; S.ridx = nullptr;
        g8::gemm_phase<true, false, true>(ldsp, DE, DE, DE, S, epi_ls8(L, St));
    }
    GRID_SYNC();
    STAMP(17);
    }
    {
        PHASE_IDS
#if defined(TP_A)
        float tp_keep = 0.f;
#endif
        for (int _r12 = 0; _r12 < REP12; ++_r12)
        for (int r = gw; r < T; r += nw) {
            float* outp = (_r12 + 1 < REP12) ? (float*)(ws + OFF_E) : p.out;
            f32x4 v[4]; load_row(x2 + (size_t)r * D, lane, v);
#pragma unroll
            for (int i = 0; i < 4; ++i) {
                const u32x2 y0 = *(const u32x2*)(ybuf + (size_t)(2 * r) * D + 4 * lane + 256 * i);
                const u32x2 y1 = *(const u32x2*)(ybuf + (size_t)(2 * r + 1) * D + 4 * lane + 256 * i);
                v[i][0] += __uint_as_float(y0[0] << 16) + __uint_as_float(y1[0] << 16);
                v[i][1] += __uint_as_float(y0[0] & 0xffff0000u) + __uint_as_float(y1[0] & 0xffff0000u);
                v[i][2] += __uint_as_float(y0[1] << 16) + __uint_as_float(y1[1] << 16);
                v[i][3] += __uint_as_float(y0[1] & 0xffff0000u) + __uint_as_float(y1[1] & 0xffff0000u);
            }
            const float inv = row_inv_rms(v);
#pragma unroll
            for (int i = 0; i < 4; ++i) {
                const f32x4 gg = *(const f32x4*)(p.fin_g + 4 * lane + 256 * i);
                f32x4 o = (f32x4){v[i][0] * inv * gg[0], v[i][1] * inv * gg[1], v[i][2] * inv * gg[2], v[i][3] * inv * gg[3]};
#if defined(TP_A)
                if (r == 0 && lane == 0 && i == 0) {
                    tp_keep = o[0];
#if TP_B != 18
                    o[0] += (float)(long long)(__hip_atomic_load(tsp + TP_B, __ATOMIC_RELAXED, __HIP_MEMORY_SCOPE_AGENT) - __hip_atomic_load(tsp + TP_A, __ATOMIC_RELAXED, __HIP_MEMORY_SCOPE_AGENT)) * (0.01f * (TP_GAIN));
#endif
                }
#endif
                *(f32x4*)(outp + (size_t)r * D + 4 * lane + 256 * i) = o;
            }
        }
#if defined(TP_A) && TP_B == 18
        {
            unsigned* donec = (unsigned*)(ws + OFF_J + J_TS + 512);
            donec = (unsigned*)(ws + OFF_J + J_CNT) + 100;
            asm volatile("s_waitcnt vmcnt(0)" ::: "memory");
            __syncthreads();
            if (threadIdx.x == 0) {
                if (blockIdx.x != 0) __hip_atomic_fetch_add(donec, 1u, __ATOMIC_RELAXED, __HIP_MEMORY_SCOPE_AGENT);
                else {
                    unsigned sp = 0;
                    while (__hip_atomic_load(donec, __ATOMIC_RELAXED, __HIP_MEMORY_SCOPE_AGENT) < gridDim.x - 1 && ++sp < (1u << 22)) __builtin_amdgcn_s_sleep(2);
                    const unsigned long long t1 = __builtin_amdgcn_s_memrealtime();
                    p.out[0] = tp_keep + (float)(long long)(t1 - __hip_atomic_load(tsp + TP_A, __ATOMIC_RELAXED, __HIP_MEMORY_SCOPE_AGENT)) * (0.01f * (TP_GAIN));
                }
            }
        }
#endif
    }
}

extern "C" void kernel_launch(void* const* d_in, const int* in_sizes, int n_in, void* d_out, int out_size, void* d_ws, size_t ws_size, hipStream_t stream) {
    (void)in_sizes; (void)n_in; (void)out_size;
    static int grid_blocks = 0;
    if (!grid_blocks) {
        int dev = 0, cus = 0, per_cu = 0;
        (void)hipGetDevice(&dev);
        (void)hipDeviceGetAttribute(&cus, hipDeviceAttributeMultiprocessorCount, dev);
        (void)hipOccupancyMaxActiveBlocksPerMultiprocessor(&per_cu, fwd_megakernel, NTHREADS, 0);
        if (per_cu > 1) per_cu = 1;
        if (per_cu < 1) per_cu = 1;
        grid_blocks = cus * per_cu;
    }
    if (ws_size < WS_NEED) { fprintf(stderr, "workspace too small: %zu < %zu\n", ws_size, (size_t)WS_NEED); return; }
    Params p{};
    p.x = (const float*)d_in[0]; p.mix_g = (const float*)d_in[1]; p.w_in = (const float*)d_in[2]; p.w_fo = (const float*)d_in[3];
    p.A_re = (const float*)d_in[4]; p.A_im = (const float*)d_in[5]; p.log_dt = (const float*)d_in[6];
    p.B_re = (const float*)d_in[7]; p.B_im = (const float*)d_in[8]; p.C_re = (const float*)d_in[9]; p.C_im = (const float*)d_in[10];
    p.ssm_D = (const float*)d_in[11]; p.w_glu = (const float*)d_in[12]; p.w_sso = (const float*)d_in[13]; p.w_out = (const float*)d_in[14];
    p.ffn_g = (const float*)d_in[15]; p.rg_w = (const float*)d_in[16]; p.rg_b = (const float*)d_in[17]; p.re_w = (const float*)d_in[18]; p.re_b = (const float*)d_in[19];
    p.e_gate = (const float*)d_in[20]; p.e_up = (const float*)d_in[21]; p.e_down = (const float*)d_in[22]; p.fin_g = (const float*)d_in[23];
    p.out = (float*)d_out; p.ws = (unsigned char*)d_ws;
    (void)hipMemsetAsync((unsigned char*)d_ws + OFF_J, 0, J_ZERO_BYTES, stream);
    void* args[] = {&p};
    hipError_t e = hipLaunchCooperativeKernel((const void*)fwd_megakernel, dim3(grid_blocks), dim3(NTHREADS), args, 0, stream);
    if (e != hipSuccess) fprintf(stderr, "cooperative launch failed: %s (grid %d)\n", hipGetErrorString(e), grid_blocks);
}
```

```cpp
#include <hip/hip_runtime.h>
#include <cstdio>
#include <type_traits>

typedef unsigned short bf16_t;
typedef short bf16x8 __attribute__((ext_vector_type(8)));
typedef float f32x4 __attribute__((ext_vector_type(4)));
typedef float f32x2 __attribute__((ext_vector_type(2)));
typedef unsigned u32x2 __attribute__((ext_vector_type(2)));
typedef unsigned u32x4 __attribute__((ext_vector_type(4)));

#ifndef REP0
#define REP0 1
#endif
#ifndef REP1
#define REP1 1
#endif
#ifndef REP2
#define REP2 1
#endif
#ifndef REP3
#define REP3 1
#endif
#ifndef REP4
#define REP4 1
#endif
#ifndef REP5
#define REP5 1
#endif
#ifndef REP7
#define REP7 1
#endif
#ifndef REP9
#define REP9 1
#endif
#ifndef REP10
#define REP10 1
#endif
#ifndef REP11
#define REP11 1
#endif
#ifndef REP12
#define REP12 1
#endif
#ifndef REP8
#define REP8 1
#endif
#ifndef REP0C
#define REP0C 1
#endif
#ifndef REP0A
#define REP0A 1
#endif
#ifndef REP0B
#define REP0B 1
#endif
#ifndef REP0D
#define REP0D 1
#endif
#ifndef REP0E
#define REP0E 1
#endif
constexpr int D = 1024, BATCH = 4, SEQ = 4096, T = BATCH * SEQ;
constexpr int FW = 512, SW = 512, INW = 3072;
constexpr int SG = 32, SC = 16, SN = 64;
constexpr int LC = 32, NCH = SEQ / LC, ROWS = T / LC;
constexpr int UK = 768;
constexpr int NE = 64, DE = 512, LISTCAP = 16384;
constexpr int NTHREADS = 512, NWAVES = 8;
constexpr int SMEM_BYTES = 156 * 1024 + 16;

constexpr size_t MiB = 1024 * 1024;
constexpr size_t OFF_WGUT = 0;
constexpr size_t OFF_WDT  = OFF_WGUT + 128 * MiB;
constexpr size_t OFF_WINT = OFF_WDT + 64 * MiB;
constexpr size_t OFF_WPT  = OFF_WINT + 6 * MiB;
constexpr size_t OFF_WGLT = OFF_WPT + 2 * MiB;
constexpr size_t OFF_WSOT = OFF_WGLT + MiB / 2;
constexpr size_t OFF_WOT  = OFF_WSOT + 1 * MiB;
constexpr size_t OFF_BTS  = OFF_WOT + 2 * MiB;
constexpr size_t OFF_BTY  = OFF_BTS + 8 * MiB;
constexpr size_t OFF_C    = OFF_BTY + 24 * MiB;
constexpr size_t OFF_D    = OFF_C + 64 * MiB;
constexpr size_t OFF_E    = OFF_D + 32 * MiB;
constexpr size_t OFF_FG   = OFF_E + 64 * MiB;
constexpr size_t OFF_H    = OFF_FG + 32 * MiB;
constexpr size_t OFF_I    = OFF_H + 24 * MiB;
constexpr size_t OFF_J    = OFF_I + 32 * MiB;
constexpr size_t J_CNT   = 0;
constexpr size_t J_BAR   = 4096;
constexpr size_t J_ZERO_BYTES = 48128;
constexpr size_t J_TS    = 1945600;
constexpr size_t J_AL    = 1900544;
constexpr size_t J_TOKW    = 65536;
constexpr size_t J_TOKINFO = 196608;
constexpr size_t J_SLOTASG = 458752;
constexpr size_t J_SLOTW   = 655360;
constexpr size_t J_SLOTTOK = 1703936;
constexpr size_t J_HIST    = 851968;
constexpr size_t J_WRT     = 1048576;
constexpr size_t J_BTA     = 1441792;
constexpr size_t J_BTC     = 1507328;
constexpr size_t J_TW      = 1638400;
constexpr size_t WS_NEED = OFF_J + 2 * MiB;
constexpr int TAB_LDS_OFF = 131072;
constexpr int BAR_LDS_OFF = SMEM_BYTES - 16;
constexpr int PBAR_LDS_OFF = SMEM_BYTES - 32;
constexpr size_t J_PBAR = 20480;

struct Params {
    const float* x; const float* mix_g; const float* w_in; const float* w_fo;
    const float* A_re; const float* A_im; const float* log_dt; const float* B_re; const float* B_im; const float* C_re; const float* C_im;
    const float* ssm_D; const float* w_glu; const float* w_sso; const float* w_out; const float* ffn_g;
    const float* rg_w; const float* rg_b; const float* re_w; const float* re_b;
    const float* e_gate; const float* e_up; const float* e_down; const float* fin_g;
    float* out; unsigned char* ws;
};

__device__ __forceinline__ bf16_t f2bf(float f) { return __builtin_bit_cast(bf16_t, (__bf16)f); }
__device__ __forceinline__ float bf2f(bf16_t b) { return __uint_as_float(((unsigned)b) << 16); }
typedef __bf16 bf16x2_hw __attribute__((ext_vector_type(2)));
__device__ __forceinline__ unsigned pack2(float lo, float hi) { const f32x2 v = {lo, hi}; return __builtin_bit_cast(unsigned, __builtin_convertvector(v, bf16x2_hw)); }
typedef long l64x2 __attribute__((ext_vector_type(2)));
typedef int i32x4_ __attribute__((ext_vector_type(4)));
typedef int i32x8_ __attribute__((ext_vector_type(8)));
constexpr float WSCALE8 = 32.0f, ASCALE8 = 4.0f;
__device__ __forceinline__ unsigned pack4_fp8(float a, float b, float c, float d) { int r = 0; r = __builtin_amdgcn_cvt_pk_fp8_f32(a, b, r, false); r = __builtin_amdgcn_cvt_pk_fp8_f32(c, d, r, true); return (unsigned)r; }
__device__ __forceinline__ float sigmoidf_(float v) { return __builtin_amdgcn_rcpf(1.0f + __expf(-v)); }
__device__ __forceinline__ float gelu_tanh(float v) { const float u = 1.5957691216057308f * (v + 0.044715f * v * v * v); return v * __builtin_amdgcn_rcpf(1.0f + __expf(-u)); }
__device__ __forceinline__ float wave_sum(float v) {
#pragma unroll
    for (int o = 32; o > 0; o >>= 1) v += __shfl_xor(v, o);
    return v;
}


#define LAS __attribute__((address_space(3)))
#define XB_TMO      128
#define XB_XCNT(j)  (256  + 64 * (j))
#define XB_XSUB(j)  (1280 + 64 * (j))
#define XB_XGEN(j)  (2304 + 64 * (j))
#define XB_TOP      3328
#define XB_TOPGEN   3392
#define XCD_BAR_WORDS 3456
#define XB_SPIN_CAP (1u << 18)
__device__ __forceinline__ unsigned xb_ld(unsigned* p)              { return __hip_atomic_load(p, __ATOMIC_RELAXED, __HIP_MEMORY_SCOPE_AGENT); }
__device__ __forceinline__ unsigned xb_add(unsigned* p, unsigned v) { return __hip_atomic_fetch_add(p, v, __ATOMIC_RELAXED, __HIP_MEMORY_SCOPE_AGENT); }
__device__ __forceinline__ unsigned xb_xcc_id() { return (unsigned)__builtin_amdgcn_s_getreg((3 << 11) | 20) & 0xFu; }
#define XB_SPIN(cond, bar) do { unsigned _sp = 0; while (cond) { __builtin_amdgcn_s_sleep(1); \
    if ((++_sp & 255u) == 0u) { if (xb_ld(&(bar)[XB_TMO])) break; if (_sp > XB_SPIN_CAP) { atomicAdd(&(bar)[XB_TMO], 1u); break; } } } } while (0)
struct XcdBarrier { unsigned* bar; unsigned x; volatile LAS unsigned* st; unsigned G; };
__device__ __forceinline__ XcdBarrier xcd_barrier_post(unsigned* bar, volatile LAS unsigned* st, unsigned G = 0u) {
    XcdBarrier b; b.bar = bar; b.x = xb_xcc_id(); b.st = st; b.G = G;
    if (threadIdx.x == 0) (void)xb_add(&bar[XB_XCNT(b.x)], 1u);
    return b;
}
__device__ __forceinline__ void xcd_barrier_complete(unsigned* bar, unsigned x, unsigned& nloc, unsigned& nx, unsigned G_) {
    const unsigned G = G_ ? G_ : gridDim.x * gridDim.y * gridDim.z;
    unsigned sum, cnt, mine, sp = 0u;
    for (;;) {
        sum = 0u; cnt = 0u; mine = 0u;
#pragma unroll
        for (unsigned j = 0; j < 16; ++j) { const unsigned c = xb_ld(&bar[XB_XCNT(j)]); sum += c; cnt += (c > 0u) ? 1u : 0u; mine = (j == x) ? c : mine; }
        if (sum == G) break;
        __builtin_amdgcn_s_sleep(1);
        if ((++sp & 255u) == 0u) { if (xb_ld(&bar[XB_TMO])) break; if (sp > XB_SPIN_CAP) { atomicAdd(&bar[XB_TMO], 1u); break; } }
    }
    nloc = mine > 0u ? mine : 1u; nx = cnt > 0u ? cnt : 1u;
}
__device__ __forceinline__ void xcd_barrier(const XcdBarrier& b) {
    asm volatile("s_waitcnt vmcnt(0)" ::: "memory");
    __syncthreads();
    if (threadIdx.x == 0) {
        unsigned* bar = b.bar;
        __builtin_amdgcn_s_waitcnt(0);
        unsigned nloc = b.st[0], nx = b.st[1];
        if (nloc == 0u) { xcd_barrier_complete(bar, b.x, nloc, nx, b.G); b.st[0] = nloc; b.st[1] = nx; }
        const unsigned old = xb_add(&bar[XB_XSUB(b.x)], 1u);
        const unsigned gen = old / nloc;
        if (old + 1u == (gen + 1u) * nloc) {
            __builtin_amdgcn_fence(__ATOMIC_RELEASE, "agent");
            asm volatile("s_waitcnt vmcnt(0)" ::: "memory");
            const unsigned og = xb_add(&bar[XB_TOP], 1u);
            const unsigned tg = og / nx;
            if (og + 1u == (tg + 1u) * nx) xb_add(&bar[XB_TOPGEN], 1u);
            else XB_SPIN(xb_ld(&bar[XB_TOPGEN]) == tg, bar);
            __builtin_amdgcn_fence(__ATOMIC_ACQUIRE, "agent");
            xb_add(&bar[XB_XGEN(b.x)], 1u);
            asm volatile("s_waitcnt vmcnt(0)" ::: "memory");
        } else {
            XB_SPIN(xb_ld(&bar[XB_XGEN(b.x)]) == gen, bar);
            __builtin_amdgcn_fence(__ATOMIC_ACQUIRE, "agent");
            asm volatile("s_waitcnt vmcnt(0)" ::: "memory");
        }
    }
    __syncthreads();
}
__device__ __forceinline__ void xcd_barrier_arrive(const XcdBarrier& b) {
    asm volatile("s_waitcnt vmcnt(0)" ::: "memory");
    __syncthreads();
    if (threadIdx.x == 0) {
        unsigned* bar = b.bar;
        __builtin_amdgcn_s_waitcnt(0);
        unsigned nloc = b.st[0], nx = b.st[1];
        if (nloc == 0u) { xcd_barrier_complete(bar, b.x, nloc, nx, b.G); b.st[0] = nloc; b.st[1] = nx; }
        const unsigned old = xb_add(&bar[XB_XSUB(b.x)], 1u);
        const unsigned gen = old / nloc;
        if (old + 1u == (gen + 1u) * nloc) {
            __builtin_amdgcn_fence(__ATOMIC_RELEASE, "agent");
            asm volatile("s_waitcnt vmcnt(0)" ::: "memory");
            const unsigned og = xb_add(&bar[XB_TOP], 1u);
            const unsigned tg = og / nx;
            if (og + 1u == (tg + 1u) * nx) xb_add(&bar[XB_TOPGEN], 1u);
            else XB_SPIN(xb_ld(&bar[XB_TOPGEN]) == tg, bar);
            __builtin_amdgcn_fence(__ATOMIC_ACQUIRE, "agent");
            xb_add(&bar[XB_XGEN(b.x)], 1u);
            asm volatile("s_waitcnt vmcnt(0)" ::: "memory");
            b.st[2] = 0u;
        } else {
            b.st[2] = gen + 1u;
        }
    }
    __syncthreads();
}
__device__ __forceinline__ void xcd_barrier_finish(const XcdBarrier& b) {
    if (threadIdx.x == 0) {
        unsigned* bar = b.bar;
        const unsigned pend = b.st[2];
        if (pend) {
            XB_SPIN(xb_ld(&bar[XB_XGEN(b.x)]) == pend - 1u, bar);
            __builtin_amdgcn_fence(__ATOMIC_ACQUIRE, "agent");
            asm volatile("s_waitcnt vmcnt(0)" ::: "memory");
            b.st[2] = 0u;
        }
    }
    __syncthreads();
}

namespace g8 {
constexpr int BM = 256, BK = 64, HALF = 128, HTB = HALF * BK * 2, STAGE_BYTES = 8 * HTB;
__device__ __forceinline__ int lds_byte(int r, int c) { const int st = (r >> 4) * 2 + (c >> 5), rr = r & 15, cc = c & 31, ob = rr * 64 + cc * 2; return st * 1024 + (ob ^ (((ob >> 9) & 1) << 5)); }
__device__ __forceinline__ void stage_rc(int b, int& R, int& C) { const int st = b / 1024, sb = b % 1024, swz = sb ^ (((sb >> 9) & 1) << 5); R = (st >> 1) * 16 + swz / 64; C = (st & 1) * 32 + (swz % 64) / 2; }
struct Unit { const char* A; const char* B; int r0, c0, aux, nrows; const int* ridx; };

struct DenseSched {
    const char* A; const char* B; size_t gsA, gsB; int lda, ldb, nM, nN, nG, G, c; int i0 = 0, nr = 1 << 30;
    __device__ __forceinline__ bool next(int i, Unit& u) const {
        const int nMt = nM * nG, nwg = nMt * nN;
        if (i >= nr) return false;
        const long L = (long)(i + i0) * G + c; if (L >= nwg) return false;
        int wgid = (int)L; { const int q = nwg / 8, r = nwg % 8, xcd = wgid % 8, off = wgid / 8; wgid = (xcd < r ? xcd * (q + 1) : r * (q + 1) + (xcd - r) * q) + off; }
        const int nig = 8 * nN, gid = wgid / nig, fm = gid * 8, gsz = (nMt - fm) < 8 ? (nMt - fm) : 8;
        const int pmt = fm + ((wgid % nig) % gsz), pn = (wgid % nig) / gsz;
        const int g = pmt / nM, pm = pmt % nM;
        u.A = A + (size_t)g * gsA + (size_t)pm * BM * lda * 2; u.B = B + (size_t)g * gsB + (size_t)pn * BM * ldb * 2;
        u.r0 = pm * BM; u.c0 = pn * BM; u.aux = g; u.nrows = BM; u.ridx = nullptr; return true;
    }
};

struct HalfSched {
    const char* A; const char* B; size_t gsA, gsB; int lda, ldb, nM, nN, nG, G, c; int i0 = 0, nr = 1 << 30;
    __device__ __forceinline__ bool next(int i, Unit& u) const {
        const int nH = 2 * nM * nG, nwg = nH * nN;
        if (i >= nr) return false;
        const long L = (long)(i + i0) * G + c; if (L >= nwg) return false;
        int wgid = (int)L; { const int q = nwg / 8, r = nwg % 8, xcd = wgid % 8, off = wgid / 8; wgid = (xcd < r ? xcd * (q + 1) : r * (q + 1) + (xcd - r) * q) + off; }
        const int ht = wgid / nN, pn = wgid % nN, g = ht / (2 * nM), hm = ht % (2 * nM);
        u.A = A + (size_t)g * gsA + (size_t)hm * HALF * lda * 2; u.B = B + (size_t)g * gsB + (size_t)pn * BM * ldb * 2;
        u.r0 = hm * HALF; u.c0 = pn * BM; u.aux = g; u.nrows = HALF; u.ridx = nullptr; return true;
    }
};

struct RaggedSched {
    const char* A; const char* B; const LAS int* tab; size_t gsB; int lda, ldb, nN, G, c; const int* ridx;
    __device__ __forceinline__ static int remap(int wgid, int nwg) { const int q = nwg / 8, r = nwg % 8, xcd = wgid % 8, off = wgid / 8; return (xcd < r ? xcd * (q + 1) : r * (q + 1) + (xcd - r) * q) + off; }
    __device__ __forceinline__ bool next(int i, Unit& u) const {
        const int nF = tab[128 + 64] * nN, nR = tab[200 + 64] * nN;
        const long L = (long)i * G + c; if (L >= nF + nR) return false;
        int e = 0, mt, pn;
        if (L < nF) { const int w = remap((int)L, nF); const int rt = w / nN; pn = w % nN; while (tab[128 + e + 1] <= rt) ++e; mt = rt - tab[128 + e]; }
        else { const int w = remap((int)L - nF, nR); const int rt = w / nN; pn = w % nN; while (tab[200 + e + 1] <= rt) ++e; mt = tab[e] >> 8; }
        const int cnt = tab[e], ro = tab[64 + e] + mt * BM;
        u.A = ridx ? A : A + (size_t)ro * lda * 2; u.B = B + (size_t)e * gsB + (size_t)pn * BM * ldb * 2; u.ridx = ridx ? ridx + ro : nullptr;
        u.r0 = ro; u.c0 = pn * BM; u.aux = e; u.nrows = (cnt - mt * BM) < BM ? (cnt - mt * BM) : BM; return true;
    }
};

__device__ __forceinline__ int perm32(int rho) { const int n = rho >> 4, i = rho & 15; return 8 * (i >> 2) + 4 * n + (i & 3); }
template <bool RAGGED = false, bool GATHER = false, bool PERM = false, bool FP8 = false, class Sched, class Epi>
__device__ __forceinline__ void gemm_phase(LAS unsigned char* lds, const int K, const int lda, const int ldb, const Sched& S, const Epi& E) {
    int tid = threadIdx.x; asm volatile("" : "+v"(tid));
    const int wid = __builtin_amdgcn_readfirstlane(tid >> 6), lane = tid & 63, wr = wid >> 2, wc = wid & 3, fr = lane & 15, fq = lane >> 4;
    int nt = K / BK; asm volatile("" : "+s"(nt));
    unsigned voffA[2], voffB[2]; int stR[2], stC[2];
#pragma unroll
    for (int i = 0; i < 2; ++i) { int R, C; stage_rc(tid * 16 + i * 8192, R, C); stR[i] = R; stC[i] = C; voffA[i] = (unsigned)(R * lda + C) * 2u; const int Rb = PERM ? ((R & ~31) + perm32(R & 31)) : R; voffB[i] = (unsigned)(Rb * ldb + C) * 2u; }
    unsigned gA0[2], gA1[2], gN0[2], gN1[2];
#define G8_GOFF(u, d0, d1) do { _Pragma("unroll") for (int _i = 0; _i < 2; ++_i) { \
        const int _r0 = stR[_i] < (u).nrows ? stR[_i] : 0, _r1 = (HALF + stR[_i]) < (u).nrows ? HALF + stR[_i] : 0; \
        d0[_i] = (unsigned)((u).ridx[_r0] * lda + stC[_i]) * 2u; d1[_i] = (unsigned)((u).ridx[_r1] * lda + stC[_i]) * 2u; } } while (0)
    const size_t kstep = (size_t)(BK * 2);
    const size_t hstepA = (size_t)HALF * lda * 2, hstepB = (size_t)HALF * ldb * 2;
    const unsigned ldsw = (unsigned)wid * 1024u;
    const int aoff = lds_byte(wr * 64 + fr, fq * 8), boff = lds_byte(wc * 32 + fr, fq * 8);
#define G8_SA(b, h) (((b) * 2 + (h)) * HTB)
#define G8_SB(b, h) ((4 + (b) * 2 + (h)) * HTB)
#define G8_STAGE(bufoff, gbase, voff) do { _Pragma("unroll") for (int _i = 0; _i < 2; ++_i) \
        __builtin_amdgcn_global_load_lds((const unsigned*)((const char*)(gbase) + (voff)[_i]), (LAS unsigned*)(lds + (bufoff) + ldsw + _i * 8192), 16, 0, 0); } while (0)
#define G8_LDA(dst, b, h) do { _Pragma("unroll") for (int m = 0; m < 4; ++m) _Pragma("unroll") for (int k = 0; k < 2; ++k) dst[m][k] = *(const LAS bf16x8*)(lds + G8_SA(b, h) + aoff + m * 2048 + k * 1024); } while (0)
#define G8_LDB(dst, b, h) do { _Pragma("unroll") for (int n = 0; n < 2; ++n) _Pragma("unroll") for (int k = 0; k < 2; ++k) dst[n][k] = *(const LAS bf16x8*)(lds + G8_SB(b, h) + boff + n * 2048 + k * 1024); } while (0)
#define G8_MMA(ai, bj, At, Bt) do { __builtin_amdgcn_s_setprio(1); \
        if constexpr (FP8) { _Pragma("unroll") for (int m = 0; m < 4; ++m) _Pragma("unroll") for (int n = 0; n < 2; ++n) { \
            const i32x8_ a_ = __builtin_shufflevector(__builtin_bit_cast(i32x4_, At[m][0]), __builtin_bit_cast(i32x4_, At[m][1]), 0, 1, 2, 3, 4, 5, 6, 7); \
            const i32x8_ b_ = __builtin_shufflevector(__builtin_bit_cast(i32x4_, Bt[n][0]), __builtin_bit_cast(i32x4_, Bt[n][1]), 0, 1, 2, 3, 4, 5, 6, 7); \
            acc[ai][bj][m][n] = __builtin_amdgcn_mfma_scale_f32_16x16x128_f8f6f4(b_, a_, acc[ai][bj][m][n], 0, 0, 0, 0x7f7f7f7f, 0, 0x7f7f7f7f); } } \
        else { _Pragma("unroll") for (int m = 0; m < 4; ++m) _Pragma("unroll") for (int n = 0; n < 2; ++n) _Pragma("unroll") for (int k = 0; k < 2; ++k) \
            acc[ai][bj][m][n] = __builtin_amdgcn_mfma_f32_16x16x32_bf16(Bt[n][k], At[m][k], acc[ai][bj][m][n], 0, 0, 0); } \
        __builtin_amdgcn_s_setprio(0); } while (0)
#define G8_WAIT_V(n) asm volatile("s_waitcnt vmcnt(" #n ")" ::: "memory")
#define G8_WAIT_L(n) asm volatile("s_waitcnt lgkmcnt(" #n ")" ::: "memory")
#define G8_BAR __builtin_amdgcn_s_barrier()
#define G8_SCHED __builtin_amdgcn_sched_barrier(0)
    Unit cur, nxt; int ui = 0;
    if (!S.next(0, cur)) return;
    f32x4 acc[2][2][4][2];
#pragma unroll
    for (int a = 0; a < 2; ++a)
#pragma unroll
        for (int b = 0; b < 2; ++b)
#pragma unroll
            for (int m = 0; m < 4; ++m)
#pragma unroll
                for (int n = 0; n < 2; ++n) acc[a][b][m][n] = (f32x4){0.f, 0.f, 0.f, 0.f};
    bf16x8 At[4][2], B0[2][2], B1[2][2];
    const char* cA = cur.A; const char* cB = cur.B;
    if (GATHER) { G8_GOFF(cur, gA0, gA1); _Pragma("unroll") for (int _i = 0; _i < 2; ++_i) { gN0[_i] = gA0[_i]; gN1[_i] = gA1[_i]; } }
#define G8_STAGE_A(bufoff, gbase, half, nx) do { if (GATHER) { unsigned _v[2]; _Pragma("unroll") for (int _i = 0; _i < 2; ++_i) _v[_i] = (nx) ? ((half) ? gN1[_i] : gN0[_i]) : ((half) ? gA1[_i] : gA0[_i]); G8_STAGE(bufoff, gbase, _v); } \
        else { G8_STAGE(bufoff, (gbase) + ((half) ? hstepA : 0), voffA); } } while (0)
    G8_STAGE(G8_SB(0, 0), cB, voffB); G8_STAGE_A(G8_SA(0, 0), cA, 0, false); G8_STAGE(G8_SB(0, 1), cB + hstepB, voffB); G8_STAGE_A(G8_SA(0, 1), cA, 1, false);
    if (wr == 1) G8_BAR;
    G8_WAIT_V(4); G8_BAR;
    G8_STAGE(G8_SB(1, 0), cB + kstep, voffB); G8_STAGE_A(G8_SA(1, 0), cA + kstep, 0, false); G8_STAGE(G8_SB(1, 1), cB + hstepB + kstep, voffB);
    G8_WAIT_V(6); G8_BAR;
    for (;;) {
        const bool has_next = S.next(ui + 1, nxt);
        const bool do0 = !RAGGED || (wr * 64 < cur.nrows), do1 = !RAGGED || (HALF + wr * 64 < cur.nrows);
        if (GATHER && has_next) G8_GOFF(nxt, gN0, gN1);
        const char* nA = has_next ? nxt.A : cA; const char* nB = has_next ? nxt.B : cB;
        for (int t = 0; t < nt; t += 2) {
            const bool last = (t == nt - 2);
            const char* a1 = cA + (size_t)(t + 1) * kstep;
            const char* a2 = last ? nA : cA + (size_t)(t + 2) * kstep; const char* b2 = last ? nB : cB + (size_t)(t + 2) * kstep;
            const char* a3 = a2 + kstep; const char* b3 = b2 + kstep;
            G8_LDB(B0, 0, 0); G8_SCHED; G8_LDA(At, 0, 0); G8_STAGE_A(G8_SA(1, 1), a1, 1, false);
            G8_WAIT_L(8); G8_BAR; G8_WAIT_L(0); if (do0) G8_MMA(0, 0, At, B0); G8_BAR; G8_SCHED;
            G8_LDB(B1, 0, 1); G8_STAGE(G8_SB(0, 0), b2, voffB);
            G8_BAR; G8_WAIT_L(0); if (do0) G8_MMA(0, 1, At, B1); G8_BAR;
            G8_LDA(At, 0, 1); G8_STAGE_A(G8_SA(0, 0), a2, 0, last);
            G8_BAR; G8_WAIT_L(0); if (do1) G8_MMA(1, 0, At, B0); G8_BAR; G8_SCHED;
            G8_STAGE(G8_SB(0, 1), b2 + hstepB, voffB);
            G8_WAIT_V(6); G8_BAR; if (do1) G8_MMA(1, 1, At, B1); G8_BAR;
            G8_LDB(B0, 1, 0); G8_SCHED; G8_LDA(At, 1, 0); G8_STAGE_A(G8_SA(0, 1), a2, 1, last);
            G8_WAIT_L(8); G8_BAR; G8_WAIT_L(0); if (do0) G8_MMA(0, 0, At, B0); G8_BAR; G8_SCHED;
            G8_LDB(B1, 1, 1); G8_STAGE(G8_SB(1, 0), b3, voffB);
            G8_BAR; G8_WAIT_L(0); if (do0) G8_MMA(0, 1, At, B1); G8_BAR;
            G8_LDA(At, 1, 1); G8_STAGE_A(G8_SA(1, 0), a3, 0, last);
            G8_BAR; G8_WAIT_L(0); if (do1) G8_MMA(1, 0, At, B0); G8_BAR; G8_SCHED;
            G8_STAGE(G8_SB(1, 1), b3 + hstepB, voffB);
            G8_WAIT_V(6); G8_BAR; if (do1) G8_MMA(1, 1, At, B1); G8_BAR;
        }
        if constexpr (PERM) {
            typedef decltype(E.load(cur, 0, 0)) AuxT_;
            constexpr int GS = sizeof(AuxT_) <= 16 ? 8 : (sizeof(AuxT_) <= 32 ? 4 : 2), NG = 16 / GS;
            AuxT_ ax[2][GS];
#define G8_ROW(e) ((((e) >> 3) & 1) * HALF + wr * 64 + (((e) >> 1) & 3) * 16 + fr)
#define G8_COL(e) (((e) & 1) * HALF + wc * 32 + 8 * fq)
#pragma unroll
            for (int j = 0; j < GS; ++j) ax[0][j] = E.load(cur, G8_ROW(j), G8_COL(j));
#pragma unroll
            for (int g = 0; g < NG; ++g) {
                if (g + 1 < NG) {
#pragma unroll
                    for (int j = 0; j < GS; ++j) ax[(g + 1) & 1][j] = E.load(cur, G8_ROW((g + 1) * GS + j), G8_COL((g + 1) * GS + j));
                }
#pragma unroll
                for (int j = 0; j < GS; ++j) { const int e = g * GS + j; E.store(cur, G8_ROW(e), G8_COL(e), acc[(e >> 3) & 1][e & 1][(e >> 1) & 3][0], acc[(e >> 3) & 1][e & 1][(e >> 1) & 3][1], ax[g & 1][j]); }
            }
#undef G8_ROW
#undef G8_COL
        } else
        {
            typedef decltype(E.load(cur, 0, 0)) AuxT_;
            constexpr int GS = sizeof(AuxT_) <= 8 ? 16 : (sizeof(AuxT_) <= 16 ? 8 : 4), NG = 32 / GS;
            AuxT_ ax[2][GS];
#define G8_ROW(e) ((((e) >> 4) & 1) * HALF + wr * 64 + (((e) >> 2) & 3) * 16 + fr)
#define G8_COL(e) ((((e) >> 1) & 1) * HALF + wc * 32 + ((e) & 1) * 16 + 4 * fq)
#pragma unroll
            for (int j = 0; j < GS; ++j) ax[0][j] = E.load(cur, G8_ROW(j), G8_COL(j));
#pragma unroll
            for (int g = 0; g < NG; ++g) {
                if (g + 1 < NG) {
#pragma unroll
                    for (int j = 0; j < GS; ++j) ax[(g + 1) & 1][j] = E.load(cur, G8_ROW((g + 1) * GS + j), G8_COL((g + 1) * GS + j));
                }
#pragma unroll
                for (int j = 0; j < GS; ++j) { const int e = g * GS + j; E.store(cur, G8_ROW(e), G8_COL(e), acc[(e >> 4) & 1][(e >> 1) & 1][(e >> 2) & 3][e & 1], ax[g & 1][j]); }
            }
#undef G8_ROW
#undef G8_COL
        }
        if (!has_next) break;
#pragma unroll
        for (int a = 0; a < 2; ++a)
#pragma unroll
            for (int b = 0; b < 2; ++b)
#pragma unroll
                for (int m = 0; m < 4; ++m)
#pragma unroll
                    for (int n = 0; n < 2; ++n) acc[a][b][m][n] = (f32x4){0.f, 0.f, 0.f, 0.f};
        cur = nxt; cA = nA; cB = nB; ++ui;
        if (GATHER) { _Pragma("unroll") for (int _i = 0; _i < 2; ++_i) { gA0[_i] = gN0[_i]; gA1[_i] = gN1[_i]; } }
    }
    G8_WAIT_V(0);
    if (wr == 0) G8_BAR;
    G8_BAR;
#undef G8_SA
#undef G8_SB
#undef G8_STAGE
#undef G8_STAGE_A
#undef G8_GOFF
#undef G8_LDA
#undef G8_LDB
#undef G8_MMA
#undef G8_WAIT_V
#undef G8_WAIT_L
#undef G8_BAR
#undef G8_SCHED
}
}

struct OneUnit { g8::Unit u; __device__ __forceinline__ bool next(int i, g8::Unit& o) const { if (i) return false; o = u; return true; } };
__device__ __forceinline__ void store16_wt(void* ptr, const u32x4 v) { asm volatile("global_store_dwordx4 %0, %1, off sc1\n\ts_nop 1" :: "v"(ptr), "v"(v) : "memory"); }
__device__ __forceinline__ void group_arrive(unsigned* cnt) {
    asm volatile("s_waitcnt vmcnt(0)" ::: "memory");
    __syncthreads();
    if (threadIdx.x == 0) (void)__hip_atomic_fetch_add(cnt, 1u, __ATOMIC_RELAXED, __HIP_MEMORY_SCOPE_AGENT);
}
__device__ __forceinline__ void group_wait(unsigned* cnt, const unsigned target) {
    if (threadIdx.x == 0) {
        unsigned sp = 0;
        while (__hip_atomic_load(cnt, __ATOMIC_RELAXED, __HIP_MEMORY_SCOPE_AGENT) < target) { __builtin_amdgcn_s_sleep(1); if (++sp > (1u << 20)) break; }
        __builtin_amdgcn_fence(__ATOMIC_ACQUIRE, "agent");
        asm volatile("s_waitcnt vmcnt(0)" ::: "memory");
    }
    __syncthreads();
}
struct NoAux {};
template <class F> struct EpiNoLoad {
    F f;
    __device__ __forceinline__ NoAux load(const g8::Unit&, int, int) const { return NoAux{}; }
    __device__ __forceinline__ void store(const g8::Unit& u, int rl, int cl, f32x4 v, const NoAux&) const { f(u, rl, cl, v); }
};
template <class F> __device__ __forceinline__ EpiNoLoad<F> epi_noload(const F& f) { return EpiNoLoad<F>{f}; }
template <class L, class S> struct EpiLS {
    L l; S s;
    __device__ __forceinline__ auto load(const g8::Unit& u, int rl, int cl) const { return l(u, rl, cl); }
    template <class A> __device__ __forceinline__ void store(const g8::Unit& u, int rl, int cl, f32x4 v, const A& a) const { s(u, rl, cl, v, a); }
};
template <class L, class S> __device__ __forceinline__ EpiLS<L, S> epi_ls(const L& l, const S& s) { return EpiLS<L, S>{l, s}; }
template <class F> struct EpiNoLoad8 {
    F f;
    __device__ __forceinline__ NoAux load(const g8::Unit&, int, int) const { return NoAux{}; }
    __device__ __forceinline__ void store(const g8::Unit& u, int rl, int cl, f32x4 v0, f32x4 v1, const NoAux&) const { f(u, rl, cl, v0, v1); }
};
template <class F> __device__ __forceinline__ EpiNoLoad8<F> epi_noload8(const F& f) { return EpiNoLoad8<F>{f}; }
template <class L, class S> struct EpiLS8 {
    L l; S s;
    __device__ __forceinline__ auto load(const g8::Unit& u, int rl, int cl) const { return l(u, rl, cl); }
    template <class A> __device__ __forceinline__ void store(const g8::Unit& u, int rl, int cl, f32x4 v0, f32x4 v1, const A& a) const { s(u, rl, cl, v0, v1, a); }
};
template <class L, class S> __device__ __forceinline__ EpiLS8<L, S> epi_ls8(const L& l, const S& s) { return EpiLS8<L, S>{l, s}; }
__device__ __forceinline__ float bflo(unsigned w) { return __uint_as_float(w << 16); }
__device__ __forceinline__ float bfhi(unsigned w) { return __uint_as_float(w & 0xffff0000u); }
struct Aux2 { u32x2 a, b; };
struct Aux44 { u32x4 a, b; };
struct AuxF8 { f32x4 a, b; };
struct AuxY8 { u32x4 uu; f32x4 d0, d1; };
struct AuxY { u32x2 uu; f32x4 dd; };
struct AuxT { f32x2 t0, t1; };
struct AuxS { int as; float w; };

template <bool PERM = false, class Epi>
__device__ __forceinline__ void half_gemm(LAS unsigned char* lds, const bf16_t* A, const bf16_t* B, int M, int N, int K, int lda, int ldb, int nG, size_t gsA, size_t gsB, const Epi& E, int G = -1, int c = -1, int i0 = 0, int nr = 1 << 30) {
    g8::HalfSched S; S.i0 = i0; S.nr = nr; S.A = (const char*)A; S.B = (const char*)B; S.gsA = gsA * 2; S.gsB = gsB * 2; S.lda = lda; S.ldb = ldb; S.nM = M / 256; S.nN = N / 256; S.nG = nG; S.G = G < 0 ? (int)gridDim.x : G; S.c = c < 0 ? (int)blockIdx.x : c;
    g8::gemm_phase<true, false, PERM>(lds, K, lda, ldb, S, E);
}
template <bool PERM = false, class Epi>
__device__ __forceinline__ void dense_gemm(LAS unsigned char* lds, const bf16_t* A, const bf16_t* B, int M, int N, int K, int lda, int ldb, int nG, size_t gsA, size_t gsB, const Epi& E, int G = -1, int c = -1, int i0 = 0, int nr = 1 << 30) {
    g8::DenseSched S; S.i0 = i0; S.nr = nr; S.A = (const char*)A; S.B = (const char*)B; S.gsA = gsA * 2; S.gsB = gsB * 2; S.lda = lda; S.ldb = ldb; S.nM = M / 256; S.nN = N / 256; S.nG = nG; S.G = G < 0 ? (int)gridDim.x : G; S.c = c < 0 ? (int)blockIdx.x : c;
    g8::gemm_phase<false, false, PERM>(lds, K, lda, ldb, S, E);
}

struct TJob { const float* src; bf16_t* dst; int K, N, nmul, nadd, tile, fp8; };
__device__ __forceinline__ void tjob_load(const TJob& j, const int lane_, f32x4 (&v)[16]) {
    int lane = lane_; asm volatile("" : "+v"(lane));
    const int tk = j.K / 64, k0 = (j.tile % tk) * 64, n0 = (j.tile / tk) * 64;
    const char* base = (const char*)(j.src + (size_t)k0 * j.N + n0);
    const unsigned loff = (unsigned)(((lane >> 4) * j.N + (lane & 15) * 4) * 4), step = (unsigned)(16 * j.N);
#pragma unroll
    for (int i = 0; i < 16; ++i) v[i] = __builtin_nontemporal_load((const f32x4*)(base + (loff + (unsigned)i * step)));
}
__device__ __forceinline__ void tjob_process(const TJob& j, const int lane_, const f32x4 (&v)[16], LAS float* lds) {
    int lane = lane_; asm volatile("" : "+v"(lane));
    const int tk = j.K / 64, k0 = (j.tile % tk) * 64, n0 = (j.tile / tk) * 64;
    {
        LAS float* wp = lds + (lane >> 4) * 65 + (lane & 15) * 4;
#pragma unroll
        for (int i = 0; i < 16; ++i) { wp[i * 260 + 0] = v[i][0]; wp[i * 260 + 1] = v[i][1]; wp[i * 260 + 2] = v[i][2]; wp[i * 260 + 3] = v[i][3]; }
    }
    asm volatile("s_waitcnt lgkmcnt(0)" ::: "memory");
    const int kc = (lane & 7) * 8;
    const LAS float* rp = lds + kc * 65 + (lane >> 3);
    if (j.fp8) {
        unsigned char* db = (unsigned char*)j.dst + (size_t)(n0 * j.nmul + j.nadd) * j.K + k0;
        const unsigned soff = (unsigned)((lane >> 3) * j.nmul * j.K + kc), sstep = (unsigned)(8 * j.nmul * j.K);
#pragma unroll
        for (int it = 0; it < 8; ++it) {
            u32x2 w;
            w[0] = pack4_fp8(rp[0 * 65 + it * 8] * WSCALE8, rp[1 * 65 + it * 8] * WSCALE8, rp[2 * 65 + it * 8] * WSCALE8, rp[3 * 65 + it * 8] * WSCALE8);
            w[1] = pack4_fp8(rp[4 * 65 + it * 8] * WSCALE8, rp[5 * 65 + it * 8] * WSCALE8, rp[6 * 65 + it * 8] * WSCALE8, rp[7 * 65 + it * 8] * WSCALE8);
            __builtin_nontemporal_store(w, (u32x2*)(db + (soff + (unsigned)it * sstep)));
            __builtin_amdgcn_sched_barrier(0);
        }
    } else {
        char* db = (char*)(j.dst + (size_t)(n0 * j.nmul + j.nadd) * j.K + k0);
        const unsigned soff = (unsigned)(((lane >> 3) * j.nmul * j.K + kc) * 2), sstep = (unsigned)(16 * j.nmul * j.K);
#pragma unroll
        for (int it = 0; it < 8; ++it) {
            u32x4 w;
            w[0] = pack2(rp[0 * 65 + it * 8], rp[1 * 65 + it * 8]);
            w[1] = pack2(rp[2 * 65 + it * 8], rp[3 * 65 + it * 8]);
            w[2] = pack2(rp[4 * 65 + it * 8], rp[5 * 65 + it * 8]);
            w[3] = pack2(rp[6 * 65 + it * 8], rp[7 * 65 + it * 8]);
            *(u32x4*)(db + (soff + (unsigned)it * sstep)) = w;
        }
    }
    asm volatile("s_waitcnt lgkmcnt(0)" ::: "memory");
}

__device__ void ssm_prep_job(const Params& p, const int g, const int part, float* lds) {
    f32x2* pw = (f32x2*)lds;
    f32x2* bb = pw + 4224;
    f32x2* cm = bb + 2048;
    float* kt = (float*)(cm + 2048);
    const int t = threadIdx.x;
    bf16_t* BtS = (bf16_t*)(p.ws + OFF_BTS) + (size_t)g * 256 * 512;
    bf16_t* BtY = (bf16_t*)(p.ws + OFF_BTY) + (size_t)g * 512 * UK;
    f32x2* aL = (f32x2*)(p.ws + OFF_J + J_AL);
    f32x2* prm = (f32x2*)(kt + 2048);
    __syncthreads();
    f32x2 bv[4], cv_[4];
#pragma unroll
    for (int q = 0; q < 4; ++q) {
        const int i = t + q * NTHREADS;
        { const int dir = i / 1024, n = (i / 16) % 64, ci = i % 16; const size_t bi = ((size_t)(dir * SG + g) * SN + n) * SC + ci; bv[q] = (f32x2){p.B_re[bi], p.B_im[bi]}; }
        { const int dir = i / 1024, co = (i / 64) % 16, n = i % 64; const size_t ci_ = ((size_t)(dir * SG + g) * SC + co) * SN + n; cv_[q] = (f32x2){p.C_re[ci_], p.C_im[ci_]}; }
    }
    if (t < 128) {
        const int dir = t >> 6, n = t & 63;
        const float dt = expf(p.log_dt[dir * SG + g]);
        prm[t] = (f32x2){p.A_re[(dir * SG + g) * SN + n] * dt, p.A_im[(dir * SG + g) * SN + n] * dt};
    }
#pragma unroll
    for (int q = 0; q < 4; ++q) cm[t + q * NTHREADS] = cv_[q];
    __syncthreads();
    for (int i = t; i < 2 * 64 * 33; i += NTHREADS) {
        const int dir = i / (64 * 33), n = (i / 33) % 64, tau = i % 33;
        const f32x2 ld = prm[dir * 64 + n];
        const float mag = expf(ld[0] * (float)tau); float sv, cv; sincosf(ld[1] * (float)tau, &sv, &cv);
        pw[i] = (f32x2){mag * cv, mag * sv};
        if (tau == 32 && part == 0) aL[(dir * SG + g) * SN + n] = pw[i];
    }
#pragma unroll
    for (int q = 0; q < 4; ++q) {
        const int i = t + q * NTHREADS;
        const int dir = i / 1024, n = (i / 16) % 64;
        const f32x2 ld = prm[dir * 64 + n];
        float sv, cv; sincosf(ld[1], &sv, &cv);
        const float mag = expf(ld[0]), nr = mag * cv - 1.0f, ni = mag * sv;
        const float den = ld[0] * ld[0] + ld[1] * ld[1];
        const float dt = expf(p.log_dt[dir * SG + g]);
        const float qr = dt * (nr * ld[0] + ni * ld[1]) / den, qi = dt * (ni * ld[0] - nr * ld[1]) / den;
        bb[i] = (f32x2){qr * bv[q][0] - qi * bv[q][1], qr * bv[q][1] + qi * bv[q][0]};
    }
    __syncthreads();
    f32x2* zt = prm + 128;
    for (int i = t; i < 2 * 32 * 2 * 64; i += NTHREADS) {
        const int dir = i >> 12, tau = (i >> 7) & 31, col = (i >> 6) & 1, n = i & 63, co = 2 * part + col;
        const f32x2 c = cm[(dir * 16 + co) * 64 + n], a = pw[(dir * 64 + n) * 33 + tau];
        zt[i] = (f32x2){c[0] * a[0] - c[1] * a[1], c[0] * a[1] + c[1] * a[0]};
    }
    __syncthreads();
    for (int i = t; i < 2 * 32 * 2 * 4; i += NTHREADS) {
        const int dir = i >> 8, ci0 = (i & 3) * 4;
        const f32x2* zp = zt + (size_t)(i >> 2) * 64;
        float s[4] = {0.f, 0.f, 0.f, 0.f};
#pragma unroll 8
        for (int n = 0; n < 64; ++n) {
            const f32x2 z = zp[n];
            const f32x4 b01 = *(const f32x4*)&bb[(dir * 64 + n) * 16 + ci0], b23 = *(const f32x4*)&bb[(dir * 64 + n) * 16 + ci0 + 2];
            s[0] += z[0] * b01[0] - z[1] * b01[1]; s[1] += z[0] * b01[2] - z[1] * b01[3];
            s[2] += z[0] * b23[0] - z[1] * b23[1]; s[3] += z[0] * b23[2] - z[1] * b23[3];
        }
#pragma unroll
        for (int j = 0; j < 4; ++j) kt[(i >> 2) * 16 + ci0 + j] = s[j];
    }
    __syncthreads();
    for (int it = t; it < 32 * 64; it += NTHREADS) {
        const int rr = it >> 6, s = (it >> 1) & 31, h8 = (it & 1) * 8;
        const int dir = rr >> 4, n = 8 * part + ((rr >> 1) & 7), ri = rr & 1;
        const f32x2 a = pw[(dir * 64 + n) * 33 + (dir == 0 ? (LC - 1 - s) : s)];
        float v[8];
#pragma unroll
        for (int j = 0; j < 8; ++j) { const f32x2 b = bb[(dir * 64 + n) * 16 + h8 + j]; v[j] = ri == 0 ? (a[0] * b[0] - a[1] * b[1]) : (a[0] * b[1] + a[1] * b[0]); }
        u32x4 w; w[0] = pack2(v[0], v[1]); w[1] = pack2(v[2], v[3]); w[2] = pack2(v[4], v[5]); w[3] = pack2(v[6], v[7]);
        *(u32x4*)(BtS + (size_t)((dir * 64 + n) * 2 + ri) * 512 + s * 16 + h8) = w;
    }
    for (int it = t; it < 64 * 64; it += NTHREADS) {
        const int rr = it >> 6, s = (it >> 1) & 31, h8 = (it & 1) * 8;
        const int tt = rr >> 1, col = rr & 1, co = 2 * part + col;
        float v[8];
        if (s < tt)      { const float* k0 = kt + ((0 * 32 + (tt - s)) * 2 + col) * 16 + h8; _Pragma("unroll") for (int j = 0; j < 8; ++j) v[j] = k0[j]; }
        else if (s > tt) { const float* k0 = kt + ((1 * 32 + (s - tt)) * 2 + col) * 16 + h8; _Pragma("unroll") for (int j = 0; j < 8; ++j) v[j] = k0[j]; }
        else             { const float* k0 = kt + ((0 * 32 + 0) * 2 + col) * 16 + h8; const float* k1 = kt + ((1 * 32 + 0) * 2 + col) * 16 + h8; _Pragma("unroll") for (int j = 0; j < 8; ++j) v[j] = k0[j] + k1[j]; }
        u32x4 w; w[0] = pack2(v[0], v[1]); w[1] = pack2(v[2], v[3]); w[2] = pack2(v[4], v[5]); w[3] = pack2(v[6], v[7]);
        *(u32x4*)(BtY + (size_t)(tt * 16 + co) * UK + s * 16 + h8) = w;
    }
    for (int it = t; it < 64 * 32; it += NTHREADS) {
        const int rr = it >> 5, dir = (it >> 4) & 1, n0 = (it & 15) * 4;
        const int tt = rr >> 1, col = rr & 1, co = 2 * part + col;
        const int tau = dir == 0 ? (tt + 1) : (LC - tt);
        float v[8];
#pragma unroll
        for (int j = 0; j < 4; ++j) {
            const f32x2 c = cm[(dir * 16 + co) * 64 + n0 + j], a = pw[(dir * 64 + n0 + j) * 33 + tau];
            v[2 * j] = c[0] * a[0] - c[1] * a[1]; v[2 * j + 1] = -(c[0] * a[1] + c[1] * a[0]);
        }
        u32x4 w; w[0] = pack2(v[0], v[1]); w[1] = pack2(v[2], v[3]); w[2] = pack2(v[4], v[5]); w[3] = pack2(v[6], v[7]);
        *(u32x4*)(BtY + (size_t)(tt * 16 + co) * UK + 512 + dir * 128 + n0 * 2) = w;
    }
}

__device__ __forceinline__ void load_row(const float* row, const int lane, f32x4 (&v)[4]) {
#pragma unroll
    for (int i = 0; i < 4; ++i) v[i] = *(const f32x4*)(row + 4 * lane + 256 * i);
}
__device__ __forceinline__ void load_row_bf16(const bf16_t* row, const int lane, f32x4 (&v)[4]) {
#pragma unroll
    for (int i = 0; i < 4; ++i) { const u32x2 w = *(const u32x2*)(row + 4 * lane + 256 * i); v[i] = (f32x4){__uint_as_float(w[0] << 16), __uint_as_float(w[0] & 0xffff0000u), __uint_as_float(w[1] << 16), __uint_as_float(w[1] & 0xffff0000u)}; }
}
__device__ __forceinline__ unsigned pack4_u8(float a, float b, float c, float d) {
    const unsigned u0 = (unsigned)(a * 255.0f + 0.5f), u1 = (unsigned)(b * 255.0f + 0.5f), u2 = (unsigned)(c * 255.0f + 0.5f), u3 = (unsigned)(d * 255.0f + 0.5f);
    return u0 | (u1 << 8) | (u2 << 16) | (u3 << 24);
}
__device__ __forceinline__ float g8f(unsigned w, int j) { return (float)((w >> (8 * j)) & 0xffu) * (1.0f / 255.0f); }
struct AuxG { u32x2 g; u32x4 m; };
constexpr float YSCALE8 = 16.0f;
__device__ __forceinline__ float row_inv_rms(const f32x4 (&v)[4]) {
    float s = 0.f;
#pragma unroll
    for (int i = 0; i < 4; ++i) s += v[i][0] * v[i][0] + v[i][1] * v[i][1] + v[i][2] * v[i][2] + v[i][3] * v[i][3];
    s = wave_sum(s);
    return 1.0f / sqrtf(s * (1.0f / 1024.0f) + 1e-6f);
}

__constant__ float CS128[128][2] = {{1.000000000e+00f, 0.000000000e+00f}, {9.987954562e-01f, 4.906767433e-02f}, {9.951847267e-01f, 9.801714033e-02f}, {9.891765100e-01f, 1.467304745e-01f}, {9.807852804e-01f, 1.950903220e-01f}, {9.700312532e-01f, 2.429801799e-01f}, {9.569403357e-01f, 2.902846773e-01f}, {9.415440652e-01f, 3.368898534e-01f}, {9.238795325e-01f, 3.826834324e-01f}, {9.039892931e-01f, 4.275550934e-01f}, {8.819212643e-01f, 4.713967368e-01f}, {8.577286100e-01f, 5.141027442e-01f}, {8.314696123e-01f, 5.555702330e-01f}, {8.032075315e-01f, 5.956993045e-01f}, {7.730104534e-01f, 6.343932842e-01f}, {7.409511254e-01f, 6.715589548e-01f}, {7.071067812e-01f, 7.071067812e-01f}, {6.715589548e-01f, 7.409511254e-01f}, {6.343932842e-01f, 7.730104534e-01f}, {5.956993045e-01f, 8.032075315e-01f}, {5.555702330e-01f, 8.314696123e-01f}, {5.141027442e-01f, 8.577286100e-01f}, {4.713967368e-01f, 8.819212643e-01f}, {4.275550934e-01f, 9.039892931e-01f}, {3.826834324e-01f, 9.238795325e-01f}, {3.368898534e-01f, 9.415440652e-01f}, {2.902846773e-01f, 9.569403357e-01f}, {2.429801799e-01f, 9.700312532e-01f}, {1.950903220e-01f, 9.807852804e-01f}, {1.467304745e-01f, 9.891765100e-01f}, {9.801714033e-02f, 9.951847267e-01f}, {4.906767433e-02f, 9.987954562e-01f}, {6.123233996e-17f, 1.000000000e+00f}, {-4.906767433e-02f, 9.987954562e-01f}, {-9.801714033e-02f, 9.951847267e-01f}, {-1.467304745e-01f, 9.891765100e-01f}, {-1.950903220e-01f, 9.807852804e-01f}, {-2.429801799e-01f, 9.700312532e-01f}, {-2.902846773e-01f, 9.569403357e-01f}, {-3.368898534e-01f, 9.415440652e-01f}, {-3.826834324e-01f, 9.238795325e-01f}, {-4.275550934e-01f, 9.039892931e-01f}, {-4.713967368e-01f, 8.819212643e-01f}, {-5.141027442e-01f, 8.577286100e-01f}, {-5.555702330e-01f, 8.314696123e-01f}, {-5.956993045e-01f, 8.032075315e-01f}, {-6.343932842e-01f, 7.730104534e-01f}, {-6.715589548e-01f, 7.409511254e-01f}, {-7.071067812e-01f, 7.071067812e-01f}, {-7.409511254e-01f, 6.715589548e-01f}, {-7.730104534e-01f, 6.343932842e-01f}, {-8.032075315e-01f, 5.956993045e-01f}, {-8.314696123e-01f, 5.555702330e-01f}, {-8.577286100e-01f, 5.141027442e-01f}, {-8.819212643e-01f, 4.713967368e-01f}, {-9.039892931e-01f, 4.275550934e-01f}, {-9.238795325e-01f, 3.826834324e-01f}, {-9.415440652e-01f, 3.368898534e-01f}, {-9.569403357e-01f, 2.902846773e-01f}, {-9.700312532e-01f, 2.429801799e-01f}, {-9.807852804e-01f, 1.950903220e-01f}, {-9.891765100e-01f, 1.467304745e-01f}, {-9.951847267e-01f, 9.801714033e-02f}, {-9.987954562e-01f, 4.906767433e-02f}, {-1.000000000e+00f, 1.224646799e-16f}, {-9.987954562e-01f, -4.906767433e-02f}, {-9.951847267e-01f, -9.801714033e-02f}, {-9.891765100e-01f, -1.467304745e-01f}, {-9.807852804e-01f, -1.950903220e-01f}, {-9.700312532e-01f, -2.429801799e-01f}, {-9.569403357e-01f, -2.902846773e-01f}, {-9.415440652e-01f, -3.368898534e-01f}, {-9.238795325e-01f, -3.826834324e-01f}, {-9.039892931e-01f, -4.275550934e-01f}, {-8.819212643e-01f, -4.713967368e-01f}, {-8.577286100e-01f, -5.141027442e-01f}, {-8.314696123e-01f, -5.555702330e-01f}, {-8.032075315e-01f, -5.956993045e-01f}, {-7.730104534e-01f, -6.343932842e-01f}, {-7.409511254e-01f, -6.715589548e-01f}, {-7.071067812e-01f, -7.071067812e-01f}, {-6.715589548e-01f, -7.409511254e-01f}, {-6.343932842e-01f, -7.730104534e-01f}, {-5.956993045e-01f, -8.032075315e-01f}, {-5.555702330e-01f, -8.314696123e-01f}, {-5.141027442e-01f, -8.577286100e-01f}, {-4.713967368e-01f, -8.819212643e-01f}, {-4.275550934e-01f, -9.039892931e-01f}, {-3.826834324e-01f, -9.238795325e-01f}, {-3.368898534e-01f, -9.415440652e-01f}, {-2.902846773e-01f, -9.569403357e-01f}, {-2.429801799e-01f, -9.700312532e-01f}, {-1.950903220e-01f, -9.807852804e-01f}, {-1.467304745e-01f, -9.891765100e-01f}, {-9.801714033e-02f, -9.951847267e-01f}, {-4.906767433e-02f, -9.987954562e-01f}, {-1.836970199e-16f, -1.000000000e+00f}, {4.906767433e-02f, -9.987954562e-01f}, {9.801714033e-02f, -9.951847267e-01f}, {1.467304745e-01f, -9.891765100e-01f}, {1.950903220e-01f, -9.807852804e-01f}, {2.429801799e-01f, -9.700312532e-01f}, {2.902846773e-01f, -9.569403357e-01f}, {3.368898534e-01f, -9.415440652e-01f}, {3.826834324e-01f, -9.238795325e-01f}, {4.275550934e-01f, -9.039892931e-01f}, {4.713967368e-01f, -8.819212643e-01f}, {5.141027442e-01f, -8.577286100e-01f}, {5.555702330e-01f, -8.314696123e-01f}, {5.956993045e-01f, -8.032075315e-01f}, {6.343932842e-01f, -7.730104534e-01f}, {6.715589548e-01f, -7.409511254e-01f}, {7.071067812e-01f, -7.071067812e-01f}, {7.409511254e-01f, -6.715589548e-01f}, {7.730104534e-01f, -6.343932842e-01f}, {8.032075315e-01f, -5.956993045e-01f}, {8.314696123e-01f, -5.555702330e-01f}, {8.577286100e-01f, -5.141027442e-01f}, {8.819212643e-01f, -4.713967368e-01f}, {9.039892931e-01f, -4.275550934e-01f}, {9.238795325e-01f, -3.826834324e-01f}, {9.415440652e-01f, -3.368898534e-01f}, {9.569403357e-01f, -2.902846773e-01f}, {9.700312532e-01f, -2.429801799e-01f}, {9.807852804e-01f, -1.950903220e-01f}, {9.891765100e-01f, -1.467304745e-01f}, {9.951847267e-01f, -9.801714033e-02f}, {9.987954562e-01f, -4.906767433e-02f}};

constexpr int TJ_WIN = 16 * 48, TJ_GLU = 8 * 8, TJ_SSO = 8 * 16, TJ_WO = 16 * 16, TJ_EG = 64 * 16 * 8, TJ_ED = 64 * 8 * 16;
constexpr int TJ_NE = TJ_WIN + TJ_GLU + TJ_SSO + TJ_WO, TJ_TOTAL = TJ_NE + 2 * TJ_EG + TJ_ED;
#ifndef TJ_POOL
#define TJ_POOL 1536
#endif
#ifndef EXP_P0
#define EXP_P0 0
#endif
__device__ __forceinline__ TJob tjob_decode(const Params& p, int j) {
    unsigned char* ws = p.ws;
    int q = j;
    if (q < TJ_WIN) return TJob{p.w_in, (bf16_t*)(ws + OFF_WINT), 1024, 3072, 1, 0, q, 0};
    q -= TJ_WIN;
    if (q < TJ_GLU) return TJob{p.w_glu, (bf16_t*)(ws + OFF_WGLT), 512, 512, 1, 0, q, 0};
    q -= TJ_GLU;
    if (q < TJ_SSO) return TJob{p.w_sso, (bf16_t*)(ws + OFF_WSOT), 512, 1024, 1, 0, q, 0};
    q -= TJ_SSO;
    if (q < TJ_WO) return TJob{p.w_out, (bf16_t*)(ws + OFF_WOT), 1024, 1024, 1, 0, q, 0};
    q -= TJ_WO;
    if (q < TJ_EG) { const int e = q / 128; return TJob{p.e_gate + (size_t)e * 1024 * 512, (bf16_t*)(ws + OFF_WGUT + (size_t)e * 1024 * 1024), 1024, 512, 2, 0, q % 128, 1}; }
    q -= TJ_EG;
    if (q < TJ_EG) { const int e = q / 128; return TJob{p.e_up + (size_t)e * 1024 * 512, (bf16_t*)(ws + OFF_WGUT + (size_t)e * 1024 * 1024), 1024, 512, 2, 1, q % 128, 1}; }
    q -= TJ_EG;
    { const int e = q / 128; return TJob{p.e_down + (size_t)e * 512 * 1024, (bf16_t*)(ws + OFF_WDT + (size_t)e * 1024 * 512), 512, 1024, 1, 0, q % 128, 1}; }
}
__device__ __forceinline__ void run_tjobs_pool(const Params& p, const int jbeg, const int jend, unsigned* ctr, const int lane, LAS float* ldsw) {
    for (;;) {
        unsigned v = 0u;
        if (lane == 0) v = __hip_atomic_fetch_add(ctr, 1u, __ATOMIC_RELAXED, __HIP_MEMORY_SCOPE_AGENT);
        const int j = jbeg + (int)__builtin_amdgcn_readfirstlane(v);
        if (j >= jend) break;
        const TJob jb = tjob_decode(p, j); f32x4 vv[16];
        tjob_load(jb, lane, vv);
        tjob_process(jb, lane, vv, ldsw);
    }
}
template <int NB>
__device__ __forceinline__ void run_tjobs(const Params& p, const int jbeg, const int jend, const int w, const int nwv, const int lane, LAS float* ldsw) {
    TJob jq[NB]; f32x4 v[NB][16]; bool has[NB];
    const int wu = __builtin_amdgcn_readfirstlane(w);
#pragma unroll
    for (int k = 0; k < NB; ++k) {
        const int jj = jbeg + wu + k * nwv; has[k] = jj < jend; jq[k] = tjob_decode(p, has[k] ? jj : jbeg);
        if (has[k]) tjob_load(jq[k], lane, v[k]);
    }
    for (int j = jbeg + wu; j < jend; j += NB * nwv) {
#pragma unroll
        for (int k = 0; k < NB; ++k) {
            if (has[k]) {
                tjob_process(jq[k], lane, v[k], ldsw);
                const int jn = j + (k + NB) * nwv;
                has[k] = jn < jend;
                if (has[k]) { jq[k] = tjob_decode(p, jn); tjob_load(jq[k], lane, v[k]); }
            }
        }
    }
}

__global__ void __launch_bounds__(NTHREADS) fwd_megakernel(const Params p) {
    __shared__ __attribute__((aligned(16))) unsigned char smem[SMEM_BYTES];
#define PHASE_IDS int tid = threadIdx.x; asm volatile("" : "+v"(tid)); const int lane = tid & 63, wid = tid >> 6; \
    const int gw = blockIdx.x * NWAVES + wid, nw = gridDim.x * NWAVES, gt = blockIdx.x * NTHREADS + tid, nt = gridDim.x * NTHREADS; \
    (void)lane; (void)wid; (void)gw; (void)nw; (void)gt; (void)nt;
    unsigned char* ws = p.ws;
    unsigned char* Wgu8 = ws + OFF_WGUT; unsigned char* Wd8 = ws + OFF_WDT;
    bf16_t* WinT = (bf16_t*)(ws + OFF_WINT); bf16_t* WpT = (bf16_t*)(ws + OFF_WPT); bf16_t* WglT = (bf16_t*)(ws + OFF_WGLT);
    bf16_t* WsoT = (bf16_t*)(ws + OFF_WSOT); bf16_t* WoT = (bf16_t*)(ws + OFF_WOT);
    bf16_t* BtS = (bf16_t*)(ws + OFF_BTS); bf16_t* BtY = (bf16_t*)(ws + OFF_BTY);
    bf16_t* T2 = (bf16_t*)(ws + OFF_C); bf16_t* ybuf = (bf16_t*)(ws + OFF_C);
    bf16_t* hn = (bf16_t*)(ws + OFF_D); bf16_t* Fb = (bf16_t*)(ws + OFF_D); unsigned char* hn2 = ws + OFF_D;
    unsigned char* gates = ws + OFF_E;
    unsigned char* act = ws + OFF_E + 65 * MiB;
    bf16_t* XA = (bf16_t*)(ws + OFF_FG); float* Sst = (float*)(ws + OFF_FG + 16 * MiB); bf16_t* m1 = (bf16_t*)(ws + OFF_FG);
    bf16_t* Ucomb = (bf16_t*)(ws + OFF_H);
    bf16_t* yg = (bf16_t*)(ws + OFF_I); bf16_t* ys2 = (bf16_t*)(ws + OFF_I + 16 * MiB);
    unsigned* cnt = (unsigned*)(ws + OFF_J + J_CNT);
    const f32x2* aL = (const f32x2*)(ws + OFF_J + J_AL);
    f32x2* tokw = (f32x2*)(ws + OFF_J + J_TOKW);
    int* tokinfo = (int*)(ws + OFF_J + J_TOKINFO);
    int* slot_asg = (int*)(ws + OFF_J + J_SLOTASG);
    float* slot_w = (float*)(ws + OFF_J + J_SLOTW);
    int* hist = (int*)(ws + OFF_J + J_HIST);
    int* slot_tok = (int*)(ws + OFF_J + J_SLOTTOK);
    bf16_t* WrT = (bf16_t*)(ws + OFF_J + J_WRT);
    bf16_t* BtA = (bf16_t*)(ws + OFF_J + J_BTA); bf16_t* BtC = (bf16_t*)(ws + OFF_J + J_BTC); f32x2* TW = (f32x2*)(ws + OFF_J + J_TW);
    bf16_t* Xg = (bf16_t*)(ws + OFF_E);
    bf16_t* x2 = (bf16_t*)(ws + OFF_BTS);
    unsigned char* ybuf8 = ws + OFF_C;
    LAS unsigned char* ldsp = (LAS unsigned char*)smem;
    if (threadIdx.x == 0) { ((volatile LAS unsigned*)(ldsp + BAR_LDS_OFF))[0] = 0u; ((volatile LAS unsigned*)(ldsp + BAR_LDS_OFF))[1] = 0u; ((volatile LAS unsigned*)(ldsp + BAR_LDS_OFF))[2] = 0u; ((volatile LAS unsigned*)(ldsp + PBAR_LDS_OFF))[0] = 0u; ((volatile LAS unsigned*)(ldsp + PBAR_LDS_OFF))[1] = 0u; }
    __syncthreads();
    const XcdBarrier bar = xcd_barrier_post((unsigned*)(ws + OFF_J + J_BAR), (volatile LAS unsigned*)(ldsp + BAR_LDS_OFF));
#define GRID_SYNC() xcd_barrier(bar)
#define PART_ ((int)((blockIdx.x >> 3) & 1))
#define PIDX_ ((int)((blockIdx.x >> 4) * 8 + (blockIdx.x & 7)))
    if (gridDim.x == 256) (void)xcd_barrier_post((unsigned*)(ws + OFF_J + J_PBAR) + PART_ * XCD_BAR_WORDS, (volatile LAS unsigned*)(ldsp + PBAR_LDS_OFF), 128u);
#ifndef NCV
#define NCV 3
#endif
#define SPLIT_ (gridDim.x == 256)
#define CVB_ (SPLIT_ && (int)((blockIdx.x >> 3) & 7) >= 8 - NCV)
#define NGB_ (32 * (8 - NCV))
#define NCB_ (32 * NCV)
#define GIDX_ ((int)(((blockIdx.x >> 6) * (8 - NCV) + ((blockIdx.x >> 3) & 7)) * 8 + (blockIdx.x & 7)))
#define CIDX_ ((int)(((blockIdx.x >> 6) * NCV + ((blockIdx.x >> 3) & 7) - (8 - NCV)) * 8 + (blockIdx.x & 7)))
#if defined(TP_A)
    unsigned long long* tsp = (unsigned long long*)(ws + OFF_J + J_TS);
#define STAMP(k) do { if (blockIdx.x == 0 && threadIdx.x == 0) { __hip_atomic_store(tsp + (k), (unsigned long long)__builtin_amdgcn_s_memrealtime(), __ATOMIC_RELAXED, __HIP_MEMORY_SCOPE_AGENT); } } while (0)
#else
#define STAMP(k) do { } while (0)
#endif
#if defined(TP_A)
#define STAMPB(blk, k) do { if (blockIdx.x == (blk) && threadIdx.x == 0) { __hip_atomic_store(tsp + (k), (unsigned long long)__builtin_amdgcn_s_memrealtime(), __ATOMIC_RELAXED, __HIP_MEMORY_SCOPE_AGENT); } } while (0)
#else
#define STAMPB(blk, k) do { } while (0)
#endif
    STAMP(0);

    for (int _rep = 0; _rep < REP0; ++_rep) {
    {
        PHASE_IDS
        const bool split = SPLIT_, cvb = CVB_;
        const int gwe = split ? GIDX_ * NWAVES + wid : gw, nwe = split ? NGB_ * NWAVES : nw;
        auto rest = [&]() {
        if (!cvb) {
            auto hn_rows = [&](const int r0, auto NRC) {
                constexpr int NR = decltype(NRC)::value;
                f32x4 v[NR][4];
#pragma unroll
                for (int q = 0; q < NR; ++q) {
#pragma unroll
                    for (int i = 0; i < 4; ++i) v[q][i] = __builtin_nontemporal_load((const f32x4*)(p.x + (size_t)(r0 + q) * D + 4 * lane + 256 * i));
                }
#pragma unroll
                for (int q = 0; q < NR; ++q) {
                    const int r = r0 + q;
                    const float inv = row_inv_rms(v[q]);
                    const int rp = (r & ~4095) | ((r & 63) << 6) | ((r >> 6) & 63);
#pragma unroll
                    for (int i = 0; i < 4; ++i) {
                        const f32x4 gg = *(const f32x4*)(p.mix_g + 4 * lane + 256 * i);
                        u32x2 w; w[0] = pack2(v[q][i][0] * inv * gg[0], v[q][i][1] * inv * gg[1]); w[1] = pack2(v[q][i][2] * inv * gg[2], v[q][i][3] * inv * gg[3]);
                        *(u32x2*)(hn + (size_t)rp * D + 4 * lane + 256 * i) = w;
                    }
                }
            };
            const int n6_even = ((T / 6) / nwe) * nwe;
            for (int s6 = gwe; s6 < n6_even; s6 += nwe) hn_rows(s6 * 6, std::integral_constant<int, 6>{});
            for (int r = n6_even * 6 + gwe; r < T; r += nwe) hn_rows(r, std::integral_constant<int, 1>{});
        }
        for (int _rb = 0; _rb < REP0B; ++_rb) {
            for (int i = gt; i < 4 * 32 * 1024; i += nt) {
                const int d = i & 1023, cc = __builtin_amdgcn_readfirstlane((i >> 10) & 31), g = __builtin_amdgcn_readfirstlane(i >> 15);
                const float* wp = p.w_fo + (size_t)(g * 128) * 1024 + d;
                float sr[4], si[4];
#pragma unroll
                for (int j = 0; j < 4; ++j) { sr[j] = 0.f; si[j] = 0.f; }
                for (int m0 = 0; m0 < 128; m0 += 32) {
                    float w[32];
#pragma unroll
                    for (int q = 0; q < 32; ++q) w[q] = wp[(size_t)(m0 + q) * 1024];
#pragma unroll
                    for (int q = 0; q < 32; ++q)
#pragma unroll
                        for (int j = 0; j < 4; ++j) { const int k = ((cc * 4 + j) * (m0 + q)) & 127; sr[j] += CS128[k][0] * w[q]; si[j] += CS128[k][1] * w[q]; }
                }
                u32x4 o;
                o[0] = pack2(sr[0] * 0.08838834764831845f, si[0] * 0.08838834764831845f); o[1] = pack2(sr[1] * 0.08838834764831845f, si[1] * 0.08838834764831845f);
                o[2] = pack2(sr[2] * 0.08838834764831845f, si[2] * 0.08838834764831845f); o[3] = pack2(sr[3] * 0.08838834764831845f, si[3] * 0.08838834764831845f);
                *(u32x4*)(WpT + (size_t)d * 1024 + g * 256 + cc * 8) = o;
            }
        }
        STAMP(2);
        for (int _rc = 0; _rc < REP0C; ++_rc) {
        for (int i = gt; i < 80 * 2048; i += nt) {
            const int n = i >> 11, k = i & 2047, kk = k & 1023;
            const float w = n < 64 ? p.re_w[kk * 64 + n] : (n < 72 ? p.rg_w[kk * 8 + (n - 64)] : 0.f);
            const bf16_t hi = f2bf(w);
            WrT[i] = k < 1024 ? hi : f2bf(w - bf2f(hi));
        }
        for (int i = gt; i < 256 * 128; i += nt) {
            const int n = i >> 7, k = i & 127;
            const int w = n >> 7, k1 = (n >> 1) & 63, ri = n & 1, w2 = k >> 6, l1 = k & 63;
            float sv, cv; sincospif((float)((k1 * l1) & 63) * (1.0f / 32.0f), &sv, &cv);
            BtA[i] = f2bf(w == w2 ? (ri ? -sv : cv) * 0.125f : 0.f);
        }
        for (int i = gt; i < 256 * 256; i += nt) {
            const int n = i >> 8, k = i & 255;
            const int w = n >> 7, k2 = (n >> 1) & 63, ri = n & 1, w2 = k >> 7, l2 = (k >> 1) & 63, ri2 = k & 1;
            float sv, cv; sincospif((float)((k2 * l2) & 63) * (1.0f / 32.0f), &sv, &cv);
            const float v = ri == 0 ? (ri2 == 0 ? cv : sv) : (ri2 == 0 ? -sv : cv);
            BtC[i] = f2bf(w == w2 ? v * 0.125f : 0.f);
        }
        for (int i = gt; i < 64 * 64; i += nt) {
            const int k1 = i >> 6, l2 = i & 63;
            float sv, cv; sincospif((float)(k1 * l2) * (1.0f / 2048.0f), &sv, &cv);
            TW[i] = (f32x2){cv, -sv};
        }
        }
        STAMP(3);
        for (int _rd = 0; _rd < REP0D; ++_rd) for (int j = blockIdx.x; j < SG * 8; j += gridDim.x) ssm_prep_job(p, j >> 3, j & 7, (float*)smem);
        STAMP(4);
            __syncthreads();
        };
        {
            LAS float* ldsw = (LAS float*)ldsp + __builtin_amdgcn_readfirstlane(wid) * (64 * 65);
            if (!cvb) run_tjobs<2>(p, 0, split ? TJ_NE + EXP_P0 : TJ_TOTAL, gwe, nwe, lane, ldsw);
        }
        __syncthreads();
        STAMP(1);
        rest();
    }
    STAMP(5);
    if (CVB_) xcd_barrier_arrive(bar); else GRID_SYNC();
    STAMP(6);
    }
    for (int _rep = 0; _rep < REP1; ++_rep) {
    {
        PHASE_IDS
        auto E = [=](const g8::Unit& u, int rl, int cl, f32x4 v0, f32x4 v1) {
            const int m = u.r0 + rl, n8 = u.c0 + cl;
            const int b = m >> 12, l2 = (m >> 6) & 63, l1 = m & 63, tok = (b << 12) + (l1 << 6) + l2;
            if (n8 < FW) {
                const int g = n8 >> 7, c = n8 & 127;
                const bool odd = (l1 & 1) != 0;
                f32x4 recv;
#pragma unroll
                for (int j = 0; j < 4; ++j) recv[j] = __shfl_xor(odd ? v0[j] : v1[j], 1);
                bf16_t* dst = XA + ((((size_t)(b * 4 + g) * 128 + c + (odd ? 4 : 0)) * 64 + l2) << 6) + (l1 & ~1);
#pragma unroll
                for (int j = 0; j < 4; ++j) *(unsigned*)(dst + ((size_t)j << 12)) = odd ? pack2(recv[j], v1[j]) : pack2(v0[j], recv[j]);
            } else if (n8 < FW + SW) {
                const int ch = n8 - FW, g = ch >> 4, ci = ch & 15;
                u32x4 w; w[0] = pack2(v0[0], v0[1]); w[1] = pack2(v0[2], v0[3]); w[2] = pack2(v1[0], v1[1]); w[3] = pack2(v1[2], v1[3]);
                *(u32x4*)(Ucomb + ((size_t)(g * ROWS + (tok >> 5))) * UK + (tok & 31) * 16 + ci) = w;
            } else {
                u32x2 w; w[0] = pack4_u8(sigmoidf_(v0[0]), sigmoidf_(v0[1]), sigmoidf_(v0[2]), sigmoidf_(v0[3])); w[1] = pack4_u8(sigmoidf_(v1[0]), sigmoidf_(v1[1]), sigmoidf_(v1[2]), sigmoidf_(v1[3]));
                *(u32x2*)(gates + (size_t)tok * 2048 + (n8 - 1024)) = w;
            }
        };
        if (CVB_) {
            LAS float* ldsw = (LAS float*)ldsp + __builtin_amdgcn_readfirstlane(wid) * (64 * 65);
            STAMPB(40, 22);
            run_tjobs<3>(p, TJ_NE + EXP_P0, TJ_TOTAL - TJ_POOL, CIDX_ * NWAVES + wid, NCB_ * NWAVES, lane, ldsw);
            run_tjobs_pool(p, TJ_TOTAL - TJ_POOL, TJ_TOTAL, (unsigned*)(ws + OFF_J + J_CNT) + 200, lane, ldsw);
            __syncthreads();
            STAMPB(40, 23);
            xcd_barrier_finish(bar);
        } else {
            g8::DenseSched S; S.A = (const char*)hn; S.B = (const char*)WinT; S.gsA = 0; S.gsB = 0; S.lda = D; S.ldb = D; S.nM = T / 256; S.nN = INW / 256; S.nG = 1;
            S.G = SPLIT_ ? NGB_ : gridDim.x; S.c = SPLIT_ ? GIDX_ : blockIdx.x;
            g8::gemm_phase<false, false, true>(ldsp, D, D, D, S, epi_noload8(E));
        }
    }
    GRID_SYNC();
    STAMP(7);
    }
    {
        PHASE_IDS
        const bool sp = gridDim.x == 256;
        const int part = sp ? PART_ : -1, PG = sp ? 128 : (int)gridDim.x, pc = sp ? PIDX_ : (int)blockIdx.x;
        XcdBarrier pbar; pbar.bar = (unsigned*)(ws + OFF_J + J_PBAR) + PART_ * XCD_BAR_WORDS; pbar.x = bar.x; pbar.st = (volatile LAS unsigned*)(ldsp + PBAR_LDS_OFF); pbar.G = 128u;
        if (part != 1)
        {
            auto L = [=](const g8::Unit& u, int rl, int cl) {
                const int r = u.r0 + rl, n4 = u.c0 + cl;
                const int l2 = 2 * (r & 31) + (n4 >> 7), k1 = (n4 & 127) >> 1;
                return AuxT{TW[k1 * 64 + l2], TW[(k1 + 1) * 64 + l2]};
            };
            auto S = [=](const g8::Unit& u, int rl, int cl, f32x4 v, const AuxT& a) {
                const int r = u.r0 + rl, n4 = u.c0 + cl;
                const int l2 = 2 * (r & 31) + (n4 >> 7), c = (r >> 5) & 127, bg = r >> 12, k1 = (n4 & 127) >> 1;
                bf16_t* dst = T2 + ((((size_t)(bg * 64 + k1) * 128 + c) * 64 + l2) << 1);
                *(unsigned*)dst = pack2(v[0] * a.t0[0] - v[1] * a.t0[1], v[0] * a.t0[1] + v[1] * a.t0[0]);
                *(unsigned*)(dst + 128 * 64 * 2) = pack2(v[2] * a.t1[0] - v[3] * a.t1[1], v[2] * a.t1[1] + v[3] * a.t1[0]);
            };
            dense_gemm(ldsp, XA, BtA, 65536, 256, 128, 128, 128, 1, 0, 0, epi_ls(L, S), PG, pc);
        }
        if (part != 0)
        {
            auto E = [=](const g8::Unit& u, int rl, int cl, f32x4 v) { if (rl < u.nrows) *(f32x4*)(Sst + (size_t)(u.aux * ROWS + u.r0 + rl) * 256 + u.c0 + cl) = v; };
            half_gemm(ldsp, Ucomb, BtS, ROWS, 256, 512, UK, 512, SG, (size_t)ROWS * UK, (size_t)256 * 512, epi_noload(E), PG, pc);
        }
        if (sp) xcd_barrier(pbar); else GRID_SYNC();
        STAMP(8);
        auto EC = [=](const g8::Unit& u, int rl, int cl, f32x4 v) {
            const int r = u.r0 + rl, n4 = u.c0 + cl;
            const int c = 2 * (r & 63) + (n4 >> 7), k1 = (r >> 6) & 63, bg = r >> 12, k2 = (n4 & 127) >> 1;
            bf16_t* dst = Fb + ((size_t)((bg >> 2) * SEQ + k1 + 64 * k2)) * 1024 + ((bg & 3) * 128 + c) * 2;
            *(unsigned*)dst = pack2(v[0], v[1]);
            *(unsigned*)(dst + 64 * 1024) = pack2(v[2], v[3]);
        };
        if (part != 1) dense_gemm(ldsp, T2, BtC, 65536, 256, 256, 256, 256, 1, 0, 0, epi_noload(EC), PG, pc, 0, sp ? 1 : 1 << 30);
        if (sp ? part == 1 : blockIdx.x < 128) {
            float* Eseg = (float*)ldsp;
            __syncthreads();
            const int seg = tid >> 7, sl = tid & 127, sidx = pc * 128 + sl;
            const int n = sidx & 63, dir = (sidx >> 6) & 1, g = (sidx >> 7) & 31, b = sidx >> 12;
            const f32x2 a = aL[(dir * SG + g) * SN + n];
            f32x2 s[32];
#pragma unroll
            for (int q = 0; q < 32; ++q) {
                const int jj = seg * 32 + q, j = dir == 0 ? jj : (NCH - 1 - jj);
                s[q] = __builtin_nontemporal_load((const f32x2*)(Sst + ((size_t)g * ROWS + b * NCH + j) * 256 + (dir * 64 + n) * 2));
            }
            float er = 0.f, ei = 0.f;
#pragma unroll
            for (int q = 0; q < 32; ++q) {
                const float nr = a[0] * er - a[1] * ei + s[q][0], ni = a[0] * ei + a[1] * er + s[q][1];
                er = nr; ei = ni;
            }
            float pr = a[0], pi = a[1];
#pragma unroll
            for (int k = 0; k < 5; ++k) { const float t = pr * pr - pi * pi; pi = 2.f * pr * pi; pr = t; }
            Eseg[(seg * 128 + sl) * 2] = er; Eseg[(seg * 128 + sl) * 2 + 1] = ei;
            __syncthreads();
            float hr = 0.f, hi = 0.f;
            for (int k = 0; k < seg; ++k) {
                const float xr = Eseg[(k * 128 + sl) * 2], xi = Eseg[(k * 128 + sl) * 2 + 1];
                const float nr = pr * hr - pi * hi + xr, ni = pr * hi + pi * hr + xi;
                hr = nr; hi = ni;
            }
#pragma unroll
            for (int q = 0; q < 32; ++q) {
                const int jj = seg * 32 + q, j = dir == 0 ? jj : (NCH - 1 - jj);
                const size_t row = (size_t)g * ROWS + b * NCH + j;
                *(unsigned*)(Ucomb + row * UK + 512 + (dir * 64 + n) * 2) = pack2(hr, hi);
                const float nr = a[0] * hr - a[1] * hi + s[q][0], ni = a[0] * hi + a[1] * hr + s[q][1];
                hr = nr; hi = ni;
            }
            __syncthreads();
        }
        if (part != 0) { if (sp) xcd_barrier(pbar); else GRID_SYNC(); }
        STAMP(9);
        if (sp && part == 0) {
            if (threadIdx.x == 0) {
                unsigned* pb1 = (unsigned*)(ws + OFF_J + J_PBAR) + XCD_BAR_WORDS;
                XB_SPIN(xb_ld(&pb1[XB_TOPGEN]) < 2u, pb1);
                __builtin_amdgcn_fence(__ATOMIC_ACQUIRE, "agent");
                asm volatile("s_waitcnt vmcnt(0)" ::: "memory");
            }
            __syncthreads();
        }
        {
            auto L = [=](const g8::Unit& u, int rl, int cl) {
                const int g = u.aux, m = u.r0 + rl, n8 = u.c0 + cl;
                const float* dp = p.ssm_D + g * 16 + (n8 & 15);
                return AuxY8{*(const u32x4*)(Ucomb + (size_t)(g * ROWS + m) * UK + n8), *(const f32x4*)dp, *(const f32x4*)(dp + 4)};
            };
            auto S = [=](const g8::Unit& u, int rl, int cl, f32x4 v0, f32x4 v1, const AuxY8& a) {
                const int g = u.aux, m = u.r0 + rl, n8 = u.c0 + cl;
                const int tt = n8 >> 4, co = n8 & 15, tok = m * LC + tt, ch = g * 16 + co;
                if (rl >= u.nrows) return;
                u32x4 w;
                w[0] = pack2(gelu_tanh(v0[0] + a.d0[0] * bflo(a.uu[0])), gelu_tanh(v0[1] + a.d0[1] * bfhi(a.uu[0])));
                w[1] = pack2(gelu_tanh(v0[2] + a.d0[2] * bflo(a.uu[1])), gelu_tanh(v0[3] + a.d0[3] * bfhi(a.uu[1])));
                w[2] = pack2(gelu_tanh(v1[0] + a.d1[0] * bflo(a.uu[2])), gelu_tanh(v1[1] + a.d1[1] * bfhi(a.uu[2])));
                w[3] = pack2(gelu_tanh(v1[2] + a.d1[2] * bflo(a.uu[3])), gelu_tanh(v1[3] + a.d1[3] * bfhi(a.uu[3])));
                *(u32x4*)(yg + (size_t)tok * SW + ch) = w;
            };
            half_gemm<true>(ldsp, Ucomb, BtY, ROWS, 512, UK, UK, UK, SG, (size_t)ROWS * UK, (size_t)512 * UK, epi_ls8(L, S), PG, pc, sp && part == 0 ? 1 : 0, sp ? 1 : 1 << 30);
        }
        if (sp && part == 1) {
            if (threadIdx.x == 0) {
                unsigned* pb0 = (unsigned*)(ws + OFF_J + J_PBAR);
                XB_SPIN(xb_ld(&pb0[XB_TOPGEN]) < 1u, pb0);
                __builtin_amdgcn_fence(__ATOMIC_ACQUIRE, "agent");
                asm volatile("s_waitcnt vmcnt(0)" ::: "memory");
            }
            __syncthreads();
            dense_gemm(ldsp, T2, BtC, 65536, 256, 256, 256, 256, 1, 0, 0, epi_noload(EC), PG, pc, 1, 1);
        }
    }
    GRID_SYNC();
    STAMP(10);
    {
        PHASE_IDS
        const int bb = blockIdx.x, grp = (bb & 7) + 8 * (bb >> 5), jj = (bb >> 3) & 3;
        unsigned* gcnt = (unsigned*)(ws + OFF_J + J_CNT) + 128 + grp;
        auto LD = [=](const g8::Unit& u, int rl, int cl) { return *(const u32x2*)(gates + (size_t)(u.r0 + rl) * 2048 + u.c0 + cl); };
        auto SD = [=](const g8::Unit& u, int rl, int cl, f32x4 v0, f32x4 v1, const u32x2& gg) {
            u32x4 w; w[0] = pack2(g8f(gg[0], 0) * v0[0], g8f(gg[0], 1) * v0[1]); w[1] = pack2(g8f(gg[0], 2) * v0[2], g8f(gg[0], 3) * v0[3]);
            w[2] = pack2(g8f(gg[1], 0) * v1[0], g8f(gg[1], 1) * v1[1]); w[3] = pack2(g8f(gg[1], 2) * v1[2], g8f(gg[1], 3) * v1[3]);
            *(u32x4*)(m1 + (size_t)(u.r0 + rl) * D + u.c0 + cl) = w;
        };
        auto LG = [=](const g8::Unit& u, int rl, int cl) { return *(const u32x4*)(yg + (size_t)(u.r0 + rl) * SW + u.c0 + cl); };
        auto LS = [=](const g8::Unit& u, int rl, int cl) {
            return AuxG{*(const u32x2*)(gates + (size_t)(u.r0 + rl) * 2048 + 1024 + u.c0 + cl), *(const u32x4*)(m1 + (size_t)(u.r0 + rl) * D + u.c0 + cl)};
        };
        auto LW = [=](const g8::Unit& u, int rl, int cl) { const float* xp = p.x + (size_t)(u.r0 + rl) * D + u.c0 + cl; return AuxF8{__builtin_nontemporal_load((const f32x4*)xp), __builtin_nontemporal_load((const f32x4*)(xp + 4))}; };
        auto SW_ = [=](const g8::Unit& u, int rl, int cl, f32x4 v0, f32x4 v1, const AuxF8& xx) {
            u32x4 w; w[0] = pack2(xx.a[0] + v0[0], xx.a[1] + v0[1]); w[1] = pack2(xx.a[2] + v0[2], xx.a[3] + v0[3]); w[2] = pack2(xx.b[0] + v1[0], xx.b[1] + v1[1]); w[3] = pack2(xx.b[2] + v1[2], xx.b[3] + v1[3]);
            *(u32x4*)(x2 + (size_t)(u.r0 + rl) * D + u.c0 + cl) = w;
        };
        if (gridDim.x == 256) {
            auto SGw = [=](const g8::Unit& u, int rl, int cl, f32x4 v0, f32x4 v1, const u32x4& yy) {
                if (rl >= u.nrows) return;
                u32x4 w; w[0] = pack2(bflo(yy[0]) * sigmoidf_(v0[0]), bfhi(yy[0]) * sigmoidf_(v0[1])); w[1] = pack2(bflo(yy[1]) * sigmoidf_(v0[2]), bfhi(yy[1]) * sigmoidf_(v0[3]));
                w[2] = pack2(bflo(yy[2]) * sigmoidf_(v1[0]), bfhi(yy[2]) * sigmoidf_(v1[1])); w[3] = pack2(bflo(yy[3]) * sigmoidf_(v1[2]), bfhi(yy[3]) * sigmoidf_(v1[3]));
                store16_wt(ys2 + (size_t)(u.r0 + rl) * SW + u.c0 + cl, w);
            };
            auto SSw = [=](const g8::Unit& u, int rl, int cl, f32x4 v0, f32x4 v1, const AuxG& a) {
                u32x4 w;
                w[0] = pack2(bflo(a.m[0]) + g8f(a.g[0], 0) * v0[0], bfhi(a.m[0]) + g8f(a.g[0], 1) * v0[1]); w[1] = pack2(bflo(a.m[1]) + g8f(a.g[0], 2) * v0[2], bfhi(a.m[1]) + g8f(a.g[0], 3) * v0[3]);
                w[2] = pack2(bflo(a.m[2]) + g8f(a.g[1], 0) * v1[0], bfhi(a.m[2]) + g8f(a.g[1], 1) * v1[1]); w[3] = pack2(bflo(a.m[3]) + g8f(a.g[1], 2) * v1[2], bfhi(a.m[3]) + g8f(a.g[1], 3) * v1[3]);
                store16_wt(m1 + (size_t)(u.r0 + rl) * D + u.c0 + cl, w);
            };
            const int hh = jj & 1, pn2 = jj >> 1;
            OneUnit S2; S2.u.A = (const char*)(yg + (size_t)(grp * 256 + hh * 128) * SW); S2.u.B = (const char*)(WglT + (size_t)pn2 * 256 * SW); S2.u.r0 = grp * 256 + hh * 128; S2.u.c0 = pn2 * 256; S2.u.aux = 0; S2.u.nrows = 128; S2.u.ridx = nullptr;
            g8::gemm_phase<true, false, true>(ldsp, SW, SW, SW, S2, epi_ls8(LG, SGw));
            group_arrive(gcnt);
            OneUnit S1; S1.u.A = (const char*)(Fb + (size_t)grp * 256 * 1024); S1.u.B = (const char*)(WpT + (size_t)jj * 256 * 1024); S1.u.r0 = grp * 256; S1.u.c0 = jj * 256; S1.u.aux = 0; S1.u.nrows = 256; S1.u.ridx = nullptr;
            g8::gemm_phase<false, false, true>(ldsp, 1024, 1024, 1024, S1, epi_ls8(LD, SD));
            group_wait(gcnt, 4u);
            OneUnit S3; S3.u.A = (const char*)(ys2 + (size_t)grp * 256 * SW); S3.u.B = (const char*)(WsoT + (size_t)jj * 256 * SW); S3.u.r0 = grp * 256; S3.u.c0 = jj * 256; S3.u.aux = 0; S3.u.nrows = 256; S3.u.ridx = nullptr;
            g8::gemm_phase<false, false, true>(ldsp, SW, SW, SW, S3, epi_ls8(LS, SSw));
            group_arrive(gcnt);
            group_wait(gcnt, 8u);
            OneUnit S4; S4.u.A = (const char*)(m1 + (size_t)grp * 256 * D); S4.u.B = (const char*)(WoT + (size_t)jj * 256 * D); S4.u.r0 = grp * 256; S4.u.c0 = jj * 256; S4.u.aux = 0; S4.u.nrows = 256; S4.u.ridx = nullptr;
            auto SWw = [=](const g8::Unit& u, int rl, int cl, f32x4 v0, f32x4 v1, const AuxF8& xx) {
                u32x4 w; w[0] = pack2(xx.a[0] + v0[0], xx.a[1] + v0[1]); w[1] = pack2(xx.a[2] + v0[2], xx.a[3] + v0[3]); w[2] = pack2(xx.b[0] + v1[0], xx.b[1] + v1[1]); w[3] = pack2(xx.b[2] + v1[2], xx.b[3] + v1[3]);
                store16_wt(x2 + (size_t)(u.r0 + rl) * D + u.c0 + cl, w);
            };
            g8::gemm_phase<false, false, true>(ldsp, D, D, D, S4, epi_ls8(LW, SWw));
            group_arrive(gcnt);
            group_wait(gcnt, 12u);
        } else {
            auto SG_ = [=](const g8::Unit& u, int rl, int cl, f32x4 v0, f32x4 v1, const u32x4& yy) {
                if (rl >= u.nrows) return;
                u32x4 w; w[0] = pack2(bflo(yy[0]) * sigmoidf_(v0[0]), bfhi(yy[0]) * sigmoidf_(v0[1])); w[1] = pack2(bflo(yy[1]) * sigmoidf_(v0[2]), bfhi(yy[1]) * sigmoidf_(v0[3]));
                w[2] = pack2(bflo(yy[2]) * sigmoidf_(v1[0]), bfhi(yy[2]) * sigmoidf_(v1[1])); w[3] = pack2(bflo(yy[3]) * sigmoidf_(v1[2]), bfhi(yy[3]) * sigmoidf_(v1[3]));
                *(u32x4*)(ys2 + (size_t)(u.r0 + rl) * SW + u.c0 + cl) = w;
            };
            auto SS = [=](const g8::Unit& u, int rl, int cl, f32x4 v0, f32x4 v1, const AuxG& a) {
                u32x4 w;
                w[0] = pack2(bflo(a.m[0]) + g8f(a.g[0], 0) * v0[0], bfhi(a.m[0]) + g8f(a.g[0], 1) * v0[1]); w[1] = pack2(bflo(a.m[1]) + g8f(a.g[0], 2) * v0[2], bfhi(a.m[1]) + g8f(a.g[0], 3) * v0[3]);
                w[2] = pack2(bflo(a.m[2]) + g8f(a.g[1], 0) * v1[0], bfhi(a.m[2]) + g8f(a.g[1], 1) * v1[1]); w[3] = pack2(bflo(a.m[3]) + g8f(a.g[1], 2) * v1[2], bfhi(a.m[3]) + g8f(a.g[1], 3) * v1[3]);
                *(u32x4*)(m1 + (size_t)(u.r0 + rl) * D + u.c0 + cl) = w;
            };
            dense_gemm<true>(ldsp, Fb, WpT, T, D, 1024, 1024, 1024, 1, 0, 0, epi_ls8(LD, SD));
            GRID_SYNC();
            half_gemm<true>(ldsp, yg, WglT, T, SW, SW, SW, SW, 1, 0, 0, epi_ls8(LG, SG_));
            GRID_SYNC();
            dense_gemm<true>(ldsp, ys2, WsoT, T, D, SW, SW, SW, 1, 0, 0, epi_ls8(LS, SS));
            GRID_SYNC();
            dense_gemm<true>(ldsp, m1, WoT, T, D, D, D, D, 1, 0, 0, epi_ls8(LW, SW_));
        }
    }
    if (gridDim.x != 256) GRID_SYNC();
    STAMP(13);
    for (int _rep = 0; _rep < REP8; ++_rep) {
    if (_rep > 0) { if (blockIdx.x == 0 && threadIdx.x < 64) cnt[threadIdx.x] = 0u; GRID_SYNC(); }
    {
        PHASE_IDS
        LAS unsigned char* hrow = ldsp;
        LAS float* lg = (LAS float*)(ldsp + 132096);
        const int fr = lane & 15, fq = lane >> 4;
        const int tb8 = gridDim.x == 256 ? (((int)(blockIdx.x & 7) + 8 * (int)(blockIdx.x >> 5)) * 4 + (int)((blockIdx.x >> 3) & 3)) : (int)blockIdx.x;
        for (int tb = tb8; tb < T / 64; tb += gridDim.x) {
            const int tok0 = tb * 64;
#pragma unroll
            for (int h = 0; h < 2; ++h) {
                f32x4 xv[4][4];
#pragma unroll
                for (int q = 0; q < 4; ++q) {
#pragma unroll
                    for (int i = 0; i < 4; ++i) { const u32x2 w = __builtin_nontemporal_load((const u32x2*)(x2 + (size_t)(tok0 + wid * 8 + h * 4 + q) * D + 4 * lane + 256 * i)); xv[q][i] = (f32x4){__uint_as_float(w[0] << 16), __uint_as_float(w[0] & 0xffff0000u), __uint_as_float(w[1] << 16), __uint_as_float(w[1] & 0xffff0000u)}; }
                }
#pragma unroll
                for (int q = 0; q < 4; ++q) {
                    const int rl = wid * 8 + h * 4 + q, r = tok0 + rl;
                    const float inv = row_inv_rms(xv[q]);
#pragma unroll
                    for (int i = 0; i < 4; ++i) {
                        const f32x4 gg = *(const f32x4*)(p.ffn_g + 4 * lane + 256 * i);
                        u32x2 w; w[0] = pack2(xv[q][i][0] * inv * gg[0], xv[q][i][1] * inv * gg[1]); w[1] = pack2(xv[q][i][2] * inv * gg[2], xv[q][i][3] * inv * gg[3]);
                        *(unsigned*)(hn2 + (size_t)r * D + 4 * lane + 256 * i) = pack4_fp8(xv[q][i][0] * inv * gg[0], xv[q][i][1] * inv * gg[1], xv[q][i][2] * inv * gg[2], xv[q][i][3] * inv * gg[3]);
                        *(LAS u32x2*)(hrow + rl * 2064 + (4 * lane + 256 * i) * 2) = w;
                    }
                }
            }
            __syncthreads();
            STAMP(19);
            if (wid < 5) {
                const LAS unsigned char* ap = hrow + fr * 2064 + fq * 16;
                const bf16_t* bp = WrT + (size_t)(wid * 16 + fr) * 2048 + fq * 8;
                asm volatile("" : "+v"(bp));
                f32x4 acc[4];
#pragma unroll
                for (int m = 0; m < 4; ++m) acc[m] = (f32x4){0.f, 0.f, 0.f, 0.f};
                bf16x8 b0[16], b1[16];
#pragma unroll
                for (int s = 0; s < 16; ++s) b0[s] = *(const bf16x8*)(bp + s * 32);
#pragma nounroll
                for (int kb = 0; kb < 4; kb += 2) {
#pragma unroll
                    for (int s = 0; s < 16; ++s) b1[s] = *(const bf16x8*)(bp + ((kb + 1) * 16 + s) * 32);
#pragma unroll
                    for (int s = 0; s < 16; ++s) {
                        const int ks = kb * 16 + s;
#pragma unroll
                        for (int m = 0; m < 4; ++m) acc[m] = __builtin_amdgcn_mfma_f32_16x16x32_bf16(b0[s], *(const LAS bf16x8*)(ap + m * 16 * 2064 + (ks & 31) * 64), acc[m], 0, 0, 0);
                        if ((s & 3) == 3) __builtin_amdgcn_sched_barrier(0);
                    }
                    if (kb + 2 < 4) {
#pragma unroll
                        for (int s = 0; s < 16; ++s) b0[s] = *(const bf16x8*)(bp + ((kb + 2) * 16 + s) * 32);
                    }
#pragma unroll
                    for (int s = 0; s < 16; ++s) {
                        const int ks = (kb + 1) * 16 + s;
#pragma unroll
                        for (int m = 0; m < 4; ++m) acc[m] = __builtin_amdgcn_mfma_f32_16x16x32_bf16(b1[s], *(const LAS bf16x8*)(ap + m * 16 * 2064 + (ks & 31) * 64), acc[m], 0, 0, 0);
                        if ((s & 3) == 3) __builtin_amdgcn_sched_barrier(0);
                    }
                }
#pragma unroll
                for (int m = 0; m < 4; ++m) *(LAS f32x4*)(lg + (m * 16 + fr) * 80 + wid * 16 + 4 * fq) = acc[m];
            }
            __syncthreads();
            STAMP(20);
            if (tid < 64) {
                const LAS float* L = lg + tid * 80;
                float gv[8];
#pragma unroll
                for (int i = 0; i < 8; ++i) gv[i] = L[64 + i] + p.rg_b[i];
                int gi = 0; float gm = gv[0];
#pragma unroll
                for (int i = 1; i < 8; ++i) if (gv[i] > gm) { gm = gv[i]; gi = i; }
                float den = 0.f;
#pragma unroll
                for (int i = 0; i < 8; ++i) den += __expf(gv[i] - gm);
                const float pg = 1.0f / den;
                float ev[8];
#pragma unroll
                for (int i = 0; i < 8; ++i) { const int c = gi * 8 + i; ev[i] = L[c] + p.re_b[c]; }
                int i1 = 0; float v1 = ev[0];
#pragma unroll
                for (int i = 1; i < 8; ++i) if (ev[i] > v1) { v1 = ev[i]; i1 = i; }
                int i2 = -1; float v2 = -3.0e38f;
#pragma unroll
                for (int i = 0; i < 8; ++i) if (i != i1 && ev[i] > v2) { v2 = ev[i]; i2 = i; }
                const float e2 = __expf(v2 - v1), w1 = pg / (1.0f + e2), w2 = pg * e2 / (1.0f + e2);
                const int tok = tok0 + tid, ex1 = gi * 8 + i1, ex2 = gi * 8 + i2;
                int r1 = 0, c1 = 0, r2 = 0, h = 0;
                for (int j = 0; j < 64; ++j) {
                    const int e1j = __shfl(ex1, j), e2j = __shfl(ex2, j);
                    r1 += (j < tid && e1j == ex1) ? 1 : 0;
                    c1 += (e1j == ex2) ? 1 : 0;
                    r2 += (j < tid && e2j == ex2) ? 1 : 0;
                    h += ((e1j == tid) ? 1 : 0) + ((e2j == tid) ? 1 : 0);
                }
                *(int4*)(tokinfo + 4 * tok) = make_int4(ex1, r1, ex2, c1 + r2);
                tokw[tok] = (f32x2){w1, w2};
                hist[tb * 64 + tid] = h;
            }
            __syncthreads();
            STAMP(21);
        }
    }
    GRID_SYNC();
    }
    STAMP(14);
    LAS int* tab = (LAS int*)(ldsp + TAB_LDS_OFF);
    for (int _rep = 0; _rep < REP9; ++_rep) {
    {
        PHASE_IDS
        LAS int* baseL = tab + 280;
        LAS int* part = tab + 352;
        const int tb0 = blockIdx.x < T / 64 ? blockIdx.x : 0;
        for (int tb = tb0; tb < T / 64; tb += gridDim.x) {
            __syncthreads();
            {
                const int e = tid & 63, sl = tid >> 6;
                int tot = 0, base = 0;
#pragma unroll 8
                for (int b = sl * 32; b < sl * 32 + 32; ++b) { const int hh = hist[b * 64 + e]; tot += hh; base += (b < tb) ? hh : 0; }
                part[(sl * 64 + e) * 2] = tot; part[(sl * 64 + e) * 2 + 1] = base;
            }
            __syncthreads();
            if (tid < 64) {
                int tot = 0, base = 0;
#pragma unroll
                for (int sl = 0; sl < 8; ++sl) { tot += part[(sl * 64 + tid) * 2]; base += part[(sl * 64 + tid) * 2 + 1]; }
                tab[tid] = tot; baseL[tid] = base;
            }
            __syncthreads();
            if (tid == 0) {
                int ro = 0, tp = 0, tr = 0;
                for (int e = 0; e < NE; ++e) { const int c = tab[e]; tab[64 + e] = ro; tab[128 + e] = tp; tab[200 + e] = tr; ro += c; tp += c >> 8; tr += (c & 255) ? 1 : 0; }
                tab[128 + NE] = tp; tab[200 + NE] = tr;
            }
            __syncthreads();
            if (blockIdx.x >= T / 64) break;
            if (tid < 64) {
                const int tok = tb * 64 + tid;
                const int4 info = *(const int4*)(tokinfo + 4 * tok); const f32x2 w = tokw[tok];
                const int s1 = tab[64 + info.x] + baseL[info.x] + info.y, s2 = tab[64 + info.z] + baseL[info.z] + info.w;
                slot_asg[s1] = tok * 2; slot_asg[s2] = tok * 2 + 1; slot_w[s1] = w[0]; slot_w[s2] = w[1]; slot_tok[s1] = tok; slot_tok[s2] = tok;
            }
        }
    }
    GRID_SYNC();
    STAMP(15);
    }
    for (int _rep = 0; _rep < REP10; ++_rep) {
    {
        PHASE_IDS
        auto E = [=](const g8::Unit& u, int rl, int cl, f32x4 v0, f32x4 v1) {
            if (rl < u.nrows) {
                constexpr float ws = 1.0f / WSCALE8;
                const float g0 = v0[0] * ws, g1 = v0[2] * ws, g2 = v1[0] * ws, g3 = v1[2] * ws;
                const float k = ws * ASCALE8;
                *(unsigned*)(act + (size_t)(u.r0 + rl) * DE + ((u.c0 + cl) >> 1)) =
                    pack4_fp8(g0 * sigmoidf_(g0) * v0[1] * k, g1 * sigmoidf_(g1) * v0[3] * k, g2 * sigmoidf_(g2) * v1[1] * k, g3 * sigmoidf_(g3) * v1[3] * k);
            }
        };
        g8::RaggedSched S; S.A = (const char*)hn2; S.B = (const char*)Wgu8; S.tab = tab; S.gsB = (size_t)1024 * 1024; S.lda = D / 2; S.ldb = D / 2; S.nN = 4; S.G = gridDim.x; S.c = blockIdx.x; S.ridx = slot_tok;
        g8::gemm_phase<true, true, true, true>(ldsp, D / 2, D / 2, D / 2, S, epi_noload8(E));
    }
    GRID_SYNC();
    STAMP(16);
    }
    for (int _rep = 0; _rep < REP11; ++_rep) {
    {
        PHASE_IDS
        auto L = [=](const g8::Unit& u, int rl, int cl) { return AuxS{slot_asg[u.r0 + rl], slot_w[u.r0 + rl]}; };
        auto St = [=](const g8::Unit& u, int rl, int cl, f32x4 v0, f32x4 v1, const AuxS& a) {
            if (rl < u.nrows) {
                const float w = a.w * (YSCALE8 / (WSCALE8 * ASCALE8));
                u32x2 o; o[0] = pack4_fp8(w * v0[0], w * v0[1], w * v0[2], w * v0[3]); o[1] = pack4_fp8(w * v1[0], w * v1[1], w * v1[2], w * v1[3]);
                *(u32x2*)(ybuf8 + (size_t)a.as * D + u.c0 + cl) = o;
            }
        };
        g8::RaggedSched S; S.A = (const char*)act; S.B = (const char*)Wd8; S.tab = tab; S.gsB = (size_t)1024 * 512; S.lda = DE / 2; S.ldb = DE / 2; S.nN = 4; S.G = gridDim.x; S.c = blockIdx.x; S.ridx = nullptr;
        g8::gemm_phase<true, false, true, true>(ldsp, DE / 2, DE / 2, DE / 2, S, epi_ls8(L, St));
    }
    GRID_SYNC();
    STAMP(17);
    }
    {
        PHASE_IDS
#if defined(TP_A)
        float tp_keep = 0.f;
#endif
        for (int _r12 = 0; _r12 < REP12; ++_r12)
        for (int r0 = gw * 8; r0 < T; r0 += 8 * nw) {
            float* outp = (_r12 + 1 < REP12) ? (float*)(ws + OFF_E) : p.out;
            u32x2 xw[8][4]; int ya[8][4], yb[8][4];
#pragma unroll
            for (int q = 0; q < 8; ++q) {
                const int r = r0 + q;
                if (r < T) {
#pragma unroll
                    for (int i = 0; i < 4; ++i) {
                        xw[q][i] = __builtin_nontemporal_load((const u32x2*)(x2 + (size_t)r * D + 4 * lane + 256 * i));
                        ya[q][i] = __builtin_nontemporal_load((const int*)(ybuf8 + (size_t)(2 * r) * D + 4 * lane + 256 * i));
                        yb[q][i] = __builtin_nontemporal_load((const int*)(ybuf8 + (size_t)(2 * r + 1) * D + 4 * lane + 256 * i));
                    }
                }
            }
#pragma unroll
            for (int q = 0; q < 8; ++q) {
                const int r = r0 + q;
                if (r < T) {
                    f32x4 v[4];
#pragma unroll
                    for (int i = 0; i < 4; ++i) {
                        const u32x2 w = xw[q][i];
                        v[i] = (f32x4){__uint_as_float(w[0] << 16), __uint_as_float(w[0] & 0xffff0000u), __uint_as_float(w[1] << 16), __uint_as_float(w[1] & 0xffff0000u)};
                        const int y0 = ya[q][i], y1 = yb[q][i];
                        const f32x2 a0 = __builtin_amdgcn_cvt_pk_f32_fp8(y0, false), a1 = __builtin_amdgcn_cvt_pk_f32_fp8(y0, true), b0 = __builtin_amdgcn_cvt_pk_f32_fp8(y1, false), b1 = __builtin_amdgcn_cvt_pk_f32_fp8(y1, true);
                        v[i][0] += (a0[0] + b0[0]) * (1.0f / YSCALE8); v[i][1] += (a0[1] + b0[1]) * (1.0f / YSCALE8);
                        v[i][2] += (a1[0] + b1[0]) * (1.0f / YSCALE8); v[i][3] += (a1[1] + b1[1]) * (1.0f / YSCALE8);
                    }
                    const float inv = row_inv_rms(v);
#pragma unroll
                    for (int i = 0; i < 4; ++i) {
                        const f32x4 gg = *(const f32x4*)(p.fin_g + 4 * lane + 256 * i);
                        f32x4 o = (f32x4){v[i][0] * inv * gg[0], v[i][1] * inv * gg[1], v[i][2] * inv * gg[2], v[i][3] * inv * gg[3]};
#if defined(TP_A)
                        if (r == 0 && lane == 0 && i == 0) {
                            tp_keep = o[0];
#if TP_B != 18
                            o[0] += (float)(long long)(__hip_atomic_load(tsp + TP_B, __ATOMIC_RELAXED, __HIP_MEMORY_SCOPE_AGENT) - __hip_atomic_load(tsp + TP_A, __ATOMIC_RELAXED, __HIP_MEMORY_SCOPE_AGENT)) * (0.01f * (TP_GAIN));
#endif
                        }
#endif
                        __builtin_nontemporal_store(o, (f32x4*)(outp + (size_t)r * D + 4 * lane + 256 * i));
                    }
                }
            }
        }
#if defined(TP_A) && TP_B == 18
        {
            unsigned* donec = (unsigned*)(ws + OFF_J + J_TS + 512);
            donec = (unsigned*)(ws + OFF_J + J_CNT) + 100;
            asm volatile("s_waitcnt vmcnt(0)" ::: "memory");
            __syncthreads();
            if (threadIdx.x == 0) {
                if (blockIdx.x != 0) __hip_atomic_fetch_add(donec, 1u, __ATOMIC_RELAXED, __HIP_MEMORY_SCOPE_AGENT);
                else {
                    unsigned sp = 0;
                    while (__hip_atomic_load(donec, __ATOMIC_RELAXED, __HIP_MEMORY_SCOPE_AGENT) < gridDim.x - 1 && ++sp < (1u << 22)) __builtin_amdgcn_s_sleep(2);
                    const unsigned long long t1 = __builtin_amdgcn_s_memrealtime();
                    p.out[0] = tp_keep + (float)(long long)(t1 - __hip_atomic_load(tsp + TP_A, __ATOMIC_RELAXED, __HIP_MEMORY_SCOPE_AGENT)) * (0.01f * (TP_GAIN));
                }
            }
        }
#endif
    }
}

extern "C" void kernel_launch(void* const* d_in, const int* in_sizes, int n_in, void* d_out, int out_size, void* d_ws, size_t ws_size, hipStream_t stream) {
    (void)in_sizes; (void)n_in; (void)out_size;
    static int grid_blocks = 0;
    if (!grid_blocks) {
        int dev = 0, cus = 0, per_cu = 0;
        (void)hipGetDevice(&dev);
        (void)hipDeviceGetAttribute(&cus, hipDeviceAttributeMultiprocessorCount, dev);
        (void)hipOccupancyMaxActiveBlocksPerMultiprocessor(&per_cu, fwd_megakernel, NTHREADS, 0);
        if (per_cu > 1) per_cu = 1;
        if (per_cu < 1) per_cu = 1;
        grid_blocks = cus * per_cu;
    }
    if (ws_size < WS_NEED) { fprintf(stderr, "workspace too small: %zu < %zu\n", ws_size, (size_t)WS_NEED); return; }
    Params p{};
    p.x = (const float*)d_in[0]; p.mix_g = (const float*)d_in[1]; p.w_in = (const float*)d_in[2]; p.w_fo = (const float*)d_in[3];
    p.A_re = (const float*)d_in[4]; p.A_im = (const float*)d_in[5]; p.log_dt = (const float*)d_in[6];
    p.B_re = (const float*)d_in[7]; p.B_im = (const float*)d_in[8]; p.C_re = (const float*)d_in[9]; p.C_im = (const float*)d_in[10];
    p.ssm_D = (const float*)d_in[11]; p.w_glu = (const float*)d_in[12]; p.w_sso = (const float*)d_in[13]; p.w_out = (const float*)d_in[14];
    p.ffn_g = (const float*)d_in[15]; p.rg_w = (const float*)d_in[16]; p.rg_b = (const float*)d_in[17]; p.re_w = (const float*)d_in[18]; p.re_b = (const float*)d_in[19];
    p.e_gate = (const float*)d_in[20]; p.e_up = (const float*)d_in[21]; p.e_down = (const float*)d_in[22]; p.fin_g = (const float*)d_in[23];
    p.out = (float*)d_out; p.ws = (unsigned char*)d_ws;
    (void)hipMemsetAsync((unsigned char*)d_ws + OFF_J, 0, J_ZERO_BYTES, stream);
    void* args[] = {&p};
    hipError_t e = hipLaunchCooperativeKernel((const void*)fwd_megakernel, dim3(grid_blocks), dim3(NTHREADS), args, 0, stream);
    if (e != hipSuccess) fprintf(stderr, "cooperative launch failed: %s (grid %d)\n", hipGetErrorString(e), grid_blocks);
}
```
